# Optimizing an MI355X kernel written in HIP

```python
import jax, jax.numpy as jnp
from jax import lax
import numpy as np

D_MODEL = 1024
BATCH = 8
SEQ = 2048
DEPTH = 1

D_MIX = D_MODEL
HEAD_DIM = 64
ATTN_WIDTH = D_MIX // 2
ATTN_HEADS = ATTN_WIDTH // HEAD_DIM
CONV_DIM = D_MIX - ATTN_WIDTH
CONV_GROUPS = 8
CONV_K = 3
D_FF = 2816
BLOCK_Q = 128
EPS = 1e-6
N_MOD = 6
IN_SPLITS = (ATTN_WIDTH, 2 * ATTN_WIDTH, 3 * ATTN_WIDTH, 3 * ATTN_WIDTH + ATTN_HEADS,
             3 * ATTN_WIDTH + ATTN_HEADS + CONV_DIM, 3 * ATTN_WIDTH + ATTN_HEADS + 2 * CONV_DIM)
D_IN = 3 * ATTN_WIDTH + ATTN_HEADS + 3 * CONV_DIM

kernel_name = "hymba_fox_shortconv_convffn_adaln"


def rmsnorm(x, g):
    xf = x.astype(jnp.float32)
    xf = xf * lax.rsqrt(jnp.mean(xf * xf, axis=-1, keepdims=True) + EPS)
    return (xf * g.astype(jnp.float32)).astype(x.dtype)


def causal_dwconv(u, w):
    s = u.shape[1]
    up = jnp.pad(u, ((0, 0), (CONV_K - 1, 0), (0, 0)))
    y = w[0] * up[:, 0:s]
    for k in range(1, CONV_K):
        y = y + w[k] * up[:, k:k + s]
    return y


def forgetting_attention(q, k, v, logf):
    b, s, h, dh = q.shape
    fcum = jnp.cumsum(logf, axis=1)
    fcum = jnp.transpose(fcum, (0, 2, 1))
    scale = 1.0 / np.sqrt(dh)
    outs = []
    for i in range(s // BLOCK_Q):
        q0, q1 = i * BLOCK_Q, (i + 1) * BLOCK_Q
        qb = q[:, q0:q1]
        kb = k[:, :q1]
        vb = v[:, :q1]
        logits = jnp.einsum('bqhd,bkhd->bhqk', qb, kb).astype(jnp.float32) * scale
        logits = logits + fcum[:, :, q0:q1, None] - fcum[:, :, None, :q1]
        q_pos = q0 + jnp.arange(BLOCK_Q)
        k_pos = jnp.arange(q1)
        causal = k_pos[None, :] <= q_pos[:, None]
        logits = jnp.where(causal[None, None], logits, -jnp.inf)
        p = jax.nn.softmax(logits, axis=-1).astype(v.dtype)
        outs.append(jnp.einsum('bhqk,bkhd->bqhd', p, vb))
    return jnp.concatenate(outs, axis=1)


def hybrid_layer(x, c_act, w_ada, b_ada, norm1_g, w_in, b_forget, q_norm_g, k_norm_g,
                 conv_mix_w, w_out, norm2_g, w_up, ffn_conv_w, w_down):
    b, s, _ = x.shape
    mod = (c_act @ w_ada + b_ada)[:, None, :]
    sh1, sc1, g1, sh2, sc2, g2 = jnp.split(mod, N_MOD, axis=-1)

    h = rmsnorm(x, norm1_g) * (1 + sc1) + sh1
    proj = h @ w_in
    q, k, v, fg, xin, bg, cg = jnp.split(proj, IN_SPLITS, axis=-1)
    q = rmsnorm(q.reshape(b, s, ATTN_HEADS, HEAD_DIM), q_norm_g)
    k = rmsnorm(k.reshape(b, s, ATTN_HEADS, HEAD_DIM), k_norm_g)
    v = v.reshape(b, s, ATTN_HEADS, HEAD_DIM)
    logf = jax.nn.log_sigmoid((fg + b_forget).astype(jnp.float32))
    attn = forgetting_attention(q, k, v, logf).reshape(b, s, ATTN_WIDTH)

    conv = bg * causal_dwconv(cg * xin, conv_mix_w)

    mixed = jnp.concatenate([attn, conv], axis=-1)
    x = x + g1 * (mixed @ w_out)

    h2 = rmsnorm(x, norm2_g) * (1 + sc2) + sh2
    u = causal_dwconv(h2 @ w_up, ffn_conv_w)
    u_gate, u_val = jnp.split(u, 2, axis=-1)
    y = (jax.nn.silu(u_gate) * u_val) @ w_down
    return x + g2 * y


def setup_inputs(seed: int = 0) -> dict:
    key = jax.random.key(seed)
    ks = jax.random.split(key, 16)
    f32 = jnp.float32
    nrm = lambda k, shape, std: jax.random.normal(k, shape, f32) * std
    return {
        "x": nrm(ks[0], (BATCH, SEQ, D_MODEL), 1.0),
        "c": nrm(ks[1], (BATCH, D_MODEL), 1.0),
        "w_ada": nrm(ks[2], (DEPTH, D_MODEL, N_MOD * D_MODEL), 0.5 * D_MODEL ** -0.5),
        "b_ada": nrm(ks[3], (DEPTH, N_MOD * D_MODEL), 0.02),
        "norm1_g": 1.0 + nrm(ks[4], (DEPTH, D_MODEL), 0.02),
        "w_in": nrm(ks[5], (DEPTH, D_MODEL, D_IN), D_MODEL ** -0.5),
        "b_forget": jax.random.uniform(ks[6], (DEPTH, ATTN_HEADS), f32, 1.0, 4.0),
        "q_norm_g": 1.0 + nrm(ks[7], (DEPTH, HEAD_DIM), 0.02),
        "k_norm_g": 1.0 + nrm(ks[8], (DEPTH, HEAD_DIM), 0.02),
        "conv_mix_w": nrm(ks[9], (DEPTH, CONV_K, CONV_DIM), CONV_K ** -0.5),
        "w_out": nrm(ks[10], (DEPTH, D_MIX, D_MODEL), D_MIX ** -0.5),
        "norm2_g": 1.0 + nrm(ks[11], (DEPTH, D_MODEL), 0.02),
        "w_up": nrm(ks[12], (DEPTH, D_MODEL, 2 * D_FF), D_MODEL ** -0.5),
        "ffn_conv_w": nrm(ks[13], (DEPTH, CONV_K, 2 * D_FF), CONV_K ** -0.5),
        "w_down": nrm(ks[14], (DEPTH, D_FF, D_MODEL), D_FF ** -0.5),
    }


def reference(x, c, w_ada, b_ada, norm1_g, w_in, b_forget, q_norm_g, k_norm_g,
              conv_mix_w, w_out, norm2_g, w_up, ffn_conv_w, w_down):
    c_act = jax.nn.silu(c)
    for l in range(DEPTH):
        x = hybrid_layer(x, c_act, w_ada[l], b_ada[l], norm1_g[l], w_in[l], b_forget[l],
                         q_norm_g[l], k_norm_g[l], conv_mix_w[l], w_out[l], norm2_g[l],
                         w_up[l], ffn_conv_w[l], w_down[l])
    return x
```

```cpp
#include <hip/hip_runtime.h>
#include <hip/hip_cooperative_groups.h>
#include <cstdio>
#include <cstdint>
namespace cg = cooperative_groups;
namespace pg8 {
#define PG8_LAS __attribute__((address_space(3)))
typedef unsigned short bf16_t;
typedef short bf16x8 __attribute__((ext_vector_type(8)));
typedef float f32x4 __attribute__((ext_vector_type(4)));
typedef unsigned u32x4 __attribute__((ext_vector_type(4)));
constexpr int BM = 256, BK = 64, HALF = 128, HTB = HALF * BK * 2  , STAGE_BYTES = 8 * HTB, NXCD = 8, WGM = 8;

__host__ __device__ __forceinline__ int lds_byte(int r, int c) { const int st = (r >> 4) * 2 + (c >> 5), rr = r & 15, cc = c & 31, ob = rr * 64 + cc * 2; return st * 1024 + (ob ^ (((ob >> 9) & 1) << 5)); }
__host__ __device__ __forceinline__ void stage_rc(int b, int& R, int& C) { const int st = b / 1024, sb = b % 1024, swz = sb ^ (((sb >> 9) & 1) << 5); R = (st >> 1) * 16 + swz / 64; C = (st & 1) * 32 + (swz % 64) / 2; }
__host__ __device__ __forceinline__ int perm32(int rho) { const int n = rho >> 4, i = rho & 15; return 8 * (i >> 2) + 4 * n + (i & 3); }

struct Unit { int pm, pn; };
struct Gemm { const bf16_t* A; const bf16_t* Bt; int M, N, K; };

struct StaticOrder {
    int nM, nN, nwg, G, c;
    __host__ __device__ void init(int M, int N, int G_, int c_) { nM = M / BM; nN = N / BM; nwg = nM * nN; G = G_; c = c_; }
    __host__ __device__ bool next(int i, Unit& u) const {
        const long L = (long)i * G + c; if (L >= nwg) return false;
        int wgid = (int)L; { const int q = nwg / NXCD, r = nwg % NXCD, xcd = wgid % NXCD, off = wgid / NXCD; wgid = (xcd < r ? xcd * (q + 1) : r * (q + 1) + (xcd - r) * q) + off; }
        const int nig = WGM * nN, gid = wgid / nig, fm = gid * WGM, gsz = (nM - fm) < WGM ? (nM - fm) : WGM;
        u.pm = fm + ((wgid % nig) % gsz); u.pn = (wgid % nig) / gsz; return true;
    }
    __device__ __forceinline__ void a_ready(const Unit&) const {}
    __device__ __forceinline__ void done(const Unit&) const {}
};

__device__ __forceinline__ unsigned cvt_pk_bf16(float lo, float hi) { unsigned r; asm volatile("v_cvt_pk_bf16_f32 %0, %1, %2" : "=v"(r) : "v"(lo), "v"(hi)); return r; }
typedef float f32x2 __attribute__((ext_vector_type(2)));
template <class Epi, class Sched, bool ALIGN_EPI = false, bool SP2 = false>
__device__ __forceinline__ void gemm_phase(PG8_LAS unsigned char* lds, const Gemm g, const Sched& S, const Epi& E) {
    int tid_o = threadIdx.x; asm volatile("" : "+v"(tid_o));
    const int tid = tid_o, wid = __builtin_amdgcn_readfirstlane(tid >> 6), lane = tid & 63, wr = wid >> 2, wc = wid & 3, fr = lane & 15, fq = lane >> 4;
    const int K = g.K, nt = K / BK;
    unsigned voffA[2], voffB[2];
#pragma unroll
    for (int i = 0; i < 2; ++i) { int R, C; stage_rc(tid * 16 + i * 8192, R, C); const int Rb = Epi::PERM ? ((R & ~31) + perm32(R & 31)) : R;
        voffA[i] = (unsigned)(R * K + C) * 2u; voffB[i] = (unsigned)(Rb * K + C) * 2u; }
    const size_t kstep = (size_t)(BK * 2);
    const size_t hstep = (size_t)HALF * K * 2;
    const size_t tstep = 2 * hstep;
    const unsigned ldsw = (unsigned)wid * 1024u;
    const int aoff = lds_byte(wr * 64 + fr, fq * 8), boff = lds_byte(wc * 32 + fr, fq * 8);
#define PG8_SA(b, h) (((b) * 2 + (h)) * HTB)
#define PG8_SB(b, h) ((4 + (b) * 2 + (h)) * HTB)
#define PG8_STAGE(bufoff, gbase, voff) do { _Pragma("unroll") for (int _i = 0; _i < 2; ++_i) \
        __builtin_amdgcn_global_load_lds((const unsigned*)((const char*)(gbase) + (voff)[_i]), (PG8_LAS unsigned*)(lds + (bufoff) + ldsw + _i * 8192), 16, 0, 0); } while (0)
#define PG8_LDA(dst, b, h) do { _Pragma("unroll") for (int m = 0; m < 4; ++m) _Pragma("unroll") for (int k = 0; k < 2; ++k) dst[m][k] = *(const PG8_LAS bf16x8*)(lds + PG8_SA(b, h) + aoff + m * 2048 + k * 1024); } while (0)
#define PG8_LDB(dst, b, h) do { _Pragma("unroll") for (int n = 0; n < 2; ++n) _Pragma("unroll") for (int k = 0; k < 2; ++k) dst[n][k] = *(const PG8_LAS bf16x8*)(lds + PG8_SB(b, h) + boff + n * 2048 + k * 1024); } while (0)
#define PG8_MMA(ai, bj, At, Bt) do { __builtin_amdgcn_s_setprio(1); _Pragma("unroll") for (int m = 0; m < 4; ++m) _Pragma("unroll") for (int n = 0; n < 2; ++n) _Pragma("unroll") for (int k = 0; k < 2; ++k) \
        acc[ai][bj][m][n] = __builtin_amdgcn_mfma_f32_16x16x32_bf16(Bt[n][k], At[m][k], acc[ai][bj][m][n], 0, 0, 0); __builtin_amdgcn_s_setprio(0); } while (0)
#define PG8_WAIT_V(n) asm volatile("s_waitcnt vmcnt(" #n ")" ::: "memory")
#define PG8_WAIT_L(n) asm volatile("s_waitcnt lgkmcnt(" #n ")" ::: "memory")
#define PG8_BAR __builtin_amdgcn_s_barrier()
#define PG8_SCHED __builtin_amdgcn_sched_barrier(0)
    Unit cur, nxt; int ui = 0;
    if (!S.next(0, cur)) return;
    f32x4 acc[2][2][4][2];
#pragma unroll
    for (int a = 0; a < 2; ++a)
#pragma unroll
        for (int b = 0; b < 2; ++b)
#pragma unroll
            for (int m = 0; m < 4; ++m)
#pragma unroll
                for (int n = 0; n < 2; ++n) acc[a][b][m][n] = (f32x4){0.f, 0.f, 0.f, 0.f};
    bf16x8 At[4][2], B0[2][2], B1[2][2];
    const char* cA = (const char*)g.A + (size_t)cur.pm * tstep; const char* cB = (const char*)g.Bt + (size_t)cur.pn * tstep;
    S.a_ready(cur);
    if constexpr (SP2) {
        PG8_STAGE(PG8_SB(0, 0), cB, voffB); PG8_STAGE(PG8_SB(0, 1), cB + hstep, voffB); PG8_STAGE(PG8_SA(0, 0), cA, voffA); PG8_STAGE(PG8_SA(0, 1), cA + hstep, voffA);
        if (wr == 1) PG8_BAR;
        PG8_WAIT_V(2); PG8_BAR;
        PG8_STAGE(PG8_SB(1, 0), cB + kstep, voffB); PG8_STAGE(PG8_SA(1, 0), cA + kstep, voffA); PG8_STAGE(PG8_SB(1, 1), cB + hstep + kstep, voffB);
        PG8_WAIT_V(6); PG8_BAR;
    } else {
        PG8_STAGE(PG8_SB(0, 0), cB, voffB); PG8_STAGE(PG8_SA(0, 0), cA, voffA); PG8_STAGE(PG8_SB(0, 1), cB + hstep, voffB); PG8_STAGE(PG8_SA(0, 1), cA + hstep, voffA);
        if (wr == 1) PG8_BAR;
        PG8_WAIT_V(4); PG8_BAR;
        PG8_STAGE(PG8_SB(1, 0), cB + kstep, voffB); PG8_STAGE(PG8_SA(1, 0), cA + kstep, voffA); PG8_STAGE(PG8_SB(1, 1), cB + hstep + kstep, voffB);
        PG8_WAIT_V(6); PG8_BAR;
    }
    for (;;) {
        const bool has_next = S.next(ui + 1, nxt);
        const char* nA = has_next ? (const char*)g.A + (size_t)nxt.pm * tstep : cA; const char* nB = has_next ? (const char*)g.Bt + (size_t)nxt.pn * tstep : cB;
        for (int t = 0; t < nt; t += 2) {
            const bool last = (t == nt - 2);
            const char* a1 = cA + (size_t)(t + 1) * kstep;
            const char* a2 = last ? nA : cA + (size_t)(t + 2) * kstep; const char* b2 = last ? nB : cB + (size_t)(t + 2) * kstep;
            const char* a3 = a2 + kstep; const char* b3 = b2 + kstep;
            if (last && has_next) S.a_ready(nxt);
            if constexpr (SP2) {
            PG8_LDB(B0, 0, 0); PG8_LDB(B1, 0, 1); PG8_SCHED; PG8_LDA(At, 0, 0); PG8_STAGE(PG8_SA(1, 1), a1 + hstep, voffA);
            PG8_WAIT_V(8); PG8_WAIT_L(0); PG8_BAR; PG8_MMA(0, 0, At, B0); PG8_MMA(0, 1, At, B1); PG8_BAR; PG8_SCHED;
            PG8_LDA(At, 0, 1); PG8_STAGE(PG8_SB(0, 0), b2, voffB); PG8_STAGE(PG8_SB(0, 1), b2 + hstep, voffB); PG8_STAGE(PG8_SA(0, 0), a2, voffA);
            PG8_WAIT_V(8); PG8_WAIT_L(0); PG8_BAR; PG8_MMA(1, 0, At, B0); PG8_MMA(1, 1, At, B1); PG8_BAR; PG8_SCHED;
            PG8_LDB(B0, 1, 0); PG8_LDB(B1, 1, 1); PG8_SCHED; PG8_LDA(At, 1, 0); PG8_STAGE(PG8_SA(0, 1), a2 + hstep, voffA);
            PG8_WAIT_V(8); PG8_WAIT_L(0); PG8_BAR; PG8_MMA(0, 0, At, B0); PG8_MMA(0, 1, At, B1); PG8_BAR; PG8_SCHED;
            PG8_LDA(At, 1, 1); PG8_STAGE(PG8_SB(1, 0), b3, voffB); PG8_STAGE(PG8_SB(1, 1), b3 + hstep, voffB); PG8_STAGE(PG8_SA(1, 0), a3, voffA);
            PG8_WAIT_V(8); PG8_WAIT_L(0); PG8_BAR; PG8_MMA(1, 0, At, B0); PG8_MMA(1, 1, At, B1); PG8_BAR; PG8_SCHED;
            } else {
            PG8_LDB(B0, 0, 0); PG8_SCHED; PG8_LDA(At, 0, 0); PG8_STAGE(PG8_SA(1, 1), a1 + hstep, voffA);
            PG8_WAIT_L(8); PG8_BAR; PG8_WAIT_L(0); PG8_MMA(0, 0, At, B0); PG8_BAR; PG8_SCHED;
            PG8_LDB(B1, 0, 1); PG8_STAGE(PG8_SB(0, 0), b2, voffB);
            PG8_BAR; PG8_WAIT_L(0); PG8_MMA(0, 1, At, B1); PG8_BAR;
            PG8_LDA(At, 0, 1); PG8_STAGE(PG8_SA(0, 0), a2, voffA);
            PG8_BAR; PG8_WAIT_L(0); PG8_MMA(1, 0, At, B0); PG8_BAR; PG8_SCHED;
            PG8_STAGE(PG8_SB(0, 1), b2 + hstep, voffB);
            PG8_WAIT_V(6); PG8_BAR; PG8_MMA(1, 1, At, B1); PG8_BAR;
            PG8_LDB(B0, 1, 0); PG8_SCHED; PG8_LDA(At, 1, 0); PG8_STAGE(PG8_SA(0, 1), a2 + hstep, voffA);
            PG8_WAIT_L(8); PG8_BAR; PG8_WAIT_L(0); PG8_MMA(0, 0, At, B0); PG8_BAR; PG8_SCHED;
            PG8_LDB(B1, 1, 1); PG8_STAGE(PG8_SB(1, 0), b3, voffB);
            PG8_BAR; PG8_WAIT_L(0); PG8_MMA(0, 1, At, B1); PG8_BAR;
            PG8_LDA(At, 1, 1); PG8_STAGE(PG8_SA(1, 0), a3, voffA);
            PG8_BAR; PG8_WAIT_L(0); PG8_MMA(1, 0, At, B0); PG8_BAR; PG8_SCHED;
            PG8_STAGE(PG8_SB(1, 1), b3 + hstep, voffB);
            PG8_WAIT_V(6); PG8_BAR; PG8_MMA(1, 1, At, B1); PG8_BAR;
            }
        }
        if constexpr (ALIGN_EPI) { if (wr == 0) PG8_BAR; }
        if constexpr (!Epi::AFTER_DRAIN) { E(acc, cur, wr, wc, fr, fq); S.done(cur); }
        if (!has_next) break;
#pragma unroll
        for (int a = 0; a < 2; ++a)
#pragma unroll
            for (int b = 0; b < 2; ++b)
#pragma unroll
                for (int m = 0; m < 4; ++m)
#pragma unroll
                    for (int n = 0; n < 2; ++n) acc[a][b][m][n] = (f32x4){0.f, 0.f, 0.f, 0.f};
        cur = nxt; cA = nA; cB = nB; ++ui;
        if constexpr (ALIGN_EPI) { if (wr == 1) PG8_BAR; }
    }
    PG8_WAIT_V(0);
    if constexpr (!ALIGN_EPI) { if (wr == 0) PG8_BAR; }
    PG8_BAR;
    if constexpr (Epi::AFTER_DRAIN) { E.fused(acc, cur, wr, wc, fr, fq, lds, wid, lane); S.done(cur); }
#undef PG8_SA
#undef PG8_SB
#undef PG8_STAGE
#undef PG8_LDA
#undef PG8_LDB
#undef PG8_MMA
#undef PG8_WAIT_V
#undef PG8_WAIT_L
#undef PG8_BAR
#undef PG8_SCHED
}
}
#define LAS __attribute__((address_space(3)))
typedef unsigned short bf16_t;
typedef short bf16x8 __attribute__((ext_vector_type(8)));
typedef float f32x4 __attribute__((ext_vector_type(4)));
typedef float f32x16 __attribute__((ext_vector_type(16)));
typedef unsigned u32x4 __attribute__((ext_vector_type(4)));
typedef unsigned u32x2 __attribute__((ext_vector_type(2)));
constexpr int T_ = 16384, D_ = 1024, S_ = 2048, NH = 8, DFF = 2816, DIN = 3080, NMOD = 6144, HALFC = 1408;
constexpr float EPS = 1e-6f;
constexpr float LOG2E = 1.4426950408889634f;
constexpr float C2 = 0.125f * LOG2E;
constexpr size_t MiB = 1u << 20;
constexpr size_t WS_MOD = 0, WS_BIAS2 = 256 * 1024, WS_ROWSS = 31 * MiB, WS_BAR = 640 * 1024, WS_LOGF = 1 * MiB, WS_QAUG = 2 * MiB, WS_KAUG = 4 * MiB,
    WS_WIN = 6 * MiB, WS_WOUT = 12 * MiB, WS_WUP = 14 * MiB, WS_WDOWN = 25 * MiB, WS_H = 32 * MiB, WS_Q = 64 * MiB, WS_K = 80 * MiB,
    WS_VT = 96 * MiB, WS_Z = 112 * MiB, WS_BG = 128 * MiB, WS_MIX = 144 * MiB, WS_U = 64 * MiB, WS_ACT = 160 * MiB;
constexpr int LDS_BYTES = 132096;

struct Params {
    const float *x, *c, *w_ada, *b_ada, *n1g, *w_in, *b_f, *qg, *kg, *cmw, *w_out, *n2g, *w_up, *fcw, *w_down;
    float* out; unsigned char* ws;
};

__device__ __forceinline__ float wave_sum(float v) {
#pragma unroll
    for (int o = 1; o < 64; o <<= 1) v += __shfl_xor(v, o);
    return v;
}
__device__ __forceinline__ unsigned f2bf(float f) { unsigned u = __builtin_bit_cast(unsigned, f); return (u + 0x7fffu + ((u >> 16) & 1u)) >> 16; }
__device__ __forceinline__ float bf2f(unsigned h) { return __builtin_bit_cast(float, h << 16); }
__device__ __forceinline__ unsigned pk2(float lo, float hi) { return pg8::cvt_pk_bf16(lo, hi); }
typedef float f32x2_t __attribute__((ext_vector_type(2))); typedef __bf16 bf16x2_t __attribute__((ext_vector_type(2)));
__device__ __forceinline__ unsigned cvtpk_s(float lo, float hi) { f32x2_t v = {lo, hi}; bf16x2_t b = __builtin_convertvector(v, bf16x2_t); return __builtin_bit_cast(unsigned, b); }
__device__ __forceinline__ void unpack8(u32x4 w, float (&f)[8]) {
    f[0] = bf2f(w.x & 0xffffu); f[1] = __builtin_bit_cast(float, w.x & 0xffff0000u);
    f[2] = bf2f(w.y & 0xffffu); f[3] = __builtin_bit_cast(float, w.y & 0xffff0000u);
    f[4] = bf2f(w.z & 0xffffu); f[5] = __builtin_bit_cast(float, w.z & 0xffff0000u);
    f[6] = bf2f(w.w & 0xffffu); f[7] = __builtin_bit_cast(float, w.w & 0xffff0000u);
}
__device__ __forceinline__ u32x4 pack8(const float (&f)[8]) { u32x4 w; w.x = pk2(f[0], f[1]); w.y = pk2(f[2], f[3]); w.z = pk2(f[4], f[5]); w.w = pk2(f[6], f[7]); return w; }

__device__ __forceinline__ void transpose_item(const float* W, int N, int K, bf16_t* WT, int dstrow0, int srccol0, int k0, LAS float* scr, int lane) {
#pragma unroll 8
    for (int i = 0; i < 32; ++i) { const int kk = 2 * i + (lane >> 5); scr[kk * 33 + (lane & 31)] = W[(size_t)(k0 + kk) * N + srccol0 + (lane & 31)]; }
    asm volatile("s_waitcnt lgkmcnt(0)" ::: "memory");
    const int c = lane & 7;
#pragma unroll
    for (int j = 0; j < 4; ++j) { const int n = (lane >> 3) + 8 * j; const LAS float* s = scr + (8 * c) * 33 + n;
        u32x4 o; o.x = pk2(s[0 * 33], s[1 * 33]); o.y = pk2(s[2 * 33], s[3 * 33]); o.z = pk2(s[4 * 33], s[5 * 33]); o.w = pk2(s[6 * 33], s[7 * 33]);
        *(u32x4*)(WT + (size_t)(dstrow0 + n) * K + k0 + 8 * c) = o; }
    asm volatile("s_waitcnt lgkmcnt(0)" ::: "memory");
}
__device__ __forceinline__ int win_src(int p0) {
    const int pn = p0 >> 8, c = p0 & 255, bj = c >> 7, wc = (c & 127) >> 5;
    if (pn < 6) return (pn >> 1) * 512 + (4 * (pn & 1) + wc) * 64 + 32 * bj;
    if (pn < 10) return (bj == 0 ? 1544 : 2568) + 128 * (pn - 6) + (c & 127);
    return 2056 + 256 * (pn - 10) + c;
}
__device__ __forceinline__ int wup_src(int p0) { const int j = p0 >> 8, c = p0 & 255; return (c < 128) ? 128 * j + c : DFF + 128 * j + (c - 128); }

__device__ __forceinline__ void gemv_item(const float* W, int N, int n0, const float* bias, const LAS float* vecs, LAS float* red, float* out, int tid) {
    const int cgp = tid & 15, kg = tid >> 4;
    float acc[8][4];
#pragma unroll
    for (int b = 0; b < 8; ++b)
#pragma unroll
        for (int j = 0; j < 4; ++j) acc[b][j] = 0.f;
#pragma unroll 4
    for (int i = 0; i < 32; ++i) { const int k = kg + 32 * i; const f32x4 w = *(const f32x4*)(W + (size_t)k * N + n0 + 4 * cgp);
#pragma unroll
        for (int b = 0; b < 8; ++b) { const float v = vecs[b * 1024 + k]; acc[b][0] += v * w.x; acc[b][1] += v * w.y; acc[b][2] += v * w.z; acc[b][3] += v * w.w; } }
#pragma unroll
    for (int b = 0; b < 8; ++b) *(LAS f32x4*)(red + (kg * 8 + b) * 64 + 4 * cgp) = (f32x4){acc[b][0], acc[b][1], acc[b][2], acc[b][3]};
    __syncthreads();
    { const int b = tid >> 6, col = tid & 63; float s = 0.f;
#pragma unroll 8
      for (int g = 0; g < 32; ++g) s += red[(g * 8 + b) * 64 + col];
      out[(size_t)b * N + n0 + col] = s + (bias ? bias[n0 + col] : 0.f); }
    __syncthreads();
}

__device__ __forceinline__ void phase0(const Params& p, LAS unsigned char* lds, int tid, int lane, int wave) {
    float* mod = (float*)(p.ws + WS_MOD);
    if (blockIdx.x < 96) {
        LAS float* vecs = (LAS float*)lds; LAS float* red = (LAS float*)(lds + 32768);
        for (int i = tid; i < 8192; i += 512) { const float v = p.c[i]; vecs[i] = v / (1.f + __expf(-v)); }
        __syncthreads();
        gemv_item(p.w_ada, NMOD, 64 * blockIdx.x, p.b_ada, vecs, red, mod, tid);
    }
    LAS float* scr = (LAS float*)(lds + wave * 8704);
    constexpr int I_IN = 16 * 96, I_OUT = 16 * 32, I_UP = 16 * 176, I_DN = 44 * 32, NIT = I_IN + I_OUT + I_UP + I_DN;
    const int gw = blockIdx.x * 8 + wave, NGW = gridDim.x * 8;
    for (int it = gw; it < NIT; it += NGW) {
        int r = it;
        if (r < I_IN) { const int kb = r / 96, nb = r % 96; transpose_item(p.w_in, DIN, 1024, (bf16_t*)(p.ws + WS_WIN), 32 * nb, win_src(32 * nb), 64 * kb, scr, lane); continue; } r -= I_IN;
        if (r < I_OUT) { const int kb = r / 32, nb = r % 32; transpose_item(p.w_out, 1024, 1024, (bf16_t*)(p.ws + WS_WOUT), 32 * nb, 32 * nb, 64 * kb, scr, lane); continue; } r -= I_OUT;
        if (r < I_UP) { const int kb = r / 176, nb = r % 176; transpose_item(p.w_up, 2 * DFF, 1024, (bf16_t*)(p.ws + WS_WUP), 32 * nb, wup_src(32 * nb), 64 * kb, scr, lane); continue; } r -= I_UP;
        { const int kb = r / 32, nb = r % 32; transpose_item(p.w_down, 1024, DFF, (bf16_t*)(p.ws + WS_WDOWN), 32 * nb, 32 * nb, 64 * kb, scr, lane); }
    }
}

__device__ __forceinline__ void phase1(const Params& p, LAS unsigned char* lds, int tid, int lane, int wave) {
    const float* mod = (const float*)(p.ws + WS_MOD);
    if (blockIdx.x < 88) {
        LAS float* vecs = (LAS float*)lds; LAS float* red = (LAS float*)(lds + 32768);
        for (int i = tid; i < 8192; i += 512) vecs[i] = mod[(i >> 10) * NMOD + 3072 + (i & 1023)];
        __syncthreads();
        gemv_item(p.w_up, 2 * DFF, 64 * blockIdx.x, nullptr, vecs, red, (float*)(p.ws + WS_BIAS2), tid);
    }
    LAS float* wf = (LAS float*)lds;
    for (int i = tid; i < 8192; i += 512) { const int k = i >> 3, h = i & 7; wf[h * 1024 + k] = p.w_in[(size_t)k * DIN + 1536 + h]; }
    __syncthreads();
    bf16_t* hb = (bf16_t*)(p.ws + WS_H); float* logf = (float*)(p.ws + WS_LOGF);
    const int gw = blockIdx.x * 8 + wave, NGW = gridDim.x * 8;
    for (int row = gw; row < T_; row += NGW) {
        const int b = row >> 11; const float* xr = p.x + (size_t)row * D_; const float* mb = mod + b * NMOD;
        f32x4 v[4]; float ss = 0.f;
#pragma unroll
        for (int j = 0; j < 4; ++j) { v[j] = *(const f32x4*)(xr + 4 * lane + 256 * j); ss += (v[j].x * v[j].x + v[j].y * v[j].y) + (v[j].z * v[j].z + v[j].w * v[j].w); }
        const float rstd = rsqrtf(wave_sum(ss) * (1.f / D_) + EPS);
#pragma unroll
        for (int j = 0; j < 4; ++j) { const int col = 4 * lane + 256 * j;
            const f32x4 g = *(const f32x4*)(p.n1g + col), sc = *(const f32x4*)(mb + 1024 + col), sh = *(const f32x4*)(mb + col);
            v[j] = (v[j] * rstd) * g * (sc + 1.f) + sh;
            u32x2 w; w.x = pk2(v[j].x, v[j].y); w.y = pk2(v[j].z, v[j].w);
            *(u32x2*)(hb + (size_t)row * D_ + col) = w; }
        float fg[8];
#pragma unroll
        for (int h = 0; h < 8; ++h) { float s = 0.f;
#pragma unroll
            for (int j = 0; j < 4; ++j) { const f32x4 w = *(const LAS f32x4*)(wf + h * 1024 + 4 * lane + 256 * j); s += (v[j].x * w.x + v[j].y * w.y) + (v[j].z * w.z + v[j].w * w.w); }
            fg[h] = wave_sum(s); }
        float z = fg[0];
#pragma unroll
        for (int h = 1; h < 8; ++h) z = (lane == h) ? fg[h] : z;
        if (lane < 8) { z += p.b_f[lane]; logf[(size_t)row * 8 + lane] = fminf(z, 0.f) - log1pf(expf(-fabsf(z))); }
    }
    __syncthreads();
}

__device__ __forceinline__ void scan_item(const Params& p, LAS unsigned char* lds, int bh, int tid, int lane, int wave) {
    const float* logf = (const float*)(p.ws + WS_LOGF); const int b = bh >> 3, h = bh & 7;
    LAS float* wt = (LAS float*)lds;
    float a[4];
#pragma unroll
    for (int i = 0; i < 4; ++i) a[i] = logf[((size_t)(b * S_ + 4 * tid + i)) * 8 + h];
    a[1] += a[0]; a[2] += a[1]; a[3] += a[2];
    float sc = a[3];
#pragma unroll
    for (int o = 1; o < 64; o <<= 1) { const float y = __shfl_up(sc, o); if (lane >= o) sc += y; }
    if (lane == 63) wt[wave] = sc;
    __syncthreads();
    float off = sc - a[3];
    for (int w = 0; w < wave; ++w) off += wt[w];
    u32x4* qa = (u32x4*)(p.ws + WS_QAUG) + (size_t)bh * S_ + 4 * tid; u32x4* ka = (u32x4*)(p.ws + WS_KAUG) + (size_t)bh * S_ + 4 * tid;
#pragma unroll
    for (int i = 0; i < 4; ++i) { const float F = (off + a[i]) * LOG2E;
        const unsigned hi = f2bf(F); const float r1 = F - bf2f(hi); const unsigned mid = f2bf(r1); const float r2 = r1 - bf2f(mid); const unsigned lo = f2bf(r2);
        u32x4 q, k; q.x = hi | (mid << 16); q.y = lo | (0x3F80u << 16); q.z = 0x3F803F80u; q.w = 0u;
        k.x = 0x3F803F80u; k.y = 0x3F80u | ((hi ^ 0x8000u) << 16); k.z = (mid ^ 0x8000u) | ((lo ^ 0x8000u) << 16); k.w = 0u;
        qa[i] = q; ka[i] = k; }
    __syncthreads();
}
struct EpiIn {
    static constexpr bool PERM = true, AFTER_DRAIN = false;
    bf16_t *Q, *K, *Vt, *Z, *BG; const float *qg, *kg;
    __device__ __forceinline__ void operator()(const f32x4 (&acc)[2][2][4][2], const pg8::Unit& u, int wr, int wc, int fr, int fq) const {
        const int pn = u.pn; const int row0 = u.pm * 256 + wr * 64 + fr;
        if (pn < 4) {
            const bool isq = pn < 2; const float* g = isq ? qg : kg; bf16_t* dst = isq ? Q : K; const int head = 4 * (pn & 1) + wc; const float mul = isq ? C2 : 1.f;
            f32x4 gv[2][2];
#pragma unroll
            for (int bj = 0; bj < 2; ++bj)
#pragma unroll
                for (int n = 0; n < 2; ++n) gv[bj][n] = *(const f32x4*)(g + 32 * bj + 8 * fq + 4 * n) * mul;
#pragma unroll
            for (int ai = 0; ai < 2; ++ai)
#pragma unroll
                for (int m = 0; m < 4; ++m) {
                    float ss = 0.f;
#pragma unroll
                    for (int bj = 0; bj < 2; ++bj)
#pragma unroll
                        for (int n = 0; n < 2; ++n) { const f32x4 a = acc[ai][bj][m][n]; ss += (a.x * a.x + a.y * a.y) + (a.z * a.z + a.w * a.w); }
                    ss += __shfl_xor(ss, 16); ss += __shfl_xor(ss, 32);
                    const float rinv = rsqrtf(ss * (1.f / 64.f) + EPS);
                    const unsigned row = (unsigned)(row0 + ai * 128 + m * 16);
#pragma unroll
                    for (int bj = 0; bj < 2; ++bj) { const f32x4 v0 = acc[ai][bj][m][0] * rinv * gv[bj][0], v1 = acc[ai][bj][m][1] * rinv * gv[bj][1];
                        u32x4 w; w.x = pk2(v0.x, v0.y); w.y = pk2(v0.z, v0.w); w.z = pk2(v1.x, v1.y); w.w = pk2(v1.z, v1.w);
                        *(u32x4*)(dst + row * 512 + head * 64 + 32 * bj + 8 * fq) = w; }
                }
        } else if (pn < 6) {
            const int head = 4 * (pn & 1) + wc, b = u.pm >> 3;
            bf16_t* vb = Vt + (size_t)((b * 8 + head) * 64) * S_;
#pragma unroll
            for (int ai = 0; ai < 2; ++ai)
#pragma unroll
                for (int m = 0; m < 4; ++m) { const int t = (row0 + ai * 128 + m * 16) & (S_ - 1);
                    const int tp = (t & ~15) | (((t >> 2) & 1) << 3) | (((t >> 3) & 1) << 2) | (t & 3);
#pragma unroll
                    for (int bj = 0; bj < 2; ++bj)
#pragma unroll
                        for (int n = 0; n < 2; ++n) { const f32x4 a = acc[ai][bj][m][n]; const int d = 32 * bj + 8 * fq + 4 * n;
                            vb[(unsigned)((d + 0) * S_ + tp)] = (bf16_t)f2bf(a.x); vb[(unsigned)((d + 1) * S_ + tp)] = (bf16_t)f2bf(a.y);
                            vb[(unsigned)((d + 2) * S_ + tp)] = (bf16_t)f2bf(a.z); vb[(unsigned)((d + 3) * S_ + tp)] = (bf16_t)f2bf(a.w); }
                }
        } else if (pn < 10) {
            const int ch0 = 128 * (pn - 6) + 32 * wc + 8 * fq;
#pragma unroll
            for (int ai = 0; ai < 2; ++ai)
#pragma unroll
                for (int m = 0; m < 4; ++m) { const unsigned row = (unsigned)(row0 + ai * 128 + m * 16);
                    const f32x4 v0 = acc[ai][0][m][0] * acc[ai][1][m][0], v1 = acc[ai][0][m][1] * acc[ai][1][m][1];
                    u32x4 w; w.x = pk2(v0.x, v0.y); w.y = pk2(v0.z, v0.w); w.z = pk2(v1.x, v1.y); w.w = pk2(v1.z, v1.w);
                    *(u32x4*)(Z + row * 512 + ch0) = w; }
        } else {
#pragma unroll
            for (int ai = 0; ai < 2; ++ai)
#pragma unroll
                for (int m = 0; m < 4; ++m) { const unsigned row = (unsigned)(row0 + ai * 128 + m * 16);
#pragma unroll
                    for (int bj = 0; bj < 2; ++bj) { const f32x4 v0 = acc[ai][bj][m][0], v1 = acc[ai][bj][m][1];
                        u32x4 w; w.x = pk2(v0.x, v0.y); w.y = pk2(v0.z, v0.w); w.z = pk2(v1.x, v1.y); w.w = pk2(v1.z, v1.w);
                        *(u32x4*)(BG + row * 512 + 256 * (pn - 10) + 128 * bj + 32 * wc + 8 * fq) = w; } }
        }
    }
};
struct EpiOut {
    static constexpr bool PERM = true, AFTER_DRAIN = false;
    const float* x; const float* mod; const float* n2g; float* out; bf16_t* A2; float* rowss;
    __device__ __forceinline__ void operator()(const f32x4 (&acc)[2][2][4][2], const pg8::Unit& u, int wr, int wc, int fr, int fq) const {
        const int b = u.pm >> 3, colb = u.pn * 256 + wc * 32 + 8 * fq; const int row0 = u.pm * 256 + wr * 64 + fr;
        const float* mb = mod + b * NMOD;
        f32x4 g1v[2][2], gm[2][2];
#pragma unroll
        for (int bj = 0; bj < 2; ++bj)
#pragma unroll
            for (int n = 0; n < 2; ++n) { const int col = colb + 128 * bj + 4 * n; g1v[bj][n] = *(const f32x4*)(mb + 2048 + col);
                gm[bj][n] = *(const f32x4*)(n2g + col) * (*(const f32x4*)(mb + 4096 + col) + 1.f); }
#pragma unroll
        for (int ai = 0; ai < 2; ++ai)
#pragma unroll
            for (int m = 0; m < 4; ++m) { const unsigned row = (unsigned)(row0 + ai * 128 + m * 16); float ss = 0.f;
#pragma unroll
                for (int bj = 0; bj < 2; ++bj) { f32x4 x1[2];
#pragma unroll
                    for (int n = 0; n < 2; ++n) { const unsigned off = row * D_ + colb + 128 * bj + 4 * n;
                        x1[n] = *(const f32x4*)(x + off) + g1v[bj][n] * acc[ai][bj][m][n]; *(f32x4*)(out + off) = x1[n];
                        ss += (x1[n].x * x1[n].x + x1[n].y * x1[n].y) + (x1[n].z * x1[n].z + x1[n].w * x1[n].w); x1[n] = x1[n] * gm[bj][n]; }
                    u32x4 w; w.x = pk2(x1[0].x, x1[0].y); w.y = pk2(x1[0].z, x1[0].w); w.z = pk2(x1[1].x, x1[1].y); w.w = pk2(x1[1].z, x1[1].w);
                    *(u32x4*)(A2 + row * D_ + colb + 128 * bj) = w; }
                ss += __shfl_xor(ss, 16); ss += __shfl_xor(ss, 32);
                if (fq == 0) rowss[row * 16 + u.pn * 4 + wc] = ss; }
    }
};
struct EpiUp {
    static constexpr bool PERM = true, AFTER_DRAIN = false;
    const float* rowss; const float* bias2; bf16_t* U; int half;
    __device__ __forceinline__ void operator()(const f32x4 (&acc)[2][2][4][2], const pg8::Unit& u, int wr, int wc, int fr, int fq) const {
        const int b = u.pm >> 3; const int row0 = u.pm * 256 + wr * 64 + fr;
        f32x4 bv[2][2];
#pragma unroll
        for (int bj = 0; bj < 2; ++bj)
#pragma unroll
            for (int n = 0; n < 2; ++n) bv[bj][n] = *(const f32x4*)(bias2 + b * (2 * DFF) + bj * DFF + half * HALFC + 128 * u.pn + 32 * wc + 8 * fq + 4 * n);
#pragma unroll
        for (int ai = 0; ai < 2; ++ai)
#pragma unroll
            for (int m = 0; m < 4; ++m) { const unsigned row = (unsigned)(row0 + ai * 128 + m * 16); const f32x4 s4 = *(const f32x4*)(rowss + row * 16 + 4 * fq); float sq = (s4.x + s4.y) + (s4.z + s4.w); sq += __shfl_xor(sq, 16); sq += __shfl_xor(sq, 32);
                const float rstd = rsqrtf(sq * (1.f / D_) + EPS);
#pragma unroll
                for (int bj = 0; bj < 2; ++bj) { const f32x4 v0 = acc[ai][bj][m][0] * rstd + bv[bj][0], v1 = acc[ai][bj][m][1] * rstd + bv[bj][1];
                    u32x4 w; w.x = pk2(v0.x, v0.y); w.y = pk2(v0.z, v0.w); w.z = pk2(v1.x, v1.y); w.w = pk2(v1.z, v1.w);
                    *(u32x4*)(U + (row * DFF + 256 * u.pn + 128 * bj + 32 * wc + 8 * fq)) = w; } }
    }
};
struct EpiDown {
    static constexpr bool PERM = true, AFTER_DRAIN = false;
    const float* mod; float* out;
    __device__ __forceinline__ void operator()(const f32x4 (&acc)[2][2][4][2], const pg8::Unit& u, int wr, int wc, int fr, int fq) const {
        const int b = u.pm >> 3, colb = u.pn * 256 + wc * 32 + 8 * fq; const int row0 = u.pm * 256 + wr * 64 + fr;
        const float* mb = mod + b * NMOD + 5120;
        f32x4 g2v[2][2];
#pragma unroll
        for (int bj = 0; bj < 2; ++bj)
#pragma unroll
            for (int n = 0; n < 2; ++n) g2v[bj][n] = *(const f32x4*)(mb + colb + 128 * bj + 4 * n);
#pragma unroll
        for (int ai = 0; ai < 2; ++ai)
#pragma unroll
            for (int m = 0; m < 4; ++m) { const unsigned row = (unsigned)(row0 + ai * 128 + m * 16);
#pragma unroll
                for (int bj = 0; bj < 2; ++bj)
#pragma unroll
                    for (int n = 0; n < 2; ++n) { float* q = out + row * D_ + colb + 128 * bj + 4 * n; *(f32x4*)q = *(const f32x4*)q + g2v[bj][n] * acc[ai][bj][m][n]; } }
    }
};

__device__ __forceinline__ int crow(int r, int hi) { return (r & 3) + 8 * (r >> 2) + 4 * hi; }
constexpr int AB_K = 0, AB_V = 9216, AB_A = 18432, ABUF = 19456, A_LW = 2 * ABUF;
__device__ __forceinline__ void attn_unit(const Params& p, LAS unsigned char* lds, int bh, int qb, float mshift, int tid, int lane, int wave) {
    const int r32 = lane & 31, hi = lane >> 5, b = bh >> 3, h = bh & 7;
    const bf16_t* Qg = (const bf16_t*)(p.ws + WS_Q); const bf16_t* Kg = (const bf16_t*)(p.ws + WS_K); const bf16_t* Vg = (const bf16_t*)(p.ws + WS_VT);
    const u32x4* qaug = (const u32x4*)(p.ws + WS_QAUG) + (size_t)bh * S_; const u32x4* kaug = (const u32x4*)(p.ws + WS_KAUG) + (size_t)bh * S_;
    bf16_t* mix = (bf16_t*)(p.ws + WS_MIX);
    const int q_rel = 32 * wave + r32, tq = 256 * qb + q_rel;
    bf16x8 qr[4], qa;
    { const bf16_t* qp = Qg + ((size_t)(b * S_ + tq)) * 512 + h * 64 + 8 * hi;
#pragma unroll
      for (int d0 = 0; d0 < 4; ++d0) qr[d0] = *(const bf16x8*)(qp + 16 * d0);
      u32x4 t = qaug[tq]; if (hi) t = (u32x4){0u, 0u, 0u, 0u}; qa = __builtin_bit_cast(bf16x8, t); }
    f32x16 o[2]; float lsum = 0.f;
#pragma unroll
    for (int i = 0; i < 16; ++i) { o[0][i] = 0.f; o[1][i] = 0.f; }
    const int NT = 4 * (qb + 1);
    const int srow = tid >> 3, sch = tid & 7;
    const bf16_t* kp = Kg + ((size_t)(b * S_ + srow)) * 512 + h * 64 + 8 * sch;
    const bf16_t* vp = Vg + ((size_t)(bh * 64 + srow)) * S_ + 8 * sch;
    u32x4 kreg = *(const u32x4*)kp, vreg = *(const u32x4*)vp, areg = (u32x4){0u, 0u, 0u, 0u};
    if (tid < 64) areg = kaug[tid];
    { LAS unsigned char* bb = lds; *(LAS u32x4*)(bb + AB_K + srow * 144 + sch * 16) = kreg; *(LAS u32x4*)(bb + AB_V + srow * 144 + sch * 16) = vreg; if (tid < 64) *(LAS u32x4*)(bb + AB_A + tid * 16) = areg; }
    __syncthreads();
    for (int j = 0; j < NT; ++j) {
        const bool more = (j + 1 < NT);
        if (more) { kreg = *(const u32x4*)(kp + (size_t)(j + 1) * 64 * 512); vreg = *(const u32x4*)(vp + (j + 1) * 64); if (tid < 64) areg = kaug[(j + 1) * 64 + tid]; }
        const LAS unsigned char* bb = lds + (j & 1) * ABUF;
        const int jb = j - 4 * qb;
#pragma unroll
        for (int kh = 0; kh < 2; ++kh) {
            if (jb >= 0 && 64 * jb + 32 * kh > 32 * wave + 31) continue;
            f32x16 C;
#pragma unroll
            for (int i = 0; i < 16; ++i) C[i] = -mshift;
            const LAS unsigned char* kr = bb + AB_K + (32 * kh + r32) * 144 + hi * 16;
#pragma unroll
            for (int d0 = 0; d0 < 4; ++d0) { const bf16x8 a = *(const LAS bf16x8*)(kr + d0 * 32); C = __builtin_amdgcn_mfma_f32_32x32x16_bf16(a, qr[d0], C, 0, 0, 0); }
            { u32x4 t = *(const LAS u32x4*)(bb + AB_A + (32 * kh + r32) * 16); if (hi) t = (u32x4){0u, 0u, 0u, 0u};
              C = __builtin_amdgcn_mfma_f32_32x32x16_bf16(__builtin_bit_cast(bf16x8, t), qa, C, 0, 0, 0); }
            if (jb >= 0) {
#pragma unroll
                for (int i = 0; i < 16; ++i) { const int kv = 64 * jb + 32 * kh + crow(i, hi); if (kv > q_rel) C[i] = -INFINITY; }
            }
#pragma unroll
            for (int i = 0; i < 16; ++i) { C[i] = __builtin_amdgcn_exp2f(C[i]); lsum += C[i]; }
#pragma unroll
            for (int s = 0; s < 2; ++s) {
                u32x4 pw; pw.x = cvtpk_s(C[8 * s + 0], C[8 * s + 1]); pw.y = cvtpk_s(C[8 * s + 2], C[8 * s + 3]); pw.z = cvtpk_s(C[8 * s + 4], C[8 * s + 5]); pw.w = cvtpk_s(C[8 * s + 6], C[8 * s + 7]);
                const bf16x8 pa = __builtin_bit_cast(bf16x8, pw);
#pragma unroll
                for (int dh = 0; dh < 2; ++dh) { const bf16x8 vf = *(const LAS bf16x8*)(bb + AB_V + (32 * dh + r32) * 144 + (32 * kh + 16 * s + 8 * hi) * 2);
                    o[dh] = __builtin_amdgcn_mfma_f32_32x32x16_bf16(pa, vf, o[dh], 0, 0, 0); }
            }
        }
        if (more) { LAS unsigned char* nb = lds + ((j + 1) & 1) * ABUF; *(LAS u32x4*)(nb + AB_K + srow * 144 + sch * 16) = kreg; *(LAS u32x4*)(nb + AB_V + srow * 144 + sch * 16) = vreg; if (tid < 64) *(LAS u32x4*)(nb + AB_A + tid * 16) = areg; }
        __syncthreads();
    }
    lsum += __shfl_xor(lsum, 32);
    LAS float* lw = (LAS float*)(lds + A_LW + wave * 128);
    if (hi == 0) lw[r32] = lsum;
    asm volatile("s_waitcnt lgkmcnt(0)" ::: "memory");
    bf16_t* op = mix + ((size_t)(b * S_ + 256 * qb + 32 * wave)) * D_ + h * 64 + r32;
#pragma unroll
    for (int i = 0; i < 16; ++i) { const int qq = crow(i, hi); const float rl = 1.f / lw[qq];
        op[(size_t)qq * D_] = (bf16_t)f2bf(o[0][i] * rl); op[(size_t)qq * D_ + 32] = (bf16_t)f2bf(o[1][i] * rl); }
    asm volatile("s_waitcnt lgkmcnt(0)" ::: "memory");
}

__device__ __forceinline__ void phase3(const Params& p, LAS unsigned char* lds, int tid, int lane, int wave) {
    float mq = 0.f, mk = 0.f;
    for (int i = 0; i < 64; ++i) { mq = fmaxf(mq, fabsf(p.qg[i])); mk = fmaxf(mk, fabsf(p.kg[i])); }
    const float mshift = 8.f * LOG2E * 1.03f * mq * mk;
    const int G = gridDim.x, bx = blockIdx.x; const int vcu = (G % 8 == 0) ? (bx % 8) * (G / 8) + bx / 8 : bx;
    for (int pr = vcu; pr < 256; pr += G) { const int bh = pr >> 2, s = pr & 3;
        attn_unit(p, lds, bh, 7 - s, mshift, tid, lane, wave);
        attn_unit(p, lds, bh, s, mshift, tid, lane, wave); }
    const bf16_t* Z = (const bf16_t*)(p.ws + WS_Z); const bf16_t* BG = (const bf16_t*)(p.ws + WS_BG); bf16_t* mix = (bf16_t*)(p.ws + WS_MIX);
    for (int it = bx * 512 + tid; it < (T_ / 8) * 64; it += G * 512) {
        const int rc = it >> 6, c0 = 8 * (it & 63), t0 = 8 * rc;
        float w0[8], w1[8], w2[8], z1[8], z2[8];
#pragma unroll
        for (int i = 0; i < 8; ++i) { w0[i] = p.cmw[c0 + i]; w1[i] = p.cmw[512 + c0 + i]; w2[i] = p.cmw[1024 + c0 + i]; z1[i] = 0.f; z2[i] = 0.f; }
        if (t0 & (S_ - 1)) { unpack8(*(const u32x4*)(Z + (size_t)(t0 - 2) * 512 + c0), z2); unpack8(*(const u32x4*)(Z + (size_t)(t0 - 1) * 512 + c0), z1); }
#pragma unroll
        for (int r = 0; r < 8; ++r) { float zc[8], bg[8], ov[8];
            unpack8(*(const u32x4*)(Z + (size_t)(t0 + r) * 512 + c0), zc); unpack8(*(const u32x4*)(BG + (size_t)(t0 + r) * 512 + c0), bg);
#pragma unroll
            for (int i = 0; i < 8; ++i) { ov[i] = bg[i] * (w0[i] * z2[i] + w1[i] * z1[i] + w2[i] * zc[i]); z2[i] = z1[i]; z1[i] = zc[i]; }
            *(u32x4*)(mix + (size_t)(t0 + r) * D_ + 512 + c0) = pack8(ov); }
    }
}

__device__ __forceinline__ void phase6(const Params& p, int half, int tid) {
    const bf16_t* U = (const bf16_t*)(p.ws + WS_U); bf16_t* act = (bf16_t*)(p.ws + WS_ACT);
    for (int it = blockIdx.x * 512 + tid; it < (T_ / 16) * 176; it += gridDim.x * 512) {
        const int rc = it / 176, cgp = it % 176, t0 = 16 * rc, cl0 = 8 * cgp, gcol = 256 * (cl0 >> 7) + (cl0 & 127), c = half * HALFC + cl0;
        float wg0[8], wg1[8], wg2[8], wv0[8], wv1[8], wv2[8], g1[8], g2[8], v1[8], v2[8];
#pragma unroll
        for (int i = 0; i < 8; ++i) { wg0[i] = p.fcw[c + i]; wg1[i] = p.fcw[2 * DFF + c + i]; wg2[i] = p.fcw[4 * DFF + c + i];
            wv0[i] = p.fcw[DFF + c + i]; wv1[i] = p.fcw[3 * DFF + c + i]; wv2[i] = p.fcw[5 * DFF + c + i]; g1[i] = g2[i] = v1[i] = v2[i] = 0.f; }
        if (t0 & (S_ - 1)) { unpack8(*(const u32x4*)(U + (size_t)(t0 - 2) * DFF + gcol), g2); unpack8(*(const u32x4*)(U + (size_t)(t0 - 1) * DFF + gcol), g1);
            unpack8(*(const u32x4*)(U + (size_t)(t0 - 2) * DFF + gcol + 128), v2); unpack8(*(const u32x4*)(U + (size_t)(t0 - 1) * DFF + gcol + 128), v1); }
#pragma unroll 4
        for (int r = 0; r < 16; ++r) { float gc[8], vc[8], ov[8];
            unpack8(*(const u32x4*)(U + (size_t)(t0 + r) * DFF + gcol), gc); unpack8(*(const u32x4*)(U + (size_t)(t0 + r) * DFF + gcol + 128), vc);
#pragma unroll
            for (int i = 0; i < 8; ++i) { const float ug = wg0[i] * g2[i] + wg1[i] * g1[i] + wg2[i] * gc[i], uv = wv0[i] * v2[i] + wv1[i] * v1[i] + wv2[i] * vc[i];
                ov[i] = ug / (1.f + __expf(-ug)) * uv; g2[i] = g1[i]; g1[i] = gc[i]; v2[i] = v1[i]; v1[i] = vc[i]; }
            *(u32x4*)(act + (size_t)(t0 + r) * DFF + c) = pack8(ov); }
    }
}

#define XB_TMO      128
#define XB_XCNT(j)  (256  + 64 * (j))
#define XB_XSUB(j)  (1280 + 64 * (j))
#define XB_XGEN(j)  (2304 + 64 * (j))
#define XB_TOP      3328
#define XB_TOPGEN   3392
#define XCD_BAR_WORDS 3456
#define XB_SPIN_CAP (1u << 18)

__device__ __forceinline__ unsigned xb_ld(unsigned* p)              { return __hip_atomic_load(p, __ATOMIC_RELAXED, __HIP_MEMORY_SCOPE_AGENT); }
__device__ __forceinline__ unsigned xb_add(unsigned* p, unsigned v) { return __hip_atomic_fetch_add(p, v, __ATOMIC_RELAXED, __HIP_MEMORY_SCOPE_AGENT); }
__device__ __forceinline__ unsigned xb_xcc_id() { return (unsigned)__builtin_amdgcn_s_getreg((3 << 11) | 20) & 0xFu; }
#define XB_SPIN(cond, bar) do { unsigned _sp = 0; while (cond) { __builtin_amdgcn_s_sleep(1); \
    if ((++_sp & 255u) == 0u) { if (xb_ld(&(bar)[XB_TMO])) break; if (_sp > XB_SPIN_CAP) { atomicAdd(&(bar)[XB_TMO], 1u); break; } } } } while (0)

struct XcdBarrier {
    unsigned* bar; unsigned x;
    volatile LAS unsigned* st;
};

__device__ __forceinline__ XcdBarrier xcd_barrier_post(unsigned* bar, volatile LAS unsigned* st) {
    XcdBarrier b; b.bar = bar; b.x = xb_xcc_id(); b.st = st;
    if (threadIdx.x == 0) (void)xb_add(&bar[XB_XCNT(b.x)], 1u);
    return b;
}
__device__ __forceinline__ void xcd_barrier_complete(unsigned* bar, unsigned x, unsigned& nloc, unsigned& nx) {
    const unsigned G = gridDim.x * gridDim.y * gridDim.z;
    unsigned sum, cnt, mine, sp = 0u;
    for (;;) {
        sum = 0u; cnt = 0u; mine = 0u;
#pragma unroll
        for (unsigned j = 0; j < 16; ++j) { const unsigned c = xb_ld(&bar[XB_XCNT(j)]); sum += c; cnt += (c > 0u) ? 1u : 0u; mine = (j == x) ? c : mine; }
        if (sum == G) break;
        __builtin_amdgcn_s_sleep(1);
        if ((++sp & 255u) == 0u) { if (xb_ld(&bar[XB_TMO])) break; if (sp > XB_SPIN_CAP) { atomicAdd(&bar[XB_TMO], 1u); break; } }
    }
    nloc = mine > 0u ? mine : 1u; nx = cnt > 0u ? cnt : 1u;
}

__device__ __forceinline__ void xcd_barrier(const XcdBarrier& b) {
    asm volatile("s_waitcnt vmcnt(0)" ::: "memory");
    __syncthreads();
    if (threadIdx.x == 0) {
        unsigned* bar = b.bar;
        __builtin_amdgcn_s_waitcnt(0);
        unsigned nloc = b.st[0], nx = b.st[1];
        if (nloc == 0u) { xcd_barrier_complete(bar, b.x, nloc, nx); b.st[0] = nloc; b.st[1] = nx; }
        const unsigned old = xb_add(&bar[XB_XSUB(b.x)], 1u);
        const unsigned gen = old / nloc;
        if (old + 1u == (gen + 1u) * nloc) {
            __builtin_amdgcn_fence(__ATOMIC_RELEASE, "agent");
            asm volatile("s_waitcnt vmcnt(0)" ::: "memory");
            const unsigned og = xb_add(&bar[XB_TOP], 1u);
            const unsigned tg = og / nx;
            if (og + 1u == (tg + 1u) * nx) xb_add(&bar[XB_TOPGEN], 1u);
            else XB_SPIN(xb_ld(&bar[XB_TOPGEN]) == tg, bar);
            __builtin_amdgcn_fence(__ATOMIC_ACQUIRE, "agent");
            xb_add(&bar[XB_XGEN(b.x)], 1u);
            asm volatile("s_waitcnt vmcnt(0)" ::: "memory");
        } else {
            XB_SPIN(xb_ld(&bar[XB_XGEN(b.x)]) == gen, bar);
            __builtin_amdgcn_fence(__ATOMIC_ACQUIRE, "agent");
            asm volatile("s_waitcnt vmcnt(0)" ::: "memory");
        }
    }
    __syncthreads();
}

__device__ __forceinline__ const void* ldarg(int byteoff) { const void* r;
    asm volatile("s_load_dwordx2 %0, %1, %2\n\ts_waitcnt lgkmcnt(0)" : "=s"(r) : "s"(__builtin_amdgcn_kernarg_segment_ptr()), "i"(byteoff) : "memory"); return r; }
#define LDA(i) ((const float*)ldarg(8 * (i)))
__device__ __forceinline__ Params load_params() { Params q;
    q.x = LDA(0); q.c = LDA(1); q.w_ada = LDA(2); q.b_ada = LDA(3); q.n1g = LDA(4); q.w_in = LDA(5); q.b_f = LDA(6); q.qg = LDA(7); q.kg = LDA(8); q.cmw = LDA(9);
    q.w_out = LDA(10); q.n2g = LDA(11); q.w_up = LDA(12); q.fcw = LDA(13); q.w_down = LDA(14); q.out = (float*)ldarg(8 * 15); q.ws = (unsigned char*)ldarg(8 * 16); return q; }
#ifndef PH
#define PH 255
#endif
#ifndef PROBE_DUP
#define PROBE_DUP 0
#endif
#ifndef LAST_PHASE
#define LAST_PHASE 99
#endif
__global__ void __launch_bounds__(512, 2) hymba_mega(Params p_arg) {
    extern __shared__ __attribute__((aligned(16))) unsigned char lds_raw[];
    cg::grid_group grid = cg::this_grid();
    LAS unsigned char* lds = (LAS unsigned char*)lds_raw;
    const int tid = threadIdx.x, lane = tid & 63, wave = __builtin_amdgcn_readfirstlane(tid >> 6);
    const int G = gridDim.x, bx = blockIdx.x;
    if (p_arg.ws == nullptr) grid.sync();
    if (tid < 2) ((volatile LAS unsigned*)(lds + 131072))[tid] = 0u;
    __syncthreads();
    const XcdBarrier xbar = xcd_barrier_post((unsigned*)((unsigned char*)ldarg(8 * 16) + WS_BAR), (volatile LAS unsigned*)(lds + 131072));
#define GSYNC() xcd_barrier(xbar)

#if PH & 1
    { const Params p = load_params(); phase0(p, lds, tid, lane, wave); }
#endif
    GSYNC();
#if PH & 2
    { const Params p = load_params(); phase1(p, lds, tid, lane, wave); }
#endif
    GSYNC();
#if PH & 4
    {
        const Params p = load_params();
        if (bx < 64) scan_item(p, lds, bx, tid, lane, wave);
        pg8::Gemm g{(const bf16_t*)(p.ws + WS_H), (const bf16_t*)(p.ws + WS_WIN), T_, 3072, 1024}; pg8::StaticOrder S; S.init(T_, 3072, G, bx);
        EpiIn E{(bf16_t*)(p.ws + WS_Q), (bf16_t*)(p.ws + WS_K), (bf16_t*)(p.ws + WS_VT), (bf16_t*)(p.ws + WS_Z), (bf16_t*)(p.ws + WS_BG), p.qg, p.kg};
        pg8::gemm_phase<EpiIn, pg8::StaticOrder, true, true>(lds, g, S, E);
    }
#endif
    GSYNC();
#if PH & 8
    { const Params p = load_params(); phase3(p, lds, tid, lane, wave); }
#endif
    GSYNC();
#if PH & 16
    {
        const Params p = load_params();
        pg8::Gemm g{(const bf16_t*)(p.ws + WS_MIX), (const bf16_t*)(p.ws + WS_WOUT), T_, 1024, 1024}; pg8::StaticOrder S; S.init(T_, 1024, G, bx);
        EpiOut E{p.x, (const float*)(p.ws + WS_MOD), p.n2g, p.out, (bf16_t*)(p.ws + WS_H), (float*)(p.ws + WS_ROWSS)};
        pg8::gemm_phase<EpiOut, pg8::StaticOrder, true, true>(lds, g, S, E);
    }
#endif
    for (int half = 0; half < 2; ++half) {
        GSYNC();
#if PH & 32
        {
            const Params p = load_params();
            pg8::Gemm g{(const bf16_t*)(p.ws + WS_H), (const bf16_t*)(p.ws + WS_WUP) + (size_t)half * DFF * 1024, T_, DFF, 1024}; pg8::StaticOrder S; S.init(T_, DFF, G, bx);
            EpiUp E{(const float*)(p.ws + WS_ROWSS), (const float*)(p.ws + WS_BIAS2), (bf16_t*)(p.ws + WS_U), half};
            pg8::gemm_phase<EpiUp, pg8::StaticOrder, true, true>(lds, g, S, E);
        }
#endif
        GSYNC();
#if PH & 64
        { const Params p = load_params(); phase6(p, half, tid); }
#endif
    }
    GSYNC();
#if PH & 128
    {
        const Params p = load_params();
        pg8::Gemm g{(const bf16_t*)(p.ws + WS_ACT), (const bf16_t*)(p.ws + WS_WDOWN), T_, 1024, DFF}; pg8::StaticOrder S; S.init(T_, 1024, G, bx);
        EpiDown E{(const float*)(p.ws + WS_MOD), p.out};
        pg8::gemm_phase<EpiDown, pg8::StaticOrder, true, true>(lds, g, S, E);
    }
#endif
}

extern "C" void kernel_launch(void* const* d_in, const int* in_sizes, int n_in, void* d_out, int out_size, void* d_ws, size_t ws_size, hipStream_t stream) {
    static int grid = 0;
    if (grid == 0) {
        int dev = 0, cus = 0, per_cu = 0;
        hipGetDevice(&dev); hipDeviceGetAttribute(&cus, hipDeviceAttributeMultiprocessorCount, dev);
        if (hipFuncSetAttribute((const void*)hymba_mega, hipFuncAttributeMaxDynamicSharedMemorySize, LDS_BYTES) != hipSuccess) fprintf(stderr, "hipFuncSetAttribute failed\n");
        if (hipOccupancyMaxActiveBlocksPerMultiprocessor(&per_cu, (const void*)hymba_mega, 512, LDS_BYTES) != hipSuccess || per_cu < 1) { fprintf(stderr, "occupancy query: %d\n", per_cu); per_cu = 1; }
        (void)hipGetLastError();
        grid = cus > 0 ? cus : 256;
    }
    Params p{};
    p.x = (const float*)d_in[0]; p.c = (const float*)d_in[1]; p.w_ada = (const float*)d_in[2]; p.b_ada = (const float*)d_in[3]; p.n1g = (const float*)d_in[4];
    p.w_in = (const float*)d_in[5]; p.b_f = (const float*)d_in[6]; p.qg = (const float*)d_in[7]; p.kg = (const float*)d_in[8]; p.cmw = (const float*)d_in[9];
    p.w_out = (const float*)d_in[10]; p.n2g = (const float*)d_in[11]; p.w_up = (const float*)d_in[12]; p.fcw = (const float*)d_in[13]; p.w_down = (const float*)d_in[14];
    p.out = (float*)d_out; p.ws = (unsigned char*)d_ws;
    (void)hipMemsetAsync((unsigned char*)d_ws + WS_BAR, 0, 16384, stream);
    void* args[] = {&p};
    hipError_t e = hipLaunchCooperativeKernel((const void*)hymba_mega, dim3(grid), dim3(512), args, LDS_BYTES, stream);
    if (e != hipSuccess) fprintf(stderr, "cooperative launch failed: %s (grid %d)\n", hipGetErrorString(e), grid);
}
```

```cpp
#include <hip/hip_runtime.h>
#include <hip/hip_cooperative_groups.h>
#include <cstdio>
#include <cstdint>
namespace cg = cooperative_groups;
namespace pg8 {
#define PG8_LAS __attribute__((address_space(3)))
typedef unsigned short bf16_t;
typedef short bf16x8 __attribute__((ext_vector_type(8)));
typedef float f32x4 __attribute__((ext_vector_type(4)));
typedef unsigned u32x4 __attribute__((ext_vector_type(4)));
constexpr int BM = 256, BK = 64, HALF = 128, HTB = HALF * BK * 2  , STAGE_BYTES = 8 * HTB, NXCD = 8, WGM = 8;

__host__ __device__ __forceinline__ int lds_byte(int r, int c) { const int st = (r >> 4) * 2 + (c >> 5), rr = r & 15, cc = c & 31, ob = rr * 64 + cc * 2; return st * 1024 + (ob ^ (((ob >> 9) & 1) << 5)); }
__host__ __device__ __forceinline__ void stage_rc(int b, int& R, int& C) { const int st = b / 1024, sb = b % 1024, swz = sb ^ (((sb >> 9) & 1) << 5); R = (st >> 1) * 16 + swz / 64; C = (st & 1) * 32 + (swz % 64) / 2; }
__host__ __device__ __forceinline__ int perm32(int rho) { const int n = rho >> 4, i = rho & 15; return 8 * (i >> 2) + 4 * n + (i & 3); }

struct Unit { int pm, pn; };
struct Gemm { const bf16_t* A; const bf16_t* Bt; int M, N, K; };

struct StaticOrder {
    int nM, nN, nwg, G, c;
    __host__ __device__ void init(int M, int N, int G_, int c_) { nM = M / BM; nN = N / BM; nwg = nM * nN; G = G_; c = c_; }
    __host__ __device__ bool next(int i, Unit& u) const {
        const long L = (long)i * G + c; if (L >= nwg) return false;
        int wgid = (int)L; { const int q = nwg / NXCD, r = nwg % NXCD, xcd = wgid % NXCD, off = wgid / NXCD; wgid = (xcd < r ? xcd * (q + 1) : r * (q + 1) + (xcd - r) * q) + off; }
        const int nig = WGM * nN, gid = wgid / nig, fm = gid * WGM, gsz = (nM - fm) < WGM ? (nM - fm) : WGM;
        u.pm = fm + ((wgid % nig) % gsz); u.pn = (wgid % nig) / gsz; return true;
    }
    __device__ __forceinline__ void a_ready(const Unit&) const {}
    __device__ __forceinline__ void done(const Unit&) const {}
    __device__ __forceinline__ long a_off(int pm, size_t tstep) const { return (long)pm * (long)tstep; }
};

__device__ __forceinline__ unsigned cvt_pk_bf16(float lo, float hi) { unsigned r; asm volatile("v_cvt_pk_bf16_f32 %0, %1, %2" : "=v"(r) : "v"(lo), "v"(hi)); return r; }
typedef float f32x2 __attribute__((ext_vector_type(2)));
template <class Epi, class Sched, bool ALIGN_EPI = false, bool SP2 = false>
__device__ __forceinline__ void gemm_phase(PG8_LAS unsigned char* lds, const Gemm g, const Sched& S, const Epi& E) {
    int tid_o = threadIdx.x; asm volatile("" : "+v"(tid_o));
    const int tid = tid_o & 511, wid = __builtin_amdgcn_readfirstlane(tid >> 6), lane = tid & 63, wr = wid >> 2, wc = wid & 3, fr = lane & 15, fq = lane >> 4;
    const int K = g.K, nt = K / BK;
    unsigned voffA[2], voffB[2];
#pragma unroll
    for (int i = 0; i < 2; ++i) { int R, C; stage_rc(tid * 16 + i * 8192, R, C); const int Rb = Epi::PERM ? ((R & ~31) + perm32(R & 31)) : R;
        voffA[i] = (unsigned)(R * K + C) * 2u; voffB[i] = (unsigned)(Rb * K + C) * 2u; }
    const size_t kstep = (size_t)(BK * 2);
    const size_t hstep = (size_t)HALF * K * 2;
    const size_t tstep = 2 * hstep;
    const unsigned ldsw = (unsigned)wid * 1024u;
    const int aoff = lds_byte(wr * 64 + fr, fq * 8), boff = lds_byte(wc * 32 + fr, fq * 8);
#define PG8_SA(b, h) (((b) * 2 + (h)) * HTB)
#define PG8_SB(b, h) ((4 + (b) * 2 + (h)) * HTB)
#define PG8_STAGE(bufoff, gbase, voff) do { _Pragma("unroll") for (int _i = 0; _i < 2; ++_i) \
        __builtin_amdgcn_global_load_lds((const unsigned*)((const char*)(gbase) + (voff)[_i]), (PG8_LAS unsigned*)(lds + (bufoff) + ldsw + _i * 8192), 16, 0, 0); } while (0)
#define PG8_LDA(dst, b, h) do { _Pragma("unroll") for (int m = 0; m < 4; ++m) _Pragma("unroll") for (int k = 0; k < 2; ++k) dst[m][k] = *(const PG8_LAS bf16x8*)(lds + PG8_SA(b, h) + aoff + m * 2048 + k * 1024); } while (0)
#define PG8_LDB(dst, b, h) do { _Pragma("unroll") for (int n = 0; n < 2; ++n) _Pragma("unroll") for (int k = 0; k < 2; ++k) dst[n][k] = *(const PG8_LAS bf16x8*)(lds + PG8_SB(b, h) + boff + n * 2048 + k * 1024); } while (0)
#define PG8_MMA(ai, bj, At, Bt) do { __builtin_amdgcn_s_setprio(1); _Pragma("unroll") for (int m = 0; m < 4; ++m) _Pragma("unroll") for (int n = 0; n < 2; ++n) _Pragma("unroll") for (int k = 0; k < 2; ++k) \
        acc[ai][bj][m][n] = __builtin_amdgcn_mfma_f32_16x16x32_bf16(Bt[n][k], At[m][k], acc[ai][bj][m][n], 0, 0, 0); __builtin_amdgcn_s_setprio(0); } while (0)
#define PG8_WAIT_V(n) asm volatile("s_waitcnt vmcnt(" #n ")" ::: "memory")
#define PG8_WAIT_L(n) asm volatile("s_waitcnt lgkmcnt(" #n ")" ::: "memory")
#define PG8_BAR __builtin_amdgcn_s_barrier()
#define PG8_SCHED __builtin_amdgcn_sched_barrier(0)
    Unit cur, nxt; int ui = 0;
    if (!S.next(0, cur)) return;
    f32x4 acc[2][2][4][2];
#pragma unroll
    for (int a = 0; a < 2; ++a)
#pragma unroll
        for (int b = 0; b < 2; ++b)
#pragma unroll
            for (int m = 0; m < 4; ++m)
#pragma unroll
                for (int n = 0; n < 2; ++n) acc[a][b][m][n] = (f32x4){0.f, 0.f, 0.f, 0.f};
    bf16x8 At[4][2], B0[2][2], B1[2][2];
    const char* cA = (const char*)g.A + S.a_off(cur.pm, tstep); const char* cB = (const char*)g.Bt + (size_t)cur.pn * tstep;
    S.a_ready(cur);
    if constexpr (SP2) {
        PG8_STAGE(PG8_SB(0, 0), cB, voffB); PG8_STAGE(PG8_SB(0, 1), cB + hstep, voffB); PG8_STAGE(PG8_SA(0, 0), cA, voffA); PG8_STAGE(PG8_SA(0, 1), cA + hstep, voffA);
        if (wr == 1) PG8_BAR;
        PG8_WAIT_V(2); PG8_BAR;
        PG8_STAGE(PG8_SB(1, 0), cB + kstep, voffB); PG8_STAGE(PG8_SA(1, 0), cA + kstep, voffA); PG8_STAGE(PG8_SB(1, 1), cB + hstep + kstep, voffB);
        PG8_WAIT_V(6); PG8_BAR;
    } else {
        PG8_STAGE(PG8_SB(0, 0), cB, voffB); PG8_STAGE(PG8_SA(0, 0), cA, voffA); PG8_STAGE(PG8_SB(0, 1), cB + hstep, voffB); PG8_STAGE(PG8_SA(0, 1), cA + hstep, voffA);
        if (wr == 1) PG8_BAR;
        PG8_WAIT_V(4); PG8_BAR;
        PG8_STAGE(PG8_SB(1, 0), cB + kstep, voffB); PG8_STAGE(PG8_SA(1, 0), cA + kstep, voffA); PG8_STAGE(PG8_SB(1, 1), cB + hstep + kstep, voffB);
        PG8_WAIT_V(6); PG8_BAR;
    }
    for (;;) {
        const bool has_next = S.next(ui + 1, nxt);
        const char* nA = has_next ? (const char*)g.A + S.a_off(nxt.pm, tstep) : cA; const char* nB = has_next ? (const char*)g.Bt + (size_t)nxt.pn * tstep : cB;
        for (int t = 0; t < nt; t += 2) {
            const bool last = (t == nt - 2);
            const char* a1 = cA + (size_t)(t + 1) * kstep;
            const char* a2 = last ? nA : cA + (size_t)(t + 2) * kstep; const char* b2 = last ? nB : cB + (size_t)(t + 2) * kstep;
            const char* a3 = a2 + kstep; const char* b3 = b2 + kstep;
            if (last && has_next) S.a_ready(nxt);
            if constexpr (SP2) {
            PG8_LDB(B0, 0, 0); PG8_LDB(B1, 0, 1); PG8_SCHED; PG8_LDA(At, 0, 0); PG8_STAGE(PG8_SA(1, 1), a1 + hstep, voffA);
            PG8_WAIT_V(8); PG8_WAIT_L(0); PG8_BAR; PG8_MMA(0, 0, At, B0); PG8_MMA(0, 1, At, B1); PG8_BAR; PG8_SCHED;
            PG8_LDA(At, 0, 1); PG8_STAGE(PG8_SB(0, 0), b2, voffB); PG8_STAGE(PG8_SB(0, 1), b2 + hstep, voffB); PG8_STAGE(PG8_SA(0, 0), a2, voffA);
            PG8_WAIT_V(8); PG8_WAIT_L(0); PG8_BAR; PG8_MMA(1, 0, At, B0); PG8_MMA(1, 1, At, B1); PG8_BAR; PG8_SCHED;
            PG8_LDB(B0, 1, 0); PG8_LDB(B1, 1, 1); PG8_SCHED; PG8_LDA(At, 1, 0); PG8_STAGE(PG8_SA(0, 1), a2 + hstep, voffA);
            PG8_WAIT_V(8); PG8_WAIT_L(0); PG8_BAR; PG8_MMA(0, 0, At, B0); PG8_MMA(0, 1, At, B1); PG8_BAR; PG8_SCHED;
            PG8_LDA(At, 1, 1); PG8_STAGE(PG8_SB(1, 0), b3, voffB); PG8_STAGE(PG8_SB(1, 1), b3 + hstep, voffB); PG8_STAGE(PG8_SA(1, 0), a3, voffA);
            PG8_WAIT_V(8); PG8_WAIT_L(0); PG8_BAR; PG8_MMA(1, 0, At, B0); PG8_MMA(1, 1, At, B1); PG8_BAR; PG8_SCHED;
            } else {
            PG8_LDB(B0, 0, 0); PG8_SCHED; PG8_LDA(At, 0, 0); PG8_STAGE(PG8_SA(1, 1), a1 + hstep, voffA);
            PG8_WAIT_L(8); PG8_BAR; PG8_WAIT_L(0); PG8_MMA(0, 0, At, B0); PG8_BAR; PG8_SCHED;
            PG8_LDB(B1, 0, 1); PG8_STAGE(PG8_SB(0, 0), b2, voffB);
            PG8_BAR; PG8_WAIT_L(0); PG8_MMA(0, 1, At, B1); PG8_BAR;
            PG8_LDA(At, 0, 1); PG8_STAGE(PG8_SA(0, 0), a2, voffA);
            PG8_BAR; PG8_WAIT_L(0); PG8_MMA(1, 0, At, B0); PG8_BAR; PG8_SCHED;
            PG8_STAGE(PG8_SB(0, 1), b2 + hstep, voffB);
            PG8_WAIT_V(6); PG8_BAR; PG8_MMA(1, 1, At, B1); PG8_BAR;
            PG8_LDB(B0, 1, 0); PG8_SCHED; PG8_LDA(At, 1, 0); PG8_STAGE(PG8_SA(0, 1), a2 + hstep, voffA);
            PG8_WAIT_L(8); PG8_BAR; PG8_WAIT_L(0); PG8_MMA(0, 0, At, B0); PG8_BAR; PG8_SCHED;
            PG8_LDB(B1, 1, 1); PG8_STAGE(PG8_SB(1, 0), b3, voffB);
            PG8_BAR; PG8_WAIT_L(0); PG8_MMA(0, 1, At, B1); PG8_BAR;
            PG8_LDA(At, 1, 1); PG8_STAGE(PG8_SA(1, 0), a3, voffA);
            PG8_BAR; PG8_WAIT_L(0); PG8_MMA(1, 0, At, B0); PG8_BAR; PG8_SCHED;
            PG8_STAGE(PG8_SB(1, 1), b3 + hstep, voffB);
            PG8_WAIT_V(6); PG8_BAR; PG8_MMA(1, 1, At, B1); PG8_BAR;
            }
        }
        if constexpr (ALIGN_EPI) { if (wr == 0) PG8_BAR; }
        if constexpr (!Epi::AFTER_DRAIN) { E(acc, cur, wr, wc, fr, fq); S.done(cur); }
        if (!has_next) break;
#pragma unroll
        for (int a = 0; a < 2; ++a)
#pragma unroll
            for (int b = 0; b < 2; ++b)
#pragma unroll
                for (int m = 0; m < 4; ++m)
#pragma unroll
                    for (int n = 0; n < 2; ++n) acc[a][b][m][n] = (f32x4){0.f, 0.f, 0.f, 0.f};
        cur = nxt; cA = nA; cB = nB; ++ui;
        if constexpr (ALIGN_EPI) { if (wr == 1) PG8_BAR; }
    }
    PG8_WAIT_V(0);
    if constexpr (!ALIGN_EPI) { if (wr == 0) PG8_BAR; }
    PG8_BAR;
    if constexpr (Epi::AFTER_DRAIN) { E.fused(acc, cur, wr, wc, fr, fq, lds, wid, lane); S.done(cur); }
#undef PG8_SA
#undef PG8_SB
#undef PG8_STAGE
#undef PG8_LDA
#undef PG8_LDB
#undef PG8_MMA
#undef PG8_WAIT_V
#undef PG8_WAIT_L
#undef PG8_BAR
#undef PG8_SCHED
}
}
#define LAS __attribute__((address_space(3)))
typedef unsigned short bf16_t;
typedef short bf16x8 __attribute__((ext_vector_type(8)));
typedef float f32x4 __attribute__((ext_vector_type(4)));
typedef float f32x16 __attribute__((ext_vector_type(16)));
typedef unsigned u32x4 __attribute__((ext_vector_type(4)));
typedef unsigned u32x2 __attribute__((ext_vector_type(2)));
constexpr int T_ = 16384, D_ = 1024, S_ = 2048, NH = 8, DFF = 2816, DIN = 3080, NMOD = 6144, HALFC = 1408;
constexpr float EPS = 1e-6f;
constexpr float LOG2E = 1.4426950408889634f;
constexpr float C2 = 0.125f * LOG2E;
constexpr size_t MiB = 1u << 20;
constexpr size_t WS_MOD = 0, WS_BIAS2 = 256 * 1024, WS_ROWSS = 31 * MiB, WS_BAR = 640 * 1024, WS_LOGF = 1 * MiB, WS_QAUG = 2 * MiB, WS_KAUG = 4 * MiB,
    WS_WIN = 6 * MiB, WS_WOUT = 12 * MiB, WS_WUP = 14 * MiB, WS_WDOWN = 25 * MiB, WS_H = 32 * MiB, WS_Q = 64 * MiB, WS_K = 80 * MiB,
    WS_VT = 96 * MiB, WS_Z = 112 * MiB, WS_BG = 128 * MiB, WS_MIX = 144 * MiB, WS_ACT = 160 * MiB, WS_TAIL = 30 * MiB + 512 * 1024;
constexpr int LDS_BYTES = 139328;
constexpr int XCH_OFF = 131072 + 64;

struct Params {
    const float *x, *c, *w_ada, *b_ada, *n1g, *w_in, *b_f, *qg, *kg, *cmw, *w_out, *n2g, *w_up, *fcw, *w_down;
    float* out; unsigned char* ws;
};

__device__ __forceinline__ float wave_sum(float v) {
#pragma unroll
    for (int o = 1; o < 64; o <<= 1) v += __shfl_xor(v, o);
    return v;
}
__device__ __forceinline__ unsigned f2bf(float f) { unsigned u = __builtin_bit_cast(unsigned, f); return (u + 0x7fffu + ((u >> 16) & 1u)) >> 16; }
__device__ __forceinline__ float bf2f(unsigned h) { return __builtin_bit_cast(float, h << 16); }
__device__ __forceinline__ unsigned pk2(float lo, float hi) { return pg8::cvt_pk_bf16(lo, hi); }
typedef float f32x2_t __attribute__((ext_vector_type(2))); typedef __bf16 bf16x2_t __attribute__((ext_vector_type(2)));
__device__ __forceinline__ unsigned cvtpk_s(float lo, float hi) { f32x2_t v = {lo, hi}; bf16x2_t b = __builtin_convertvector(v, bf16x2_t); return __builtin_bit_cast(unsigned, b); }
__device__ __forceinline__ void unpack8(u32x4 w, float (&f)[8]) {
    f[0] = bf2f(w.x & 0xffffu); f[1] = __builtin_bit_cast(float, w.x & 0xffff0000u);
    f[2] = bf2f(w.y & 0xffffu); f[3] = __builtin_bit_cast(float, w.y & 0xffff0000u);
    f[4] = bf2f(w.z & 0xffffu); f[5] = __builtin_bit_cast(float, w.z & 0xffff0000u);
    f[6] = bf2f(w.w & 0xffffu); f[7] = __builtin_bit_cast(float, w.w & 0xffff0000u);
}
__device__ __forceinline__ u32x4 pack8(const float (&f)[8]) { u32x4 w; w.x = pk2(f[0], f[1]); w.y = pk2(f[2], f[3]); w.z = pk2(f[4], f[5]); w.w = pk2(f[6], f[7]); return w; }

__device__ __forceinline__ void transpose_item(const float* W, int N, int K, bf16_t* WT, int dstrow0, int srccol0, int k0, LAS float* scr, int lane) {
#pragma unroll 8
    for (int i = 0; i < 32; ++i) { const int kk = 2 * i + (lane >> 5); scr[kk * 33 + (lane & 31)] = W[(size_t)(k0 + kk) * N + srccol0 + (lane & 31)]; }
    asm volatile("s_waitcnt lgkmcnt(0)" ::: "memory");
    const int c = lane & 7;
#pragma unroll
    for (int j = 0; j < 4; ++j) { const int n = (lane >> 3) + 8 * j; const LAS float* s = scr + (8 * c) * 33 + n;
        u32x4 o; o.x = pk2(s[0 * 33], s[1 * 33]); o.y = pk2(s[2 * 33], s[3 * 33]); o.z = pk2(s[4 * 33], s[5 * 33]); o.w = pk2(s[6 * 33], s[7 * 33]);
        *(u32x4*)(WT + (size_t)(dstrow0 + n) * K + k0 + 8 * c) = o; }
    asm volatile("s_waitcnt lgkmcnt(0)" ::: "memory");
}
__device__ __forceinline__ int win_src(int p0) {
    const int pn = p0 >> 8, c = p0 & 255, bj = c >> 7, wc = (c & 127) >> 5;
    if (pn < 6) return (pn >> 1) * 512 + (4 * (pn & 1) + wc) * 64 + 32 * bj;
    if (pn < 10) return (bj == 0 ? 1544 : 2568) + 128 * (pn - 6) + (c & 127);
    return 2056 + 256 * (pn - 10) + c;
}
__device__ __forceinline__ int wup_src(int p0) { const int j = p0 >> 8, c = p0 & 255; return (c < 128) ? 128 * j + c : DFF + 128 * j + (c - 128); }

__device__ __forceinline__ void gemv_item(const float* W, int N, int n0, const float* bias, const LAS float* vecs, LAS float* red, float* out, int tid) {
    const int cgp = tid & 15, kg = tid >> 4;
    float acc[8][4];
#pragma unroll
    for (int b = 0; b < 8; ++b)
#pragma unroll
        for (int j = 0; j < 4; ++j) acc[b][j] = 0.f;
#pragma unroll 4
    for (int i = 0; i < 32; ++i) { const int k = kg + 32 * i; const f32x4 w = *(const f32x4*)(W + (size_t)k * N + n0 + 4 * cgp);
#pragma unroll
        for (int b = 0; b < 8; ++b) { const float v = vecs[b * 1024 + k]; acc[b][0] += v * w.x; acc[b][1] += v * w.y; acc[b][2] += v * w.z; acc[b][3] += v * w.w; } }
#pragma unroll
    for (int b = 0; b < 8; ++b) *(LAS f32x4*)(red + (kg * 8 + b) * 64 + 4 * cgp) = (f32x4){acc[b][0], acc[b][1], acc[b][2], acc[b][3]};
    __syncthreads();
    { const int b = tid >> 6, col = tid & 63; float s = 0.f;
#pragma unroll 8
      for (int g = 0; g < 32; ++g) s += red[(g * 8 + b) * 64 + col];
      out[(size_t)b * N + n0 + col] = s + (bias ? bias[n0 + col] : 0.f); }
    __syncthreads();
}

__device__ __forceinline__ void phase0(const Params& p, LAS unsigned char* lds, int tid, int lane, int wave) {
    float* mod = (float*)(p.ws + WS_MOD);
    if (blockIdx.x < 96) {
        LAS float* vecs = (LAS float*)lds; LAS float* red = (LAS float*)(lds + 32768);
        for (int i = tid; i < 8192; i += 512) { const float v = p.c[i]; vecs[i] = v / (1.f + __expf(-v)); }
        __syncthreads();
        gemv_item(p.w_ada, NMOD, 64 * blockIdx.x, p.b_ada, vecs, red, mod, tid);
    }
    LAS float* scr = (LAS float*)(lds + wave * 8704);
    constexpr int I_IN = 16 * 96, I_OUT = 16 * 32, I_UP = 16 * 176, I_DN = 44 * 32, NIT = I_IN + I_OUT + I_UP + I_DN;
    const int gw = blockIdx.x * 8 + wave, NGW = gridDim.x * 8;
    for (int it = gw; it < NIT; it += NGW) {
        int r = it;
        if (r < I_IN) { const int kb = r / 96, nb = r % 96; transpose_item(p.w_in, DIN, 1024, (bf16_t*)(p.ws + WS_WIN), 32 * nb, win_src(32 * nb), 64 * kb, scr, lane); continue; } r -= I_IN;
        if (r < I_OUT) { const int kb = r / 32, nb = r % 32; transpose_item(p.w_out, 1024, 1024, (bf16_t*)(p.ws + WS_WOUT), 32 * nb, 32 * nb, 64 * kb, scr, lane); continue; } r -= I_OUT;
        if (r < I_UP) { const int kb = r / 176, nb = r % 176; transpose_item(p.w_up, 2 * DFF, 1024, (bf16_t*)(p.ws + WS_WUP), 32 * nb, wup_src(32 * nb), 64 * kb, scr, lane); continue; } r -= I_UP;
        { const int kb = r / 32, nb = r % 32; transpose_item(p.w_down, 1024, DFF, (bf16_t*)(p.ws + WS_WDOWN), 32 * nb, 32 * nb, 64 * kb, scr, lane); }
    }
}

__device__ __forceinline__ void phase1(const Params& p, LAS unsigned char* lds, int tid, int lane, int wave) {
    const float* mod = (const float*)(p.ws + WS_MOD);
    if (blockIdx.x < 88) {
        LAS float* vecs = (LAS float*)lds; LAS float* red = (LAS float*)(lds + 32768);
        for (int i = tid; i < 8192; i += 512) vecs[i] = mod[(i >> 10) * NMOD + 3072 + (i & 1023)];
        __syncthreads();
        gemv_item(p.w_up, 2 * DFF, 64 * blockIdx.x, nullptr, vecs, red, (float*)(p.ws + WS_BIAS2), tid);
    }
    LAS float* wf = (LAS float*)lds;
    for (int i = tid; i < 8192; i += 512) { const int k = i >> 3, h = i & 7; wf[h * 1024 + k] = p.w_in[(size_t)k * DIN + 1536 + h]; }
    __syncthreads();
    bf16_t* hb = (bf16_t*)(p.ws + WS_H); float* logf = (float*)(p.ws + WS_LOGF);
    const int gw = blockIdx.x * 8 + wave, NGW = gridDim.x * 8;
    for (int row = gw; row < T_; row += NGW) {
        const int b = row >> 11; const float* xr = p.x + (size_t)row * D_; const float* mb = mod + b * NMOD;
        f32x4 v[4]; float ss = 0.f;
#pragma unroll
        for (int j = 0; j < 4; ++j) { v[j] = *(const f32x4*)(xr + 4 * lane + 256 * j); ss += (v[j].x * v[j].x + v[j].y * v[j].y) + (v[j].z * v[j].z + v[j].w * v[j].w); }
        const float rstd = rsqrtf(wave_sum(ss) * (1.f / D_) + EPS);
#pragma unroll
        for (int j = 0; j < 4; ++j) { const int col = 4 * lane + 256 * j;
            const f32x4 g = *(const f32x4*)(p.n1g + col), sc = *(const f32x4*)(mb + 1024 + col), sh = *(const f32x4*)(mb + col);
            v[j] = (v[j] * rstd) * g * (sc + 1.f) + sh;
            u32x2 w; w.x = pk2(v[j].x, v[j].y); w.y = pk2(v[j].z, v[j].w);
            *(u32x2*)(hb + (size_t)row * D_ + col) = w; }
        float fg[8];
#pragma unroll
        for (int h = 0; h < 8; ++h) { float s = 0.f;
#pragma unroll
            for (int j = 0; j < 4; ++j) { const f32x4 w = *(const LAS f32x4*)(wf + h * 1024 + 4 * lane + 256 * j); s += (v[j].x * w.x + v[j].y * w.y) + (v[j].z * w.z + v[j].w * w.w); }
            fg[h] = wave_sum(s); }
        float z = fg[0];
#pragma unroll
        for (int h = 1; h < 8; ++h) z = (lane == h) ? fg[h] : z;
        if (lane < 8) { z += p.b_f[lane]; logf[(size_t)row * 8 + lane] = fminf(z, 0.f) - log1pf(expf(-fabsf(z))); }
    }
    __syncthreads();
}

__device__ __forceinline__ void scan_item(const Params& p, LAS unsigned char* lds, int bh, int tid, int lane, int wave) {
    const float* logf = (const float*)(p.ws + WS_LOGF); const int b = bh >> 3, h = bh & 7;
    LAS float* wt = (LAS float*)lds;
    float a[4];
#pragma unroll
    for (int i = 0; i < 4; ++i) a[i] = logf[((size_t)(b * S_ + 4 * tid + i)) * 8 + h];
    a[1] += a[0]; a[2] += a[1]; a[3] += a[2];
    float sc = a[3];
#pragma unroll
    for (int o = 1; o < 64; o <<= 1) { const float y = __shfl_up(sc, o); if (lane >= o) sc += y; }
    if (lane == 63) wt[wave] = sc;
    __syncthreads();
    float off = sc - a[3];
    for (int w = 0; w < wave; ++w) off += wt[w];
    u32x4* qa = (u32x4*)(p.ws + WS_QAUG) + (size_t)bh * S_ + 4 * tid; u32x4* ka = (u32x4*)(p.ws + WS_KAUG) + (size_t)bh * S_ + 4 * tid;
#pragma unroll
    for (int i = 0; i < 4; ++i) { const float F = (off + a[i]) * LOG2E;
        const unsigned hi = f2bf(F); const float r1 = F - bf2f(hi); const unsigned mid = f2bf(r1); const float r2 = r1 - bf2f(mid); const unsigned lo = f2bf(r2);
        u32x4 q, k; q.x = hi | (mid << 16); q.y = lo | (0x3F80u << 16); q.z = 0x3F803F80u; q.w = 0u;
        k.x = 0x3F803F80u; k.y = 0x3F80u | ((hi ^ 0x8000u) << 16); k.z = (mid ^ 0x8000u) | ((lo ^ 0x8000u) << 16); k.w = 0u;
        qa[i] = q; ka[i] = k; }
    __syncthreads();
}
struct EpiIn {
    static constexpr bool PERM = true, AFTER_DRAIN = false;
    bf16_t *Q, *K, *Vt, *Z, *BG; const float *qg, *kg;
    __device__ __forceinline__ void operator()(const f32x4 (&acc)[2][2][4][2], const pg8::Unit& u, int wr, int wc, int fr, int fq) const {
        const int pn = u.pn; const int row0 = u.pm * 256 + wr * 64 + fr;
        if (pn < 4) {
            const bool isq = pn < 2; const float* g = isq ? qg : kg; bf16_t* dst = isq ? Q : K; const int head = 4 * (pn & 1) + wc; const float mul = isq ? C2 : 1.f;
            f32x4 gv[2][2];
#pragma unroll
            for (int bj = 0; bj < 2; ++bj)
#pragma unroll
                for (int n = 0; n < 2; ++n) gv[bj][n] = *(const f32x4*)(g + 32 * bj + 8 * fq + 4 * n) * mul;
#pragma unroll
            for (int ai = 0; ai < 2; ++ai)
#pragma unroll
                for (int m = 0; m < 4; ++m) {
                    float ss = 0.f;
#pragma unroll
                    for (int bj = 0; bj < 2; ++bj)
#pragma unroll
                        for (int n = 0; n < 2; ++n) { const f32x4 a = acc[ai][bj][m][n]; ss += (a.x * a.x + a.y * a.y) + (a.z * a.z + a.w * a.w); }
                    ss += __shfl_xor(ss, 16); ss += __shfl_xor(ss, 32);
                    const float rinv = rsqrtf(ss * (1.f / 64.f) + EPS);
                    const unsigned row = (unsigned)(row0 + ai * 128 + m * 16);
#pragma unroll
                    for (int bj = 0; bj < 2; ++bj) { const f32x4 v0 = acc[ai][bj][m][0] * rinv * gv[bj][0], v1 = acc[ai][bj][m][1] * rinv * gv[bj][1];
                        u32x4 w; w.x = pk2(v0.x, v0.y); w.y = pk2(v0.z, v0.w); w.z = pk2(v1.x, v1.y); w.w = pk2(v1.z, v1.w);
                        *(u32x4*)(dst + row * 512 + head * 64 + 32 * bj + 8 * fq) = w; }
                }
        } else if (pn < 6) {
            const int head = 4 * (pn & 1) + wc, b = u.pm >> 3;
            bf16_t* vb = Vt + (size_t)((b * 8 + head) * 64) * S_;
#pragma unroll
            for (int ai = 0; ai < 2; ++ai)
#pragma unroll
                for (int m = 0; m < 4; ++m) { const int t = (row0 + ai * 128 + m * 16) & (S_ - 1);
                    const int tp = (t & ~15) | (((t >> 2) & 1) << 3) | (((t >> 3) & 1) << 2) | (t & 3);
#pragma unroll
                    for (int bj = 0; bj < 2; ++bj)
#pragma unroll
                        for (int n = 0; n < 2; ++n) { const f32x4 a = acc[ai][bj][m][n]; const int d = 32 * bj + 8 * fq + 4 * n;
                            vb[(unsigned)((d + 0) * S_ + tp)] = (bf16_t)f2bf(a.x); vb[(unsigned)((d + 1) * S_ + tp)] = (bf16_t)f2bf(a.y);
                            vb[(unsigned)((d + 2) * S_ + tp)] = (bf16_t)f2bf(a.z); vb[(unsigned)((d + 3) * S_ + tp)] = (bf16_t)f2bf(a.w); }
                }
        } else if (pn < 10) {
            const int ch0 = 128 * (pn - 6) + 32 * wc + 8 * fq;
#pragma unroll
            for (int ai = 0; ai < 2; ++ai)
#pragma unroll
                for (int m = 0; m < 4; ++m) { const unsigned row = (unsigned)(row0 + ai * 128 + m * 16);
                    const f32x4 v0 = acc[ai][0][m][0] * acc[ai][1][m][0], v1 = acc[ai][0][m][1] * acc[ai][1][m][1];
                    u32x4 w; w.x = pk2(v0.x, v0.y); w.y = pk2(v0.z, v0.w); w.z = pk2(v1.x, v1.y); w.w = pk2(v1.z, v1.w);
                    *(u32x4*)(Z + row * 512 + ch0) = w; }
        } else {
#pragma unroll
            for (int ai = 0; ai < 2; ++ai)
#pragma unroll
                for (int m = 0; m < 4; ++m) { const unsigned row = (unsigned)(row0 + ai * 128 + m * 16);
#pragma unroll
                    for (int bj = 0; bj < 2; ++bj) { const f32x4 v0 = acc[ai][bj][m][0], v1 = acc[ai][bj][m][1];
                        u32x4 w; w.x = pk2(v0.x, v0.y); w.y = pk2(v0.z, v0.w); w.z = pk2(v1.x, v1.y); w.w = pk2(v1.z, v1.w);
                        *(u32x4*)(BG + row * 512 + 256 * (pn - 10) + 128 * bj + 32 * wc + 8 * fq) = w; } }
        }
    }
};
struct EpiOut {
    static constexpr bool PERM = true, AFTER_DRAIN = false;
    const float* x; const float* mod; const float* n2g; float* out; bf16_t* A2; float* rowss; bf16_t* A2tail;
    __device__ __forceinline__ void operator()(const f32x4 (&acc)[2][2][4][2], const pg8::Unit& u, int wr, int wc, int fr, int fq) const {
        const int b = u.pm >> 3, colb = u.pn * 256 + wc * 32 + 8 * fq; const int row0 = u.pm * 256 + wr * 64 + fr;
        const float* mb = mod + b * NMOD;
        f32x4 g1v[2][2], gm[2][2];
#pragma unroll
        for (int bj = 0; bj < 2; ++bj)
#pragma unroll
            for (int n = 0; n < 2; ++n) { const int col = colb + 128 * bj + 4 * n; g1v[bj][n] = *(const f32x4*)(mb + 2048 + col);
                gm[bj][n] = *(const f32x4*)(n2g + col) * (*(const f32x4*)(mb + 4096 + col) + 1.f); }
#pragma unroll
        for (int ai = 0; ai < 2; ++ai)
#pragma unroll
            for (int m = 0; m < 4; ++m) { const unsigned row = (unsigned)(row0 + ai * 128 + m * 16); float ss = 0.f;
#pragma unroll
                for (int bj = 0; bj < 2; ++bj) { f32x4 x1[2];
#pragma unroll
                    for (int n = 0; n < 2; ++n) { const unsigned off = row * D_ + colb + 128 * bj + 4 * n;
                        x1[n] = *(const f32x4*)(x + off) + g1v[bj][n] * acc[ai][bj][m][n]; *(f32x4*)(out + off) = x1[n];
                        ss += (x1[n].x * x1[n].x + x1[n].y * x1[n].y) + (x1[n].z * x1[n].z + x1[n].w * x1[n].w); x1[n] = x1[n] * gm[bj][n]; }
                    u32x4 w; w.x = pk2(x1[0].x, x1[0].y); w.y = pk2(x1[0].z, x1[0].w); w.z = pk2(x1[1].x, x1[1].y); w.w = pk2(x1[1].z, x1[1].w);
                    *(u32x4*)(A2 + row * D_ + colb + 128 * bj) = w;
                    { const unsigned t = row & (S_ - 1); if (t >= 2016u) *(u32x4*)(A2tail + ((row >> 11) * 32 + (t - 2016u)) * D_ + colb + 128 * bj) = w; } }
                ss += __shfl_xor(ss, 16); ss += __shfl_xor(ss, 32);
                if (fq == 0) rowss[row * 16 + u.pn * 4 + wc] = ss; }
    }
};
struct EpiUp {
    static constexpr bool PERM = true, AFTER_DRAIN = false;
    const float* rowss; const float* bias2; bf16_t* U; int half;
    __device__ __forceinline__ void operator()(const f32x4 (&acc)[2][2][4][2], const pg8::Unit& u, int wr, int wc, int fr, int fq) const {
        const int b = u.pm >> 3; const int row0 = u.pm * 256 + wr * 64 + fr;
        f32x4 bv[2][2];
#pragma unroll
        for (int bj = 0; bj < 2; ++bj)
#pragma unroll
            for (int n = 0; n < 2; ++n) bv[bj][n] = *(const f32x4*)(bias2 + b * (2 * DFF) + bj * DFF + half * HALFC + 128 * u.pn + 32 * wc + 8 * fq + 4 * n);
#pragma unroll
        for (int ai = 0; ai < 2; ++ai)
#pragma unroll
            for (int m = 0; m < 4; ++m) { const unsigned row = (unsigned)(row0 + ai * 128 + m * 16); const f32x4 s4 = *(const f32x4*)(rowss + row * 16 + 4 * fq); float sq = (s4.x + s4.y) + (s4.z + s4.w); sq += __shfl_xor(sq, 16); sq += __shfl_xor(sq, 32);
                const float rstd = rsqrtf(sq * (1.f / D_) + EPS);
#pragma unroll
                for (int bj = 0; bj < 2; ++bj) { const f32x4 v0 = acc[ai][bj][m][0] * rstd + bv[bj][0], v1 = acc[ai][bj][m][1] * rstd + bv[bj][1];
                    u32x4 w; w.x = pk2(v0.x, v0.y); w.y = pk2(v0.z, v0.w); w.z = pk2(v1.x, v1.y); w.w = pk2(v1.z, v1.w);
                    *(u32x4*)(U + (row * DFF + 256 * u.pn + 128 * bj + 32 * wc + 8 * fq)) = w; } }
    }
};

__device__ __forceinline__ float dpp_f(float old, float src, int which) {
    const int o = __builtin_bit_cast(int, old), v = __builtin_bit_cast(int, src); int r;
    if (which == 0) r = __builtin_amdgcn_update_dpp(o, v, 0x111, 0xf, 0xf, false);
    else if (which == 1) r = __builtin_amdgcn_update_dpp(o, v, 0x112, 0xf, 0xf, false);
    else if (which == 2) r = __builtin_amdgcn_update_dpp(o, v, 0x121, 0xf, 0xf, false);
    else r = __builtin_amdgcn_update_dpp(o, v, 0x122, 0xf, 0xf, false);
    return __builtin_bit_cast(float, r);
}
struct UpOrder : pg8::StaticOrder {
    long tail_off;
    __device__ __forceinline__ long a_off(int pm, size_t) const { return pm < 64 ? ((long)((pm >> 3) * S_ + 254 * (pm & 7) - 2)) * (D_ * 2) : tail_off; }
};
struct EpiUpF {
    static constexpr bool PERM = true, AFTER_DRAIN = false;
    const float* rowss; const float* bias2; const float* fcw; bf16_t* act; LAS float* xch;
    __device__ __forceinline__ void operator()(f32x4 (&acc)[2][2][4][2], const pg8::Unit& u, int wr, int wc, int fr, int fq) const {
        if (u.pm == 64) run<true>(acc, u, wr, wc, fr, fq); else run<false>(acc, u, wr, wc, fr, fq);
    }
    template <bool tail> __device__ __forceinline__ void run(f32x4 (&acc)[2][2][4][2], const pg8::Unit& u, int wr, int wc, int fr_in, int fq_in) const {
        int fr = fr_in, fq = fq_in; asm volatile("" : "+v"(fr), "+v"(fq));
        fr &= 15; fq &= 3;
        const int pm = u.pm, pn = u.pn; const int breg = pm >> 3, ireg = pm & 7;
        const int rbase = wr * 64 + fr, colg = 32 * wc + 8 * fq, chan0 = 128 * pn + colg;
        const int tok0 = breg * S_ + 254 * ireg - 2;
        const bool zfirst = !tail && ireg == 0 && wr == 0 && fr < 2;
        float rstd[2][4];
#pragma unroll
        for (int ai = 0; ai < 2; ++ai)
#pragma unroll
            for (int m = 0; m < 4; ++m) {
                const int r = rbase + 128 * ai + 16 * m; int grow = tail ? (r >> 5) * S_ + 2016 + (r & 31) : tok0 + r; grow = grow < 0 ? 0 : grow;
                const f32x4 s4 = *(const f32x4*)(rowss + (unsigned)grow * 16 + 4 * fq); float sq = (s4.x + s4.y) + (s4.z + s4.w); sq += __shfl_xor(sq, 16); sq += __shfl_xor(sq, 32);
                rstd[ai][m] = rsqrtf(sq * (1.f / D_) + EPS);
            }
#pragma unroll
        for (int ai = 0; ai < 2; ++ai) { const float* bp = bias2 + (tail ? (4 * ai + 2 * wr + 1) : breg) * (2 * DFF) + chan0;
#pragma unroll
            for (int bj = 0; bj < 2; ++bj)
#pragma unroll
                for (int n = 0; n < 2; ++n) { const f32x4 v = acc[ai][bj][3][n] * rstd[ai][3] + *(const f32x4*)(bp + bj * DFF + 4 * n);
                    if (fr >= 14) *(LAS f32x4*)(xch + (((2 * ai + wr) * 2 + (fr - 14)) * 256 + 128 * bj + colg + 4 * n)) = v; } }
        asm volatile("s_waitcnt lgkmcnt(0)" ::: "memory"); __builtin_amdgcn_s_barrier(); asm volatile("" ::: "memory");
#pragma unroll
        for (int n = 0; n < 2; ++n) {
            const float* wp = fcw + chan0 + 4 * n;
            const f32x4 wg0 = *(const f32x4*)(wp), wg1 = *(const f32x4*)(wp + 2 * DFF), wg2 = *(const f32x4*)(wp + 4 * DFF);
            const f32x4 wv0 = *(const f32x4*)(wp + DFF), wv1 = *(const f32x4*)(wp + 3 * DFF), wv2 = *(const f32x4*)(wp + 5 * DFF);
            f32x4 bg = (f32x4){0.f, 0.f, 0.f, 0.f}, bvl = bg;
            if (!tail) { bg = *(const f32x4*)(bias2 + breg * (2 * DFF) + chan0 + 4 * n); bvl = *(const f32x4*)(bias2 + breg * (2 * DFF) + DFF + chan0 + 4 * n); }
#pragma unroll
            for (int ai = 0; ai < 2; ++ai) {
                const int slot = 2 * ai + wr - 1;
                f32x4 g14 = (f32x4){0.f, 0.f, 0.f, 0.f}, g15 = g14, v14 = g14, v15 = g14;
                if (slot >= 0) { const LAS float* xp = xch + (slot * 2) * 256 + colg + 4 * n;
                    g14 = *(const LAS f32x4*)(xp); g15 = *(const LAS f32x4*)(xp + 256); v14 = *(const LAS f32x4*)(xp + 128); v15 = *(const LAS f32x4*)(xp + 256 + 128); }
                f32x4 pg = g14, pv = g14;
#pragma unroll
                for (int m = 0; m < 4; ++m) {
                    const int r = rbase + 128 * ai + 16 * m;
                    if (tail) { const float* bp = bias2 + (4 * ai + 2 * wr + (m >> 1)) * (2 * DFF) + chan0 + 4 * n; bg = *(const f32x4*)(bp); bvl = *(const f32x4*)(bp + DFF); }
                    f32x4 cg_ = acc[ai][0][m][n] * rstd[ai][m] + bg, cv_ = acc[ai][1][m][n] * rstd[ai][m] + bvl;
                    if (ai == 0 && m == 0) { if (zfirst) { cg_ = (f32x4){0.f, 0.f, 0.f, 0.f}; cv_ = cg_; } }
                    float o[4];
#pragma unroll
                    for (int e = 0; e < 4; ++e) {
                        float o1g, o2g, o1v, o2v;
                        if (m == 0) { o1g = g15[e]; o2g = (fr == 0) ? g14[e] : g15[e]; o1v = v15[e]; o2v = (fr == 0) ? v14[e] : v15[e]; }
                        else { o1g = dpp_f(0.f, pg[e], 2); o2g = dpp_f(0.f, pg[e], 3); o1v = dpp_f(0.f, pv[e], 2); o2v = dpp_f(0.f, pv[e], 3); }
                        const float p1g = dpp_f(o1g, cg_[e], 0), p2g = dpp_f(o2g, cg_[e], 1), p1v = dpp_f(o1v, cv_[e], 0), p2v = dpp_f(o2v, cv_[e], 1);
                        const float G = wg0[e] * p2g + wg1[e] * p1g + wg2[e] * cg_[e], V = wv0[e] * p2v + wv1[e] * p1v + wv2[e] * cv_[e];
                        o[e] = G * __builtin_amdgcn_rcpf(1.f + __expf(-G)) * V;
                    }
                    pg = cg_; pv = cv_;
                    bool outv; int tg;
                    if (tail) { outv = (m & 1) != 0; tg = (r >> 5) * S_ + 2016 + (r & 31); } else { outv = r >= 2; tg = tok0 + r; }
                    if (outv) { u32x2 w; w.x = pk2(o[0], o[1]); w.y = pk2(o[2], o[3]); *(u32x2*)(act + ((unsigned)tg * DFF + chan0 + 4 * n)) = w; }
                    __builtin_amdgcn_sched_barrier(0);
                }
            }
        }
    }
};
struct EpiDown {
    static constexpr bool PERM = true, AFTER_DRAIN = false;
    const float* mod; float* out;
    __device__ __forceinline__ void operator()(const f32x4 (&acc)[2][2][4][2], const pg8::Unit& u, int wr, int wc, int fr, int fq) const {
        const int b = u.pm >> 3, colb = u.pn * 256 + wc * 32 + 8 * fq; const int row0 = u.pm * 256 + wr * 64 + fr;
        const float* mb = mod + b * NMOD + 5120;
        f32x4 g2v[2][2];
#pragma unroll
        for (int bj = 0; bj < 2; ++bj)
#pragma unroll
            for (int n = 0; n < 2; ++n) g2v[bj][n] = *(const f32x4*)(mb + colb + 128 * bj + 4 * n);
#pragma unroll
        for (int ai = 0; ai < 2; ++ai)
#pragma unroll
            for (int m = 0; m < 4; ++m) { const unsigned row = (unsigned)(row0 + ai * 128 + m * 16);
#pragma unroll
                for (int bj = 0; bj < 2; ++bj)
#pragma unroll
                    for (int n = 0; n < 2; ++n) { float* q = out + row * D_ + colb + 128 * bj + 4 * n; *(f32x4*)q = *(const f32x4*)q + g2v[bj][n] * acc[ai][bj][m][n]; } }
    }
};

__device__ __forceinline__ int crow(int r, int hi) { return (r & 3) + 8 * (r >> 2) + 4 * hi; }
constexpr int AB_K = 0, AB_V = 9216, AB_A = 18432, ABUF = 19456, A_LW = 2 * ABUF;
__device__ __forceinline__ void attn_unit(const Params& p, LAS unsigned char* lds, int bh, int qb, float mshift, int tid, int lane, int wave) {
    const int r32 = lane & 31, hi = lane >> 5, b = bh >> 3, h = bh & 7;
    const bf16_t* Qg = (const bf16_t*)(p.ws + WS_Q); const bf16_t* Kg = (const bf16_t*)(p.ws + WS_K); const bf16_t* Vg = (const bf16_t*)(p.ws + WS_VT);
    const u32x4* qaug = (const u32x4*)(p.ws + WS_QAUG) + (size_t)bh * S_; const u32x4* kaug = (const u32x4*)(p.ws + WS_KAUG) + (size_t)bh * S_;
    bf16_t* mix = (bf16_t*)(p.ws + WS_MIX);
    const int q_rel = 32 * wave + r32, tq = 256 * qb + q_rel;
    bf16x8 qr[4], qa;
    { const bf16_t* qp = Qg + ((size_t)(b * S_ + tq)) * 512 + h * 64 + 8 * hi;
#pragma unroll
      for (int d0 = 0; d0 < 4; ++d0) qr[d0] = *(const bf16x8*)(qp + 16 * d0);
      u32x4 t = qaug[tq]; if (hi) t = (u32x4){0u, 0u, 0u, 0u}; qa = __builtin_bit_cast(bf16x8, t); }
    f32x16 o[2]; float lsum = 0.f;
#pragma unroll
    for (int i = 0; i < 16; ++i) { o[0][i] = 0.f; o[1][i] = 0.f; }
    const int NT = 4 * (qb + 1);
    const int srow = tid >> 3, sch = tid & 7;
    const bf16_t* kp = Kg + ((size_t)(b * S_ + srow)) * 512 + h * 64 + 8 * sch;
    const bf16_t* vp = Vg + ((size_t)(bh * 64 + srow)) * S_ + 8 * sch;
    u32x4 kreg = *(const u32x4*)kp, vreg = *(const u32x4*)vp, areg = (u32x4){0u, 0u, 0u, 0u};
    if (tid < 64) areg = kaug[tid];
    { LAS unsigned char* bb = lds; *(LAS u32x4*)(bb + AB_K + srow * 144 + sch * 16) = kreg; *(LAS u32x4*)(bb + AB_V + srow * 144 + sch * 16) = vreg; if (tid < 64) *(LAS u32x4*)(bb + AB_A + tid * 16) = areg; }
    __syncthreads();
    for (int j = 0; j < NT; ++j) {
        const bool more = (j + 1 < NT);
        if (more) { kreg = *(const u32x4*)(kp + (size_t)(j + 1) * 64 * 512); vreg = *(const u32x4*)(vp + (j + 1) * 64); if (tid < 64) areg = kaug[(j + 1) * 64 + tid]; }
        const LAS unsigned char* bb = lds + (j & 1) * ABUF;
        const int jb = j - 4 * qb;
#pragma unroll
        for (int kh = 0; kh < 2; ++kh) {
            if (jb >= 0 && 64 * jb + 32 * kh > 32 * wave + 31) continue;
            f32x16 C;
#pragma unroll
            for (int i = 0; i < 16; ++i) C[i] = -mshift;
            const LAS unsigned char* kr = bb + AB_K + (32 * kh + r32) * 144 + hi * 16;
#pragma unroll
            for (int d0 = 0; d0 < 4; ++d0) { const bf16x8 a = *(const LAS bf16x8*)(kr + d0 * 32); C = __builtin_amdgcn_mfma_f32_32x32x16_bf16(a, qr[d0], C, 0, 0, 0); }
            { u32x4 t = *(const LAS u32x4*)(bb + AB_A + (32 * kh + r32) * 16); if (hi) t = (u32x4){0u, 0u, 0u, 0u};
              C = __builtin_amdgcn_mfma_f32_32x32x16_bf16(__builtin_bit_cast(bf16x8, t), qa, C, 0, 0, 0); }
            if (jb >= 0) {
#pragma unroll
                for (int i = 0; i < 16; ++i) { const int kv = 64 * jb + 32 * kh + crow(i, hi); if (kv > q_rel) C[i] = -INFINITY; }
            }
#pragma unroll
            for (int i = 0; i < 16; ++i) { C[i] = __builtin_amdgcn_exp2f(C[i]); lsum += C[i]; }
#pragma unroll
            for (int s = 0; s < 2; ++s) {
                u32x4 pw; pw.x = cvtpk_s(C[8 * s + 0], C[8 * s + 1]); pw.y = cvtpk_s(C[8 * s + 2], C[8 * s + 3]); pw.z = cvtpk_s(C[8 * s + 4], C[8 * s + 5]); pw.w = cvtpk_s(C[8 * s + 6], C[8 * s + 7]);
                const bf16x8 pa = __builtin_bit_cast(bf16x8, pw);
#pragma unroll
                for (int dh = 0; dh < 2; ++dh) { const bf16x8 vf = *(const LAS bf16x8*)(bb + AB_V + (32 * dh + r32) * 144 + (32 * kh + 16 * s + 8 * hi) * 2);
                    o[dh] = __builtin_amdgcn_mfma_f32_32x32x16_bf16(pa, vf, o[dh], 0, 0, 0); }
            }
        }
        if (more) { LAS unsigned char* nb = lds + ((j + 1) & 1) * ABUF; *(LAS u32x4*)(nb + AB_K + srow * 144 + sch * 16) = kreg; *(LAS u32x4*)(nb + AB_V + srow * 144 + sch * 16) = vreg; if (tid < 64) *(LAS u32x4*)(nb + AB_A + tid * 16) = areg; }
        __syncthreads();
    }
    lsum += __shfl_xor(lsum, 32);
    LAS float* lw = (LAS float*)(lds + A_LW + wave * 128);
    if (hi == 0) lw[r32] = lsum;
    asm volatile("s_waitcnt lgkmcnt(0)" ::: "memory");
    bf16_t* op = mix + ((size_t)(b * S_ + 256 * qb + 32 * wave)) * D_ + h * 64 + r32;
#pragma unroll
    for (int i = 0; i < 16; ++i) { const int qq = crow(i, hi); const float rl = 1.f / lw[qq];
        op[(size_t)qq * D_] = (bf16_t)f2bf(o[0][i] * rl); op[(size_t)qq * D_ + 32] = (bf16_t)f2bf(o[1][i] * rl); }
    asm volatile("s_waitcnt lgkmcnt(0)" ::: "memory");
}

__device__ __forceinline__ void phase3(const Params& p, LAS unsigned char* lds, int tid, int lane, int wave) {
    float mq = 0.f, mk = 0.f;
    for (int i = 0; i < 64; ++i) { mq = fmaxf(mq, fabsf(p.qg[i])); mk = fmaxf(mk, fabsf(p.kg[i])); }
    const float mshift = 8.f * LOG2E * 1.03f * mq * mk;
    const int G = gridDim.x, bx = blockIdx.x; const int vcu = (G % 8 == 0) ? (bx % 8) * (G / 8) + bx / 8 : bx;
    for (int pr = vcu; pr < 256; pr += G) { const int bh = pr >> 2, s = pr & 3;
        attn_unit(p, lds, bh, 7 - s, mshift, tid, lane, wave);
        attn_unit(p, lds, bh, s, mshift, tid, lane, wave); }
    const bf16_t* Z = (const bf16_t*)(p.ws + WS_Z); const bf16_t* BG = (const bf16_t*)(p.ws + WS_BG); bf16_t* mix = (bf16_t*)(p.ws + WS_MIX);
    for (int it = bx * 512 + tid; it < (T_ / 8) * 64; it += G * 512) {
        const int rc = it >> 6, c0 = 8 * (it & 63), t0 = 8 * rc;
        float w0[8], w1[8], w2[8], z1[8], z2[8];
#pragma unroll
        for (int i = 0; i < 8; ++i) { w0[i] = p.cmw[c0 + i]; w1[i] = p.cmw[512 + c0 + i]; w2[i] = p.cmw[1024 + c0 + i]; z1[i] = 0.f; z2[i] = 0.f; }
        if (t0 & (S_ - 1)) { unpack8(*(const u32x4*)(Z + (size_t)(t0 - 2) * 512 + c0), z2); unpack8(*(const u32x4*)(Z + (size_t)(t0 - 1) * 512 + c0), z1); }
#pragma unroll
        for (int r = 0; r < 8; ++r) { float zc[8], bg[8], ov[8];
            unpack8(*(const u32x4*)(Z + (size_t)(t0 + r) * 512 + c0), zc); unpack8(*(const u32x4*)(BG + (size_t)(t0 + r) * 512 + c0), bg);
#pragma unroll
            for (int i = 0; i < 8; ++i) { ov[i] = bg[i] * (w0[i] * z2[i] + w1[i] * z1[i] + w2[i] * zc[i]); z2[i] = z1[i]; z1[i] = zc[i]; }
            *(u32x4*)(mix + (size_t)(t0 + r) * D_ + 512 + c0) = pack8(ov); }
    }
}

#define XB_TMO      128
#define XB_XCNT(j)  (256  + 64 * (j))
#define XB_XSUB(j)  (1280 + 64 * (j))
#define XB_XGEN(j)  (2304 + 64 * (j))
#define XB_TOP      3328
#define XB_TOPGEN   3392
#define XCD_BAR_WORDS 3456
#define XB_SPIN_CAP (1u << 18)

__device__ __forceinline__ unsigned xb_ld(unsigned* p)              { return __hip_atomic_load(p, __ATOMIC_RELAXED, __HIP_MEMORY_SCOPE_AGENT); }
__device__ __forceinline__ unsigned xb_add(unsigned* p, unsigned v) { return __hip_atomic_fetch_add(p, v, __ATOMIC_RELAXED, __HIP_MEMORY_SCOPE_AGENT); }
__device__ __forceinline__ unsigned xb_xcc_id() { return (unsigned)__builtin_amdgcn_s_getreg((3 << 11) | 20) & 0xFu; }
#define XB_SPIN(cond, bar) do { unsigned _sp = 0; while (cond) { __builtin_amdgcn_s_sleep(1); \
    if ((++_sp & 255u) == 0u) { if (xb_ld(&(bar)[XB_TMO])) break; if (_sp > XB_SPIN_CAP) { atomicAdd(&(bar)[XB_TMO], 1u); break; } } } } while (0)

struct XcdBarrier {
    unsigned* bar; unsigned x;
    volatile LAS unsigned* st;
};

__device__ __forceinline__ XcdBarrier xcd_barrier_post(unsigned* bar, volatile LAS unsigned* st) {
    XcdBarrier b; b.bar = bar; b.x = xb_xcc_id(); b.st = st;
    if (threadIdx.x == 0) (void)xb_add(&bar[XB_XCNT(b.x)], 1u);
    return b;
}
__device__ __forceinline__ void xcd_barrier_complete(unsigned* bar, unsigned x, unsigned& nloc, unsigned& nx) {
    const unsigned G = gridDim.x * gridDim.y * gridDim.z;
    unsigned sum, cnt, mine, sp = 0u;
    for (;;) {
        sum = 0u; cnt = 0u; mine = 0u;
#pragma unroll
        for (unsigned j = 0; j < 16; ++j) { const unsigned c = xb_ld(&bar[XB_XCNT(j)]); sum += c; cnt += (c > 0u) ? 1u : 0u; mine = (j == x) ? c : mine; }
        if (sum == G) break;
        __builtin_amdgcn_s_sleep(1);
        if ((++sp & 255u) == 0u) { if (xb_ld(&bar[XB_TMO])) break; if (sp > XB_SPIN_CAP) { atomicAdd(&bar[XB_TMO], 1u); break; } }
    }
    nloc = mine > 0u ? mine : 1u; nx = cnt > 0u ? cnt : 1u;
}

__device__ __forceinline__ void xcd_barrier(const XcdBarrier& b) {
    asm volatile("s_waitcnt vmcnt(0)" ::: "memory");
    __syncthreads();
    if (threadIdx.x == 0) {
        unsigned* bar = b.bar;
        __builtin_amdgcn_s_waitcnt(0);
        unsigned nloc = b.st[0], nx = b.st[1];
        if (nloc == 0u) { xcd_barrier_complete(bar, b.x, nloc, nx); b.st[0] = nloc; b.st[1] = nx; }
        const unsigned old = xb_add(&bar[XB_XSUB(b.x)], 1u);
        const unsigned gen = old / nloc;
        if (old + 1u == (gen + 1u) * nloc) {
            __builtin_amdgcn_fence(__ATOMIC_RELEASE, "agent");
            asm volatile("s_waitcnt vmcnt(0)" ::: "memory");
            const unsigned og = xb_add(&bar[XB_TOP], 1u);
            const unsigned tg = og / nx;
            if (og + 1u == (tg + 1u) * nx) xb_add(&bar[XB_TOPGEN], 1u);
            else XB_SPIN(xb_ld(&bar[XB_TOPGEN]) == tg, bar);
            __builtin_amdgcn_fence(__ATOMIC_ACQUIRE, "agent");
            xb_add(&bar[XB_XGEN(b.x)], 1u);
            asm volatile("s_waitcnt vmcnt(0)" ::: "memory");
        } else {
            XB_SPIN(xb_ld(&bar[XB_XGEN(b.x)]) == gen, bar);
            __builtin_amdgcn_fence(__ATOMIC_ACQUIRE, "agent");
            asm volatile("s_waitcnt vmcnt(0)" ::: "memory");
        }
    }
    __syncthreads();
}

__device__ __forceinline__ const void* ldarg(int byteoff) { const void* r;
    asm volatile("s_load_dwordx2 %0, %1, %2\n\ts_waitcnt lgkmcnt(0)" : "=s"(r) : "s"(__builtin_amdgcn_kernarg_segment_ptr()), "i"(byteoff) : "memory"); return r; }
#define LDA(i) ((const float*)ldarg(8 * (i)))
#define GASF __attribute__((address_space(1)))
__device__ __forceinline__ Params load_params() {
    unsigned long long v0, v1, v2, v3, v4, v5, v6, v7, v8, v9, v10, v11, v12, v13, v14, v15, v16;
    asm volatile("s_load_dwordx2 %0, %17, 0\n\ts_load_dwordx2 %1, %17, 8\n\ts_load_dwordx2 %2, %17, 16\n\ts_load_dwordx2 %3, %17, 24\n\ts_load_dwordx2 %4, %17, 32\n\ts_load_dwordx2 %5, %17, 40\n\t"
                 "s_load_dwordx2 %6, %17, 48\n\ts_load_dwordx2 %7, %17, 56\n\ts_load_dwordx2 %8, %17, 64\n\ts_load_dwordx2 %9, %17, 72\n\ts_load_dwordx2 %10, %17, 80\n\ts_load_dwordx2 %11, %17, 88\n\t"
                 "s_load_dwordx2 %12, %17, 96\n\ts_load_dwordx2 %13, %17, 104\n\ts_load_dwordx2 %14, %17, 112\n\ts_load_dwordx2 %15, %17, 120\n\ts_load_dwordx2 %16, %17, 128\n\ts_waitcnt lgkmcnt(0)"
                 : "=&s"(v0), "=&s"(v1), "=&s"(v2), "=&s"(v3), "=&s"(v4), "=&s"(v5), "=&s"(v6), "=&s"(v7), "=&s"(v8), "=&s"(v9),
                   "=&s"(v10), "=&s"(v11), "=&s"(v12), "=&s"(v13), "=&s"(v14), "=&s"(v15), "=&s"(v16)
                 : "s"(__builtin_amdgcn_kernarg_segment_ptr()) : "memory");
#define GP(v) ((const float*)(GASF const float*)(v))
    Params q; q.x = GP(v0); q.c = GP(v1); q.w_ada = GP(v2); q.b_ada = GP(v3); q.n1g = GP(v4); q.w_in = GP(v5); q.b_f = GP(v6); q.qg = GP(v7); q.kg = GP(v8); q.cmw = GP(v9);
    q.w_out = GP(v10); q.n2g = GP(v11); q.w_up = GP(v12); q.fcw = GP(v13); q.w_down = GP(v14); q.out = (float*)(GASF float*)(v15); q.ws = (unsigned char*)(GASF unsigned char*)(v16);
    return q; }
#ifndef PH
#define PH 255
#endif
#ifndef PROBE_DUP
#define PROBE_DUP 0
#endif
#ifndef LAST_PHASE
#define LAST_PHASE 99
#endif
__global__ void __launch_bounds__(512, 2) hymba_mega(Params p_arg) {
    extern __shared__ __attribute__((aligned(16))) unsigned char lds_raw[];
    cg::grid_group grid = cg::this_grid();
    LAS unsigned char* lds = (LAS unsigned char*)lds_raw;
    const int tid = threadIdx.x, lane = tid & 63, wave = __builtin_amdgcn_readfirstlane(tid >> 6);
    const int G = gridDim.x, bx = blockIdx.x;
    if (p_arg.ws == nullptr) grid.sync();
    if (tid < 2) ((volatile LAS unsigned*)(lds + 131072))[tid] = 0u;
    __syncthreads();
    const XcdBarrier xbar = xcd_barrier_post((unsigned*)((unsigned char*)(GASF unsigned char*)(unsigned long long)ldarg(8 * 16) + WS_BAR), (volatile LAS unsigned*)(lds + 131072));
#define GSYNC() xcd_barrier(xbar)

#if PH & 1
    { const Params p = load_params(); phase0(p, lds, tid, lane, wave); }
#endif
    GSYNC();
#if PH & 2
    { const Params p = load_params(); phase1(p, lds, tid, lane, wave); }
#endif
    GSYNC();
#if PH & 4
    {
        const Params p = load_params();
        if (bx < 64) scan_item(p, lds, bx, tid, lane, wave);
        pg8::Gemm g{(const bf16_t*)(p.ws + WS_H), (const bf16_t*)(p.ws + WS_WIN), T_, 3072, 1024}; pg8::StaticOrder S; S.init(T_, 3072, G, bx);
        EpiIn E{(bf16_t*)(p.ws + WS_Q), (bf16_t*)(p.ws + WS_K), (bf16_t*)(p.ws + WS_VT), (bf16_t*)(p.ws + WS_Z), (bf16_t*)(p.ws + WS_BG), p.qg, p.kg};
        pg8::gemm_phase<EpiIn, pg8::StaticOrder, true, true>(lds, g, S, E);
    }
#endif
    GSYNC();
#if PH & 8
    { const Params p = load_params(); phase3(p, lds, tid, lane, wave); }
#endif
    GSYNC();
#if PH & 16
    {
        const Params p = load_params();
        pg8::Gemm g{(const bf16_t*)(p.ws + WS_MIX), (const bf16_t*)(p.ws + WS_WOUT), T_, 1024, 1024}; pg8::StaticOrder S; S.init(T_, 1024, G, bx);
        EpiOut E{p.x, (const float*)(p.ws + WS_MOD), p.n2g, p.out, (bf16_t*)(p.ws + WS_H), (float*)(p.ws + WS_ROWSS), (bf16_t*)(p.ws + WS_TAIL)};
        pg8::gemm_phase<EpiOut, pg8::StaticOrder, true, true>(lds, g, S, E);
#if PROBE_DUP == 7
        GSYNC();
        pg8::gemm_phase<EpiOut, pg8::StaticOrder, true, true>(lds, g, S, E);
#endif
    }
#endif
    GSYNC();
#if PH & 32
    {
        const Params p = load_params();
        pg8::Gemm g{(const bf16_t*)(p.ws + WS_H), (const bf16_t*)(p.ws + WS_WUP), 65 * 256, 2 * DFF, 1024};
        UpOrder S; S.init(65 * 256, 2 * DFF, G, bx); S.tail_off = (long)WS_TAIL - (long)WS_H;
        EpiUpF E{(const float*)(p.ws + WS_ROWSS), (const float*)(p.ws + WS_BIAS2), p.fcw, (bf16_t*)(p.ws + WS_ACT), (LAS float*)(lds + XCH_OFF)};
        pg8::gemm_phase<EpiUpF, UpOrder, true, true>(lds, g, S, E);
    }
#endif
    GSYNC();
#if PH & 128
    {
        const Params p = load_params();
        pg8::Gemm g{(const bf16_t*)(p.ws + WS_ACT), (const bf16_t*)(p.ws + WS_WDOWN), T_, 1024, DFF}; pg8::StaticOrder S; S.init(T_, 1024, G, bx);
        EpiDown E{(const float*)(p.ws + WS_MOD), p.out};
        pg8::gemm_phase<EpiDown, pg8::StaticOrder, true, true>(lds, g, S, E);
    }
#endif
}

extern "C" void kernel_launch(void* const* d_in, const int* in_sizes, int n_in, void* d_out, int out_size, void* d_ws, size_t ws_size, hipStream_t stream) {
    static int grid = 0;
    if (grid == 0) {
        int dev = 0, cus = 0, per_cu = 0;
        hipGetDevice(&dev); hipDeviceGetAttribute(&cus, hipDeviceAttributeMultiprocessorCount, dev);
        if (hipFuncSetAttribute((const void*)hymba_mega, hipFuncAttributeMaxDynamicSharedMemorySize, LDS_BYTES) != hipSuccess) fprintf(stderr, "hipFuncSetAttribute failed\n");
        if (hipOccupancyMaxActiveBlocksPerMultiprocessor(&per_cu, (const void*)hymba_mega, 512, LDS_BYTES) != hipSuccess || per_cu < 1) { fprintf(stderr, "occupancy query: %d\n", per_cu); per_cu = 1; }
        (void)hipGetLastError();
        grid = cus > 0 ? cus : 256;
    }
    Params p{};
    p.x = (const float*)d_in[0]; p.c = (const float*)d_in[1]; p.w_ada = (const float*)d_in[2]; p.b_ada = (const float*)d_in[3]; p.n1g = (const float*)d_in[4];
    p.w_in = (const float*)d_in[5]; p.b_f = (const float*)d_in[6]; p.qg = (const float*)d_in[7]; p.kg = (const float*)d_in[8]; p.cmw = (const float*)d_in[9];
    p.w_out = (const float*)d_in[10]; p.n2g = (const float*)d_in[11]; p.w_up = (const float*)d_in[12]; p.fcw = (const float*)d_in[13]; p.w_down = (const float*)d_in[14];
    p.out = (float*)d_out; p.ws = (unsigned char*)d_ws;
    (void)hipMemsetAsync((unsigned char*)d_ws + WS_BAR, 0, 16384, stream);
    void* args[] = {&p};
    hipError_t e = hipLaunchCooperativeKernel((const void*)hymba_mega, dim3(grid), dim3(512), args, LDS_BYTES, stream);
    if (e != hipSuccess) fprintf(stderr, "cooperative launch failed: %s (grid %d)\n", hipGetErrorString(e), grid);
}
```

```cpp
#include <hip/hip_runtime.h>
#include <hip/hip_cooperative_groups.h>
#include <cstdio>
#include <cstdint>
namespace cg = cooperative_groups;
namespace pg8 {
#define PG8_LAS __attribute__((address_space(3)))
typedef unsigned short bf16_t;
typedef short bf16x8 __attribute__((ext_vector_type(8)));
typedef float f32x4 __attribute__((ext_vector_type(4)));
typedef unsigned u32x4 __attribute__((ext_vector_type(4)));
constexpr int BM = 256, BK = 64, HALF = 128, HTB = HALF * BK * 2  , STAGE_BYTES = 8 * HTB, NXCD = 8, WGM = 8;

__host__ __device__ __forceinline__ int lds_byte(int r, int c) { const int st = (r >> 4) * 2 + (c >> 5), rr = r & 15, cc = c & 31, ob = rr * 64 + cc * 2; return st * 1024 + (ob ^ (((ob >> 9) & 1) << 5)); }
__host__ __device__ __forceinline__ void stage_rc(int b, int& R, int& C) { const int st = b / 1024, sb = b % 1024, swz = sb ^ (((sb >> 9) & 1) << 5); R = (st >> 1) * 16 + swz / 64; C = (st & 1) * 32 + (swz % 64) / 2; }
__host__ __device__ __forceinline__ int perm32(int rho) { const int n = rho >> 4, i = rho & 15; return 8 * (i >> 2) + 4 * n + (i & 3); }

struct Unit { int pm, pn; };
struct Gemm { const bf16_t* A; const bf16_t* Bt; int M, N, K; };

struct StaticOrder {
    int nM, nN, nwg, G, c;
    __host__ __device__ void init(int M, int N, int G_, int c_) { nM = M / BM; nN = N / BM; nwg = nM * nN; G = G_; c = c_; }
    __host__ __device__ bool next(int i, Unit& u) const {
        const long L = (long)i * G + c; if (L >= nwg) return false;
        int wgid = (int)L; { const int q = nwg / NXCD, r = nwg % NXCD, xcd = wgid % NXCD, off = wgid / NXCD; wgid = (xcd < r ? xcd * (q + 1) : r * (q + 1) + (xcd - r) * q) + off; }
        const int nig = WGM * nN, gid = wgid / nig, fm = gid * WGM, gsz = (nM - fm) < WGM ? (nM - fm) : WGM;
        u.pm = fm + ((wgid % nig) % gsz); u.pn = (wgid % nig) / gsz; return true;
    }
    __device__ __forceinline__ void a_ready(const Unit&) const {}
    __device__ __forceinline__ void done(const Unit&) const {}
    __device__ __forceinline__ long a_off(int pm, size_t tstep) const { return (long)pm * (long)tstep; }
};

__device__ __forceinline__ unsigned cvt_pk_bf16(float lo, float hi) { unsigned r; asm volatile("v_cvt_pk_bf16_f32 %0, %1, %2" : "=v"(r) : "v"(lo), "v"(hi)); return r; }
typedef float f32x2 __attribute__((ext_vector_type(2)));
template <class Epi, class Sched, bool ALIGN_EPI = false, bool SP2 = false>
__device__ __forceinline__ void gemm_phase(PG8_LAS unsigned char* lds, const Gemm g, const Sched& S, const Epi& E) {
    int tid_o = threadIdx.x; asm volatile("" : "+v"(tid_o));
    const int tid = tid_o & 511, wid = __builtin_amdgcn_readfirstlane(tid >> 6), lane = tid & 63, wr = wid >> 2, wc = wid & 3, fr = lane & 15, fq = lane >> 4;
    const int K = g.K, nt = K / BK;
    unsigned voffA[2], voffB[2];
#pragma unroll
    for (int i = 0; i < 2; ++i) { int R, C; stage_rc(tid * 16 + i * 8192, R, C); const int Rb = Epi::PERM ? ((R & ~31) + perm32(R & 31)) : R;
        voffA[i] = (unsigned)(R * K + C) * 2u; voffB[i] = (unsigned)(Rb * K + C) * 2u; }
    const size_t kstep = (size_t)(BK * 2);
    const size_t hstep = (size_t)HALF * K * 2;
    const size_t tstep = 2 * hstep;
    const unsigned ldsw = (unsigned)wid * 1024u;
    const int aoff = lds_byte(wr * 64 + fr, fq * 8), boff = lds_byte(wc * 32 + fr, fq * 8);
#define PG8_SA(b, h) (((b) * 2 + (h)) * HTB)
#define PG8_SB(b, h) ((4 + (b) * 2 + (h)) * HTB)
#define PG8_STAGE(bufoff, gbase, voff) do { _Pragma("unroll") for (int _i = 0; _i < 2; ++_i) \
        __builtin_amdgcn_global_load_lds((const unsigned*)((const char*)(gbase) + (voff)[_i]), (PG8_LAS unsigned*)(lds + (bufoff) + ldsw + _i * 8192), 16, 0, 0); } while (0)
#define PG8_LDA(dst, b, h) do { _Pragma("unroll") for (int m = 0; m < 4; ++m) _Pragma("unroll") for (int k = 0; k < 2; ++k) dst[m][k] = *(const PG8_LAS bf16x8*)(lds + PG8_SA(b, h) + aoff + m * 2048 + k * 1024); } while (0)
#define PG8_LDB(dst, b, h) do { _Pragma("unroll") for (int n = 0; n < 2; ++n) _Pragma("unroll") for (int k = 0; k < 2; ++k) dst[n][k] = *(const PG8_LAS bf16x8*)(lds + PG8_SB(b, h) + boff + n * 2048 + k * 1024); } while (0)
#define PG8_MMA(ai, bj, At, Bt) do { __builtin_amdgcn_s_setprio(1); _Pragma("unroll") for (int m = 0; m < 4; ++m) _Pragma("unroll") for (int n = 0; n < 2; ++n) _Pragma("unroll") for (int k = 0; k < 2; ++k) \
        acc[ai][bj][m][n] = __builtin_amdgcn_mfma_f32_16x16x32_bf16(Bt[n][k], At[m][k], acc[ai][bj][m][n], 0, 0, 0); __builtin_amdgcn_s_setprio(0); } while (0)
#define PG8_WAIT_V(n) asm volatile("s_waitcnt vmcnt(" #n ")" ::: "memory")
#define PG8_WAIT_L(n) asm volatile("s_waitcnt lgkmcnt(" #n ")" ::: "memory")
#define PG8_BAR __builtin_amdgcn_s_barrier()
#define PG8_SCHED __builtin_amdgcn_sched_barrier(0)
    Unit cur, nxt; int ui = 0;
    if (!S.next(0, cur)) return;
    f32x4 acc[2][2][4][2];
#pragma unroll
    for (int a = 0; a < 2; ++a)
#pragma unroll
        for (int b = 0; b < 2; ++b)
#pragma unroll
            for (int m = 0; m < 4; ++m)
#pragma unroll
                for (int n = 0; n < 2; ++n) acc[a][b][m][n] = (f32x4){0.f, 0.f, 0.f, 0.f};
    bf16x8 At[4][2], B0[2][2], B1[2][2];
    const char* cA = (const char*)g.A + S.a_off(cur.pm, tstep); const char* cB = (const char*)g.Bt + (size_t)cur.pn * tstep;
    S.a_ready(cur);
    if constexpr (SP2) {
        PG8_STAGE(PG8_SB(0, 0), cB, voffB); PG8_STAGE(PG8_SB(0, 1), cB + hstep, voffB); PG8_STAGE(PG8_SA(0, 0), cA, voffA); PG8_STAGE(PG8_SA(0, 1), cA + hstep, voffA);
        if (wr == 1) PG8_BAR;
        PG8_WAIT_V(2); PG8_BAR;
        PG8_STAGE(PG8_SB(1, 0), cB + kstep, voffB); PG8_STAGE(PG8_SA(1, 0), cA + kstep, voffA); PG8_STAGE(PG8_SB(1, 1), cB + hstep + kstep, voffB);
        PG8_WAIT_V(6); PG8_BAR;
    } else {
        PG8_STAGE(PG8_SB(0, 0), cB, voffB); PG8_STAGE(PG8_SA(0, 0), cA, voffA); PG8_STAGE(PG8_SB(0, 1), cB + hstep, voffB); PG8_STAGE(PG8_SA(0, 1), cA + hstep, voffA);
        if (wr == 1) PG8_BAR;
        PG8_WAIT_V(4); PG8_BAR;
        PG8_STAGE(PG8_SB(1, 0), cB + kstep, voffB); PG8_STAGE(PG8_SA(1, 0), cA + kstep, voffA); PG8_STAGE(PG8_SB(1, 1), cB + hstep + kstep, voffB);
        PG8_WAIT_V(6); PG8_BAR;
    }
    for (;;) {
        const bool has_next = S.next(ui + 1, nxt);
        const char* nA = has_next ? (const char*)g.A + S.a_off(nxt.pm, tstep) : cA; const char* nB = has_next ? (const char*)g.Bt + (size_t)nxt.pn * tstep : cB;
        for (int t = 0; t < nt; t += 2) {
            const bool last = (t == nt - 2);
            const char* a1 = cA + (size_t)(t + 1) * kstep;
            const char* a2 = last ? nA : cA + (size_t)(t + 2) * kstep; const char* b2 = last ? nB : cB + (size_t)(t + 2) * kstep;
            const char* a3 = a2 + kstep; const char* b3 = b2 + kstep;
            if (last && has_next) S.a_ready(nxt);
            if constexpr (SP2) {
            PG8_LDB(B0, 0, 0); PG8_LDB(B1, 0, 1); PG8_SCHED; PG8_LDA(At, 0, 0); PG8_STAGE(PG8_SA(1, 1), a1 + hstep, voffA);
            PG8_WAIT_V(8); PG8_WAIT_L(0); PG8_BAR; PG8_MMA(0, 0, At, B0); PG8_MMA(0, 1, At, B1); PG8_BAR; PG8_SCHED;
            PG8_LDA(At, 0, 1); PG8_STAGE(PG8_SB(0, 0), b2, voffB); PG8_STAGE(PG8_SB(0, 1), b2 + hstep, voffB); PG8_STAGE(PG8_SA(0, 0), a2, voffA);
            PG8_WAIT_V(8); PG8_WAIT_L(0); PG8_BAR; PG8_MMA(1, 0, At, B0); PG8_MMA(1, 1, At, B1); PG8_BAR; PG8_SCHED;
            PG8_LDB(B0, 1, 0); PG8_LDB(B1, 1, 1); PG8_SCHED; PG8_LDA(At, 1, 0); PG8_STAGE(PG8_SA(0, 1), a2 + hstep, voffA);
            PG8_WAIT_V(8); PG8_WAIT_L(0); PG8_BAR; PG8_MMA(0, 0, At, B0); PG8_MMA(0, 1, At, B1); PG8_BAR; PG8_SCHED;
            PG8_LDA(At, 1, 1); PG8_STAGE(PG8_SB(1, 0), b3, voffB); PG8_STAGE(PG8_SB(1, 1), b3 + hstep, voffB); PG8_STAGE(PG8_SA(1, 0), a3, voffA);
            PG8_WAIT_V(8); PG8_WAIT_L(0); PG8_BAR; PG8_MMA(1, 0, At, B0); PG8_MMA(1, 1, At, B1); PG8_BAR; PG8_SCHED;
            } else {
            PG8_LDB(B0, 0, 0); PG8_SCHED; PG8_LDA(At, 0, 0); PG8_STAGE(PG8_SA(1, 1), a1 + hstep, voffA);
            PG8_WAIT_L(8); PG8_BAR; PG8_WAIT_L(0); PG8_MMA(0, 0, At, B0); PG8_BAR; PG8_SCHED;
            PG8_LDB(B1, 0, 1); PG8_STAGE(PG8_SB(0, 0), b2, voffB);
            PG8_BAR; PG8_WAIT_L(0); PG8_MMA(0, 1, At, B1); PG8_BAR;
            PG8_LDA(At, 0, 1); PG8_STAGE(PG8_SA(0, 0), a2, voffA);
            PG8_BAR; PG8_WAIT_L(0); PG8_MMA(1, 0, At, B0); PG8_BAR; PG8_SCHED;
            PG8_STAGE(PG8_SB(0, 1), b2 + hstep, voffB);
            PG8_WAIT_V(6); PG8_BAR; PG8_MMA(1, 1, At, B1); PG8_BAR;
            PG8_LDB(B0, 1, 0); PG8_SCHED; PG8_LDA(At, 1, 0); PG8_STAGE(PG8_SA(0, 1), a2 + hstep, voffA);
            PG8_WAIT_L(8); PG8_BAR; PG8_WAIT_L(0); PG8_MMA(0, 0, At, B0); PG8_BAR; PG8_SCHED;
            PG8_LDB(B1, 1, 1); PG8_STAGE(PG8_SB(1, 0), b3, voffB);
            PG8_BAR; PG8_WAIT_L(0); PG8_MMA(0, 1, At, B1); PG8_BAR;
            PG8_LDA(At, 1, 1); PG8_STAGE(PG8_SA(1, 0), a3, voffA);
            PG8_BAR; PG8_WAIT_L(0); PG8_MMA(1, 0, At, B0); PG8_BAR; PG8_SCHED;
            PG8_STAGE(PG8_SB(1, 1), b3 + hstep, voffB);
            PG8_WAIT_V(6); PG8_BAR; PG8_MMA(1, 1, At, B1); PG8_BAR;
            }
        }
        if constexpr (ALIGN_EPI) { if (wr == 0) PG8_BAR; }
        if constexpr (!Epi::AFTER_DRAIN) { E(acc, cur, wr, wc, fr, fq); S.done(cur); }
        if (!has_next) break;
#pragma unroll
        for (int a = 0; a < 2; ++a)
#pragma unroll
            for (int b = 0; b < 2; ++b)
#pragma unroll
                for (int m = 0; m < 4; ++m)
#pragma unroll
                    for (int n = 0; n < 2; ++n) acc[a][b][m][n] = (f32x4){0.f, 0.f, 0.f, 0.f};
        cur = nxt; cA = nA; cB = nB; ++ui;
        if constexpr (ALIGN_EPI) { if (wr == 1) PG8_BAR; }
    }
    PG8_WAIT_V(0);
    if constexpr (!ALIGN_EPI) { if (wr == 0) PG8_BAR; }
    PG8_BAR;
    if constexpr (Epi::AFTER_DRAIN) { E.fused(acc, cur, wr, wc, fr, fq, lds, wid, lane); S.done(cur); }
#undef PG8_SA
#undef PG8_SB
#undef PG8_STAGE
#undef PG8_LDA
#undef PG8_LDB
#undef PG8_MMA
#undef PG8_WAIT_V
#undef PG8_WAIT_L
#undef PG8_BAR
#undef PG8_SCHED
}
}
#define LAS __attribute__((address_space(3)))
typedef unsigned short bf16_t;
typedef short bf16x8 __attribute__((ext_vector_type(8)));
typedef float f32x4 __attribute__((ext_vector_type(4)));
typedef float f32x16 __attribute__((ext_vector_type(16)));
typedef unsigned u32x4 __attribute__((ext_vector_type(4)));
typedef unsigned u32x2 __attribute__((ext_vector_type(2)));
constexpr int T_ = 16384, D_ = 1024, S_ = 2048, NH = 8, DFF = 2816, DIN = 3080, NMOD = 6144, HALFC = 1408;
constexpr float EPS = 1e-6f;
constexpr float LOG2E = 1.4426950408889634f;
constexpr float C2 = 0.125f * LOG2E;
constexpr size_t MiB = 1u << 20;
constexpr size_t WS_MOD = 0, WS_BIAS2 = 256 * 1024, WS_ROWSS = 31 * MiB, WS_BAR = 640 * 1024, WS_LOGF = 1 * MiB, WS_QAUG = 2 * MiB, WS_KAUG = 4 * MiB,
    WS_WIN = 6 * MiB, WS_WOUT = 12 * MiB, WS_WUP = 14 * MiB, WS_WDOWN = 25 * MiB, WS_H = 32 * MiB, WS_Q = 64 * MiB, WS_K = 80 * MiB,
    WS_VT = 96 * MiB, WS_Z = 112 * MiB, WS_BG = 128 * MiB, WS_MIX = 144 * MiB, WS_ACT = 160 * MiB, WS_TAIL = 30 * MiB + 512 * 1024;
constexpr int LDS_BYTES = 139328;
constexpr int XCH_OFF = 131072 + 64;

struct Params {
    const float *x, *c, *w_ada, *b_ada, *n1g, *w_in, *b_f, *qg, *kg, *cmw, *w_out, *n2g, *w_up, *fcw, *w_down;
    float* out; unsigned char* ws;
};

__device__ __forceinline__ float wave_sum(float v) {
#pragma unroll
    for (int o = 1; o < 64; o <<= 1) v += __shfl_xor(v, o);
    return v;
}
__device__ __forceinline__ unsigned f2bf(float f) { unsigned u = __builtin_bit_cast(unsigned, f); return (u + 0x7fffu + ((u >> 16) & 1u)) >> 16; }
__device__ __forceinline__ float bf2f(unsigned h) { return __builtin_bit_cast(float, h << 16); }
__device__ __forceinline__ unsigned pk2(float lo, float hi) { return pg8::cvt_pk_bf16(lo, hi); }
typedef float f32x2_t __attribute__((ext_vector_type(2))); typedef __bf16 bf16x2_t __attribute__((ext_vector_type(2)));
__device__ __forceinline__ unsigned cvtpk_s(float lo, float hi) { f32x2_t v = {lo, hi}; bf16x2_t b = __builtin_convertvector(v, bf16x2_t); return __builtin_bit_cast(unsigned, b); }
__device__ __forceinline__ void unpack8(u32x4 w, float (&f)[8]) {
    f[0] = bf2f(w.x & 0xffffu); f[1] = __builtin_bit_cast(float, w.x & 0xffff0000u);
    f[2] = bf2f(w.y & 0xffffu); f[3] = __builtin_bit_cast(float, w.y & 0xffff0000u);
    f[4] = bf2f(w.z & 0xffffu); f[5] = __builtin_bit_cast(float, w.z & 0xffff0000u);
    f[6] = bf2f(w.w & 0xffffu); f[7] = __builtin_bit_cast(float, w.w & 0xffff0000u);
}
__device__ __forceinline__ u32x4 pack8(const float (&f)[8]) { u32x4 w; w.x = pk2(f[0], f[1]); w.y = pk2(f[2], f[3]); w.z = pk2(f[4], f[5]); w.w = pk2(f[6], f[7]); return w; }

__device__ __forceinline__ void transpose_item(const float* W, int N, int K, bf16_t* WT, int dstrow0, int srccol0, int k0, LAS float* scr, int lane) {
    float tv[32];
    { const float* wp = W + (size_t)(k0 + (lane >> 5)) * N + srccol0 + (lane & 31);
#pragma unroll
      for (int i = 0; i < 32; ++i) tv[i] = wp[(size_t)(2 * i) * N]; }
#pragma unroll
    for (int i = 0; i < 32; ++i) scr[(2 * i + (lane >> 5)) * 33 + (lane & 31)] = tv[i];
    asm volatile("s_waitcnt lgkmcnt(0)" ::: "memory");
    const int c = lane & 7;
#pragma unroll
    for (int j = 0; j < 4; ++j) { const int n = (lane >> 3) + 8 * j; const LAS float* s = scr + (8 * c) * 33 + n;
        u32x4 o; o.x = pk2(s[0 * 33], s[1 * 33]); o.y = pk2(s[2 * 33], s[3 * 33]); o.z = pk2(s[4 * 33], s[5 * 33]); o.w = pk2(s[6 * 33], s[7 * 33]);
        *(u32x4*)(WT + (size_t)(dstrow0 + n) * K + k0 + 8 * c) = o; }
    asm volatile("s_waitcnt lgkmcnt(0)" ::: "memory");
}
__device__ __forceinline__ int win_src(int p0) {
    const int pn = p0 >> 8, c = p0 & 255, bj = c >> 7, wc = (c & 127) >> 5;
    if (pn < 6) return (pn >> 1) * 512 + (4 * (pn & 1) + wc) * 64 + 32 * bj;
    if (pn < 10) return (bj == 0 ? 1544 : 2568) + 128 * (pn - 6) + (c & 127);
    return 2056 + 256 * (pn - 10) + c;
}
__device__ __forceinline__ int wup_src(int p0) { const int j = p0 >> 8, c = p0 & 255; return (c < 128) ? 128 * j + c : DFF + 128 * j + (c - 128); }

__device__ __forceinline__ void gemv_item(const float* W, int N, int n0, const float* bias, const LAS float* vecs, LAS float* red, float* out, int tid) {
    const int cgp = tid & 7, kg = tid >> 3;
    float acc[8][4];
#pragma unroll
    for (int b = 0; b < 8; ++b)
#pragma unroll
        for (int j = 0; j < 4; ++j) acc[b][j] = 0.f;
#pragma unroll 4
    for (int i = 0; i < 16; ++i) { const int k = kg + 64 * i; const f32x4 w = *(const f32x4*)(W + (size_t)k * N + n0 + 4 * cgp);
#pragma unroll
        for (int b = 0; b < 8; ++b) { const float v = vecs[b * 1024 + k]; acc[b][0] += v * w.x; acc[b][1] += v * w.y; acc[b][2] += v * w.z; acc[b][3] += v * w.w; } }
#pragma unroll
    for (int b = 0; b < 8; ++b) *(LAS f32x4*)(red + (kg * 8 + b) * 32 + 4 * cgp) = (f32x4){acc[b][0], acc[b][1], acc[b][2], acc[b][3]};
    __syncthreads();
    if (tid < 256) { const int b = tid >> 5, col = tid & 31; float s = 0.f;
#pragma unroll 8
      for (int g = 0; g < 64; ++g) s += red[(g * 8 + b) * 32 + col];
      out[(size_t)b * N + n0 + col] = s + (bias ? bias[n0 + col] : 0.f); }
    __syncthreads();
}

__device__ __forceinline__ void transposes(const Params& p, LAS unsigned char* lds, int it_begin, int it_end, int gw, int NGW, int lane, int wave) {
    LAS float* scr = (LAS float*)(lds + wave * 8704);
    constexpr int I_IN = 16 * 96, I_OUT = 16 * 32, I_UP = 16 * 176;
    for (int it = it_begin + gw; it < it_end; it += NGW) {
        int r = it;
        if (r < I_IN) { const int kb = r / 96, nb = r % 96; transpose_item(p.w_in, DIN, 1024, (bf16_t*)(p.ws + WS_WIN), 32 * nb, win_src(32 * nb), 64 * kb, scr, lane); continue; } r -= I_IN;
        if (r < I_OUT) { const int kb = r / 32, nb = r % 32; transpose_item(p.w_out, 1024, 1024, (bf16_t*)(p.ws + WS_WOUT), 32 * nb, 32 * nb, 64 * kb, scr, lane); continue; } r -= I_OUT;
        if (r < I_UP) { const int kb = r / 176, nb = r % 176; transpose_item(p.w_up, 2 * DFF, 1024, (bf16_t*)(p.ws + WS_WUP), 32 * nb, wup_src(32 * nb), 64 * kb, scr, lane); continue; } r -= I_UP;
        { const int kb = r / 32, nb = r % 32; transpose_item(p.w_down, 1024, DFF, (bf16_t*)(p.ws + WS_WDOWN), 32 * nb, 32 * nb, 64 * kb, scr, lane); }
    }
}
constexpr int NIT_IN = 16 * 96, NIT_ALL = 16 * 96 + 16 * 32 + 16 * 176 + 44 * 32;
__device__ __forceinline__ void phase0(const Params& p, LAS unsigned char* lds, int tid, int lane, int wave) {
    float* mod = (float*)(p.ws + WS_MOD);
    const int ngemv = gridDim.x > 192 ? 192 : gridDim.x;
    if (blockIdx.x < ngemv) {
        LAS float* vecs = (LAS float*)lds; LAS float* red = (LAS float*)(lds + 32768);
        for (int i = tid; i < 8192; i += 512) { const float v = p.c[i]; vecs[i] = v / (1.f + __expf(-v)); }
        __syncthreads();
        for (int it = blockIdx.x; it < 192; it += ngemv) gemv_item(p.w_ada, NMOD, 32 * it, p.b_ada, vecs, red, mod, tid);
    } else {
        transposes(p, lds, 0, NIT_IN, (blockIdx.x - 192) * 8 + wave, (gridDim.x - 192) * 8, lane, wave);
    }
}

__device__ __forceinline__ void phase1(const Params& p, LAS unsigned char* lds, int tid, int lane, int wave) {
    const float* mod = (const float*)(p.ws + WS_MOD);
    if (blockIdx.x < 176) {
        LAS float* vecs = (LAS float*)lds; LAS float* red = (LAS float*)(lds + 32768);
        for (int i = tid; i < 8192; i += 512) vecs[i] = mod[(i >> 10) * NMOD + 3072 + (i & 1023)];
        __syncthreads();
        for (int it = blockIdx.x; it < 176; it += gridDim.x) gemv_item(p.w_up, 2 * DFF, 32 * it, nullptr, vecs, red, (float*)(p.ws + WS_BIAS2), tid);
    }
    transposes(p, lds, gridDim.x > 192 ? NIT_IN : 0, NIT_ALL, blockIdx.x * 8 + wave, gridDim.x * 8, lane, wave);
    __syncthreads();
    LAS float* wf = (LAS float*)lds;
    for (int i = tid; i < 8192; i += 512) { const int k = i >> 3, h = i & 7; wf[h * 1024 + k] = p.w_in[(size_t)k * DIN + 1536 + h]; }
    __syncthreads();
    bf16_t* hb = (bf16_t*)(p.ws + WS_H); float* logf = (float*)(p.ws + WS_LOGF);
    const int gw = blockIdx.x * 8 + wave, NGW = gridDim.x * 8;
    f32x4 vn[4];
    if (gw < T_) {
#pragma unroll
        for (int j = 0; j < 4; ++j) vn[j] = *(const f32x4*)(p.x + (size_t)gw * D_ + 4 * lane + 256 * j); }
    for (int row = gw; row < T_; row += NGW) {
        const int b = row >> 11; const float* mb = mod + b * NMOD;
        f32x4 v[4]; float ss = 0.f;
#pragma unroll
        for (int j = 0; j < 4; ++j) { v[j] = vn[j]; ss += (v[j].x * v[j].x + v[j].y * v[j].y) + (v[j].z * v[j].z + v[j].w * v[j].w); }
        if (row + NGW < T_) {
#pragma unroll
            for (int j = 0; j < 4; ++j) vn[j] = *(const f32x4*)(p.x + (size_t)(row + NGW) * D_ + 4 * lane + 256 * j); }
        const float rstd = rsqrtf(wave_sum(ss) * (1.f / D_) + EPS);
#pragma unroll
        for (int j = 0; j < 4; ++j) { const int col = 4 * lane + 256 * j;
            const f32x4 g = *(const f32x4*)(p.n1g + col), sc = *(const f32x4*)(mb + 1024 + col), sh = *(const f32x4*)(mb + col);
            v[j] = (v[j] * rstd) * g * (sc + 1.f) + sh;
            u32x2 w; w.x = pk2(v[j].x, v[j].y); w.y = pk2(v[j].z, v[j].w);
            *(u32x2*)(hb + (size_t)row * D_ + col) = w; }
        float fg[8];
#pragma unroll
        for (int h = 0; h < 8; ++h) { float s = 0.f;
#pragma unroll
            for (int j = 0; j < 4; ++j) { const f32x4 w = *(const LAS f32x4*)(wf + h * 1024 + 4 * lane + 256 * j); s += (v[j].x * w.x + v[j].y * w.y) + (v[j].z * w.z + v[j].w * w.w); }
            fg[h] = wave_sum(s); }
        float z = fg[0];
#pragma unroll
        for (int h = 1; h < 8; ++h) z = (lane == h) ? fg[h] : z;
        if (lane < 8) { z += p.b_f[lane]; logf[(size_t)row * 8 + lane] = fminf(z, 0.f) - log1pf(expf(-fabsf(z))); }
    }
    __syncthreads();
}

__device__ __forceinline__ void scan_item(const Params& p, LAS unsigned char* lds, int bh, int tid, int lane, int wave) {
    const float* logf = (const float*)(p.ws + WS_LOGF); const int b = bh >> 3, h = bh & 7;
    LAS float* wt = (LAS float*)lds;
    float a[4];
#pragma unroll
    for (int i = 0; i < 4; ++i) a[i] = logf[((size_t)(b * S_ + 4 * tid + i)) * 8 + h];
    a[1] += a[0]; a[2] += a[1]; a[3] += a[2];
    float sc = a[3];
#pragma unroll
    for (int o = 1; o < 64; o <<= 1) { const float y = __shfl_up(sc, o); if (lane >= o) sc += y; }
    if (lane == 63) wt[wave] = sc;
    __syncthreads();
    float off = sc - a[3];
    for (int w = 0; w < wave; ++w) off += wt[w];
    u32x4* qa = (u32x4*)(p.ws + WS_QAUG) + (size_t)bh * S_ + 4 * tid; u32x4* ka = (u32x4*)(p.ws + WS_KAUG) + (size_t)bh * S_ + 4 * tid;
#pragma unroll
    for (int i = 0; i < 4; ++i) { const float F = (off + a[i]) * LOG2E;
        const unsigned hi = f2bf(F); const float r1 = F - bf2f(hi); const unsigned mid = f2bf(r1); const float r2 = r1 - bf2f(mid); const unsigned lo = f2bf(r2);
        u32x4 q, k; q.x = hi | (mid << 16); q.y = lo | (0x3F80u << 16); q.z = 0x3F803F80u; q.w = 0u;
        k.x = 0x3F803F80u; k.y = 0x3F80u | ((hi ^ 0x8000u) << 16); k.z = (mid ^ 0x8000u) | ((lo ^ 0x8000u) << 16); k.w = 0u;
        qa[i] = q; ka[i] = k; }
    __syncthreads();
}
struct EpiIn {
    static constexpr bool PERM = true, AFTER_DRAIN = false;
    bf16_t *Q, *K, *Vt, *Z, *BG; const float *qg, *kg;
    __device__ __forceinline__ void operator()(const f32x4 (&acc)[2][2][4][2], const pg8::Unit& u, int wr, int wc, int fr, int fq) const {
        const int pn = u.pn; const int row0 = u.pm * 256 + wr * 64 + fr;
        if (pn < 4) {
            const bool isq = pn < 2; const float* g = isq ? qg : kg; bf16_t* dst = isq ? Q : K; const int head = 4 * (pn & 1) + wc; const float mul = isq ? C2 : 1.f;
            f32x4 gv[2][2];
#pragma unroll
            for (int bj = 0; bj < 2; ++bj)
#pragma unroll
                for (int n = 0; n < 2; ++n) gv[bj][n] = *(const f32x4*)(g + 32 * bj + 8 * fq + 4 * n) * mul;
#pragma unroll
            for (int ai = 0; ai < 2; ++ai)
#pragma unroll
                for (int m = 0; m < 4; ++m) {
                    float ss = 0.f;
#pragma unroll
                    for (int bj = 0; bj < 2; ++bj)
#pragma unroll
                        for (int n = 0; n < 2; ++n) { const f32x4 a = acc[ai][bj][m][n]; ss += (a.x * a.x + a.y * a.y) + (a.z * a.z + a.w * a.w); }
                    ss += __shfl_xor(ss, 16); ss += __shfl_xor(ss, 32);
                    const float rinv = rsqrtf(ss * (1.f / 64.f) + EPS);
                    const unsigned row = (unsigned)(row0 + ai * 128 + m * 16);
#pragma unroll
                    for (int bj = 0; bj < 2; ++bj) { const f32x4 v0 = acc[ai][bj][m][0] * rinv * gv[bj][0], v1 = acc[ai][bj][m][1] * rinv * gv[bj][1];
                        u32x4 w; w.x = pk2(v0.x, v0.y); w.y = pk2(v0.z, v0.w); w.z = pk2(v1.x, v1.y); w.w = pk2(v1.z, v1.w);
                        *(u32x4*)(dst + row * 512 + head * 64 + 32 * bj + 8 * fq) = w; }
                }
        } else if (pn < 6) {
            const int head = 4 * (pn & 1) + wc, b = u.pm >> 3;
            bf16_t* vb = Vt + (size_t)((b * 8 + head) * 64) * S_;
#pragma unroll
            for (int ai = 0; ai < 2; ++ai)
#pragma unroll
                for (int m = 0; m < 4; ++m) { const int t = (row0 + ai * 128 + m * 16) & (S_ - 1);
                    const int tp = (t & ~15) | (((t >> 2) & 1) << 3) | (((t >> 3) & 1) << 2) | (t & 3);
#pragma unroll
                    for (int bj = 0; bj < 2; ++bj)
#pragma unroll
                        for (int n = 0; n < 2; ++n) { const f32x4 a = acc[ai][bj][m][n]; const int d = 32 * bj + 8 * fq + 4 * n;
                            vb[(unsigned)((d + 0) * S_ + tp)] = (bf16_t)f2bf(a.x); vb[(unsigned)((d + 1) * S_ + tp)] = (bf16_t)f2bf(a.y);
                            vb[(unsigned)((d + 2) * S_ + tp)] = (bf16_t)f2bf(a.z); vb[(unsigned)((d + 3) * S_ + tp)] = (bf16_t)f2bf(a.w); }
                }
        } else if (pn < 10) {
            const int ch0 = 128 * (pn - 6) + 32 * wc + 8 * fq;
#pragma unroll
            for (int ai = 0; ai < 2; ++ai)
#pragma unroll
                for (int m = 0; m < 4; ++m) { const unsigned row = (unsigned)(row0 + ai * 128 + m * 16);
                    const f32x4 v0 = acc[ai][0][m][0] * acc[ai][1][m][0], v1 = acc[ai][0][m][1] * acc[ai][1][m][1];
                    u32x4 w; w.x = pk2(v0.x, v0.y); w.y = pk2(v0.z, v0.w); w.z = pk2(v1.x, v1.y); w.w = pk2(v1.z, v1.w);
                    *(u32x4*)(Z + row * 512 + ch0) = w; }
        } else {
#pragma unroll
            for (int ai = 0; ai < 2; ++ai)
#pragma unroll
                for (int m = 0; m < 4; ++m) { const unsigned row = (unsigned)(row0 + ai * 128 + m * 16);
#pragma unroll
                    for (int bj = 0; bj < 2; ++bj) { const f32x4 v0 = acc[ai][bj][m][0], v1 = acc[ai][bj][m][1];
                        u32x4 w; w.x = pk2(v0.x, v0.y); w.y = pk2(v0.z, v0.w); w.z = pk2(v1.x, v1.y); w.w = pk2(v1.z, v1.w);
                        *(u32x4*)(BG + row * 512 + 256 * (pn - 10) + 128 * bj + 32 * wc + 8 * fq) = w; } }
        }
    }
};
struct EpiOut {
    static constexpr bool PERM = true, AFTER_DRAIN = false;
    const float* x; const float* mod; const float* n2g; float* out; bf16_t* A2; float* rowss; bf16_t* A2tail;
    __device__ __forceinline__ void operator()(const f32x4 (&acc)[2][2][4][2], const pg8::Unit& u, int wr, int wc, int fr, int fq) const {
        const int b = u.pm >> 3, colb = u.pn * 256 + wc * 32 + 8 * fq; const int row0 = u.pm * 256 + wr * 64 + fr;
        const float* mb = mod + b * NMOD;
        f32x4 g1v[2][2], gm[2][2];
#pragma unroll
        for (int bj = 0; bj < 2; ++bj)
#pragma unroll
            for (int n = 0; n < 2; ++n) { const int col = colb + 128 * bj + 4 * n; g1v[bj][n] = *(const f32x4*)(mb + 2048 + col);
                gm[bj][n] = *(const f32x4*)(n2g + col) * (*(const f32x4*)(mb + 4096 + col) + 1.f); }
#pragma unroll
        for (int ai = 0; ai < 2; ++ai) {
            f32x4 xv[4][2][2];
#pragma unroll
            for (int m = 0; m < 4; ++m)
#pragma unroll
                for (int bj = 0; bj < 2; ++bj)
#pragma unroll
                    for (int n = 0; n < 2; ++n) xv[m][bj][n] = *(const f32x4*)(x + ((unsigned)(row0 + ai * 128 + m * 16) * D_ + colb + 128 * bj + 4 * n));
#pragma unroll
            for (int m = 0; m < 4; ++m) { const unsigned row = (unsigned)(row0 + ai * 128 + m * 16); float ss = 0.f;
#pragma unroll
                for (int bj = 0; bj < 2; ++bj) { f32x4 x1[2];
#pragma unroll
                    for (int n = 0; n < 2; ++n) { const unsigned off = row * D_ + colb + 128 * bj + 4 * n;
                        x1[n] = xv[m][bj][n] + g1v[bj][n] * acc[ai][bj][m][n]; *(f32x4*)(out + off) = x1[n];
                        ss += (x1[n].x * x1[n].x + x1[n].y * x1[n].y) + (x1[n].z * x1[n].z + x1[n].w * x1[n].w); x1[n] = x1[n] * gm[bj][n]; }
                    u32x4 w; w.x = pk2(x1[0].x, x1[0].y); w.y = pk2(x1[0].z, x1[0].w); w.z = pk2(x1[1].x, x1[1].y); w.w = pk2(x1[1].z, x1[1].w);
                    *(u32x4*)(A2 + row * D_ + colb + 128 * bj) = w;
                    { const unsigned t = row & (S_ - 1); if (t >= 2016u) *(u32x4*)(A2tail + ((row >> 11) * 32 + (t - 2016u)) * D_ + colb + 128 * bj) = w; } }
                ss += __shfl_xor(ss, 16); ss += __shfl_xor(ss, 32);
                if (fq == 0) rowss[row * 16 + u.pn * 4 + wc] = ss; }
            asm volatile("" ::: "memory");
        }
    }
};
struct EpiUp {
    static constexpr bool PERM = true, AFTER_DRAIN = false;
    const float* rowss; const float* bias2; bf16_t* U; int half;
    __device__ __forceinline__ void operator()(const f32x4 (&acc)[2][2][4][2], const pg8::Unit& u, int wr, int wc, int fr, int fq) const {
        const int b = u.pm >> 3; const int row0 = u.pm * 256 + wr * 64 + fr;
        f32x4 bv[2][2];
#pragma unroll
        for (int bj = 0; bj < 2; ++bj)
#pragma unroll
            for (int n = 0; n < 2; ++n) bv[bj][n] = *(const f32x4*)(bias2 + b * (2 * DFF) + bj * DFF + half * HALFC + 128 * u.pn + 32 * wc + 8 * fq + 4 * n);
#pragma unroll
        for (int ai = 0; ai < 2; ++ai)
#pragma unroll
            for (int m = 0; m < 4; ++m) { const unsigned row = (unsigned)(row0 + ai * 128 + m * 16); const f32x4 s4 = *(const f32x4*)(rowss + row * 16 + 4 * fq); float sq = (s4.x + s4.y) + (s4.z + s4.w); sq += __shfl_xor(sq, 16); sq += __shfl_xor(sq, 32);
                const float rstd = rsqrtf(sq * (1.f / D_) + EPS);
#pragma unroll
                for (int bj = 0; bj < 2; ++bj) { const f32x4 v0 = acc[ai][bj][m][0] * rstd + bv[bj][0], v1 = acc[ai][bj][m][1] * rstd + bv[bj][1];
                    u32x4 w; w.x = pk2(v0.x, v0.y); w.y = pk2(v0.z, v0.w); w.z = pk2(v1.x, v1.y); w.w = pk2(v1.z, v1.w);
                    *(u32x4*)(U + (row * DFF + 256 * u.pn + 128 * bj + 32 * wc + 8 * fq)) = w; } }
    }
};

__device__ __forceinline__ float dpp_f(float old, float src, int which) {
    const int o = __builtin_bit_cast(int, old), v = __builtin_bit_cast(int, src); int r;
    if (which == 0) r = __builtin_amdgcn_update_dpp(o, v, 0x111, 0xf, 0xf, false);
    else if (which == 1) r = __builtin_amdgcn_update_dpp(o, v, 0x112, 0xf, 0xf, false);
    else if (which == 2) r = __builtin_amdgcn_update_dpp(o, v, 0x121, 0xf, 0xf, false);
    else r = __builtin_amdgcn_update_dpp(o, v, 0x122, 0xf, 0xf, false);
    return __builtin_bit_cast(float, r);
}
struct UpOrder : pg8::StaticOrder {
    long tail_off;
    __device__ __forceinline__ long a_off(int pm, size_t) const { return pm < 64 ? ((long)((pm >> 3) * S_ + 254 * (pm & 7) - 2)) * (D_ * 2) : tail_off; }
};
struct EpiUpF {
    static constexpr bool PERM = true, AFTER_DRAIN = false;
    const float* rowss; const float* bias2; const float* fcw; bf16_t* act; LAS float* xch;
    __device__ __forceinline__ void operator()(f32x4 (&acc)[2][2][4][2], const pg8::Unit& u, int wr, int wc, int fr, int fq) const {
        if (u.pm == 64) run<true>(acc, u, wr, wc, fr, fq); else run<false>(acc, u, wr, wc, fr, fq);
    }
    template <bool tail> __device__ __forceinline__ void run(f32x4 (&acc)[2][2][4][2], const pg8::Unit& u, int wr, int wc, int fr_in, int fq_in) const {
        int fr = fr_in, fq = fq_in; asm volatile("" : "+v"(fr), "+v"(fq));
        fr &= 15; fq &= 3;
        const int pm = u.pm, pn = u.pn; const int breg = pm >> 3, ireg = pm & 7;
        const int rbase = wr * 64 + fr, colg = 32 * wc + 8 * fq, chan0 = 128 * pn + colg;
        const int tok0 = breg * S_ + 254 * ireg - 2;
        const bool zfirst = !tail && ireg == 0 && wr == 0 && fr < 2;
        float rstd[2][4];
#pragma unroll
        for (int ai = 0; ai < 2; ++ai)
#pragma unroll
            for (int m = 0; m < 4; ++m) {
                const int r = rbase + 128 * ai + 16 * m; int grow = tail ? (r >> 5) * S_ + 2016 + (r & 31) : tok0 + r; grow = grow < 0 ? 0 : grow;
                const f32x4 s4 = *(const f32x4*)(rowss + (unsigned)grow * 16 + 4 * fq); float sq = (s4.x + s4.y) + (s4.z + s4.w); sq += __shfl_xor(sq, 16); sq += __shfl_xor(sq, 32);
                rstd[ai][m] = rsqrtf(sq * (1.f / D_) + EPS);
            }
#pragma unroll
        for (int ai = 0; ai < 2; ++ai) { const float* bp = bias2 + (tail ? (4 * ai + 2 * wr + 1) : breg) * (2 * DFF) + chan0;
#pragma unroll
            for (int bj = 0; bj < 2; ++bj)
#pragma unroll
                for (int n = 0; n < 2; ++n) { const f32x4 v = acc[ai][bj][3][n] * rstd[ai][3] + *(const f32x4*)(bp + bj * DFF + 4 * n);
                    if (fr >= 14) *(LAS f32x4*)(xch + (((2 * ai + wr) * 2 + (fr - 14)) * 256 + 128 * bj + colg + 4 * n)) = v; } }
        asm volatile("s_waitcnt lgkmcnt(0)" ::: "memory"); __builtin_amdgcn_s_barrier(); asm volatile("" ::: "memory");
#pragma unroll
        for (int n = 0; n < 2; ++n) {
            const float* wp = fcw + chan0 + 4 * n;
            const f32x4 wg0 = *(const f32x4*)(wp), wg1 = *(const f32x4*)(wp + 2 * DFF), wg2 = *(const f32x4*)(wp + 4 * DFF);
            const f32x4 wv0 = *(const f32x4*)(wp + DFF), wv1 = *(const f32x4*)(wp + 3 * DFF), wv2 = *(const f32x4*)(wp + 5 * DFF);
            f32x4 bg = (f32x4){0.f, 0.f, 0.f, 0.f}, bvl = bg;
            if (!tail) { bg = *(const f32x4*)(bias2 + breg * (2 * DFF) + chan0 + 4 * n); bvl = *(const f32x4*)(bias2 + breg * (2 * DFF) + DFF + chan0 + 4 * n); }
#pragma unroll
            for (int ai = 0; ai < 2; ++ai) {
                const int slot = 2 * ai + wr - 1;
                f32x4 g14 = (f32x4){0.f, 0.f, 0.f, 0.f}, g15 = g14, v14 = g14, v15 = g14;
                if (slot >= 0) { const LAS float* xp = xch + (slot * 2) * 256 + colg + 4 * n;
                    g14 = *(const LAS f32x4*)(xp); g15 = *(const LAS f32x4*)(xp + 256); v14 = *(const LAS f32x4*)(xp + 128); v15 = *(const LAS f32x4*)(xp + 256 + 128); }
                f32x4 pg = g14, pv = g14;
#pragma unroll
                for (int m = 0; m < 4; ++m) {
                    const int r = rbase + 128 * ai + 16 * m;
                    if (tail) { const float* bp = bias2 + (4 * ai + 2 * wr + (m >> 1)) * (2 * DFF) + chan0 + 4 * n; bg = *(const f32x4*)(bp); bvl = *(const f32x4*)(bp + DFF); }
                    f32x4 cg_ = acc[ai][0][m][n] * rstd[ai][m] + bg, cv_ = acc[ai][1][m][n] * rstd[ai][m] + bvl;
                    if (ai == 0 && m == 0) { if (zfirst) { cg_ = (f32x4){0.f, 0.f, 0.f, 0.f}; cv_ = cg_; } }
                    float o[4];
#pragma unroll
                    for (int e = 0; e < 4; ++e) {
                        float o1g, o2g, o1v, o2v;
                        if (m == 0) { o1g = g15[e]; o2g = (fr == 0) ? g14[e] : g15[e]; o1v = v15[e]; o2v = (fr == 0) ? v14[e] : v15[e]; }
                        else { o1g = dpp_f(0.f, pg[e], 2); o2g = dpp_f(0.f, pg[e], 3); o1v = dpp_f(0.f, pv[e], 2); o2v = dpp_f(0.f, pv[e], 3); }
                        const float p1g = dpp_f(o1g, cg_[e], 0), p2g = dpp_f(o2g, cg_[e], 1), p1v = dpp_f(o1v, cv_[e], 0), p2v = dpp_f(o2v, cv_[e], 1);
                        const float G = wg0[e] * p2g + wg1[e] * p1g + wg2[e] * cg_[e], V = wv0[e] * p2v + wv1[e] * p1v + wv2[e] * cv_[e];
                        o[e] = G * __builtin_amdgcn_rcpf(1.f + __expf(-G)) * V;
                    }
                    pg = cg_; pv = cv_;
                    bool outv; int tg;
                    if (tail) { outv = (m & 1) != 0; tg = (r >> 5) * S_ + 2016 + (r & 31); } else { outv = r >= 2; tg = tok0 + r; }
                    if (outv) { u32x2 w; w.x = pk2(o[0], o[1]); w.y = pk2(o[2], o[3]); *(u32x2*)(act + ((unsigned)tg * DFF + chan0 + 4 * n)) = w; }
                    __builtin_amdgcn_sched_barrier(0);
                }
            }
        }
    }
};
struct EpiDown {
    static constexpr bool PERM = true, AFTER_DRAIN = false;
    const float* mod; float* out; float* dst;
    __device__ __forceinline__ void operator()(const f32x4 (&acc)[2][2][4][2], const pg8::Unit& u, int wr, int wc, int fr, int fq) const {
        const int b = u.pm >> 3, colb = u.pn * 256 + wc * 32 + 8 * fq; const int row0 = u.pm * 256 + wr * 64 + fr;
        const float* mb = mod + b * NMOD + 5120;
        f32x4 g2v[2][2];
#pragma unroll
        for (int bj = 0; bj < 2; ++bj)
#pragma unroll
            for (int n = 0; n < 2; ++n) g2v[bj][n] = *(const f32x4*)(mb + colb + 128 * bj + 4 * n);
#pragma unroll
        for (int ai = 0; ai < 2; ++ai) {
            f32x4 xv[4][2][2];
#pragma unroll
            for (int m = 0; m < 4; ++m)
#pragma unroll
                for (int bj = 0; bj < 2; ++bj)
#pragma unroll
                    for (int n = 0; n < 2; ++n) xv[m][bj][n] = *(const f32x4*)(out + ((unsigned)(row0 + ai * 128 + m * 16) * D_ + colb + 128 * bj + 4 * n));
#pragma unroll
            for (int m = 0; m < 4; ++m) { const unsigned row = (unsigned)(row0 + ai * 128 + m * 16);
#pragma unroll
                for (int bj = 0; bj < 2; ++bj)
#pragma unroll
                    for (int n = 0; n < 2; ++n) { const unsigned o_ = row * D_ + colb + 128 * bj + 4 * n; *(f32x4*)(dst + o_) = xv[m][bj][n] + g2v[bj][n] * acc[ai][bj][m][n]; } }
            asm volatile("" ::: "memory");
        }
    }
};

__device__ __forceinline__ int crow(int r, int hi) { return (r & 3) + 8 * (r >> 2) + 4 * hi; }
constexpr int AB_K = 0, AB_V = 9216, AB_A = 18432, ABUF = 19456, A_LW = 2 * ABUF;
__device__ __forceinline__ void attn_unit(const Params& p, LAS unsigned char* lds, int bh, int qb, float mshift, int tid, int lane, int wave) {
    const int r32 = lane & 31, hi = lane >> 5, b = bh >> 3, h = bh & 7;
    const bf16_t* Qg = (const bf16_t*)(p.ws + WS_Q); const bf16_t* Kg = (const bf16_t*)(p.ws + WS_K); const bf16_t* Vg = (const bf16_t*)(p.ws + WS_VT);
    const u32x4* qaug = (const u32x4*)(p.ws + WS_QAUG) + (size_t)bh * S_; const u32x4* kaug = (const u32x4*)(p.ws + WS_KAUG) + (size_t)bh * S_;
    bf16_t* mix = (bf16_t*)(p.ws + WS_MIX);
    const int q_rel = 32 * wave + r32, tq = 256 * qb + q_rel;
    bf16x8 qr[4], qa;
    { const bf16_t* qp = Qg + ((size_t)(b * S_ + tq)) * 512 + h * 64 + 8 * hi;
#pragma unroll
      for (int d0 = 0; d0 < 4; ++d0) qr[d0] = *(const bf16x8*)(qp + 16 * d0);
      u32x4 t = qaug[tq]; if (hi) t = (u32x4){0u, 0u, 0u, 0u}; qa = __builtin_bit_cast(bf16x8, t); }
    f32x16 o[2]; float lsum = 0.f;
#pragma unroll
    for (int i = 0; i < 16; ++i) { o[0][i] = 0.f; o[1][i] = 0.f; }
    const int NT = 4 * (qb + 1);
    const int srow = tid >> 3, sch = tid & 7;
    const bf16_t* kp = Kg + ((size_t)(b * S_ + srow)) * 512 + h * 64 + 8 * sch;
    const bf16_t* vp = Vg + ((size_t)(bh * 64 + srow)) * S_ + 8 * sch;
    u32x4 kreg = *(const u32x4*)kp, vreg = *(const u32x4*)vp, areg = (u32x4){0u, 0u, 0u, 0u};
    if (tid < 64) areg = kaug[tid];
    { LAS unsigned char* bb = lds; *(LAS u32x4*)(bb + AB_K + srow * 144 + sch * 16) = kreg; *(LAS u32x4*)(bb + AB_V + srow * 144 + sch * 16) = vreg; if (tid < 64) *(LAS u32x4*)(bb + AB_A + tid * 16) = areg; }
    __syncthreads();
    for (int j = 0; j < NT; ++j) {
        const bool more = (j + 1 < NT);
        if (more) { kreg = *(const u32x4*)(kp + (size_t)(j + 1) * 64 * 512); vreg = *(const u32x4*)(vp + (j + 1) * 64); if (tid < 64) areg = kaug[(j + 1) * 64 + tid]; }
        const LAS unsigned char* bb = lds + (j & 1) * ABUF;
        const int jb = j - 4 * qb;
#pragma unroll
        for (int kh = 0; kh < 2; ++kh) {
            if (jb >= 0 && 64 * jb + 32 * kh > 32 * wave + 31) continue;
            f32x16 C;
#pragma unroll
            for (int i = 0; i < 16; ++i) C[i] = -mshift;
            const LAS unsigned char* kr = bb + AB_K + (32 * kh + r32) * 144 + hi * 16;
#pragma unroll
            for (int d0 = 0; d0 < 4; ++d0) { const bf16x8 a = *(const LAS bf16x8*)(kr + d0 * 32); C = __builtin_amdgcn_mfma_f32_32x32x16_bf16(a, qr[d0], C, 0, 0, 0); }
            { u32x4 t = *(const LAS u32x4*)(bb + AB_A + (32 * kh + r32) * 16); if (hi) t = (u32x4){0u, 0u, 0u, 0u};
              C = __builtin_amdgcn_mfma_f32_32x32x16_bf16(__builtin_bit_cast(bf16x8, t), qa, C, 0, 0, 0); }
            if (jb >= 0) {
#pragma unroll
                for (int i = 0; i < 16; ++i) { const int kv = 64 * jb + 32 * kh + crow(i, hi); if (kv > q_rel) C[i] = -INFINITY; }
            }
#pragma unroll
            for (int i = 0; i < 16; ++i) { C[i] = __builtin_amdgcn_exp2f(C[i]); lsum += C[i]; }
#pragma unroll
            for (int s = 0; s < 2; ++s) {
                u32x4 pw; pw.x = cvtpk_s(C[8 * s + 0], C[8 * s + 1]); pw.y = cvtpk_s(C[8 * s + 2], C[8 * s + 3]); pw.z = cvtpk_s(C[8 * s + 4], C[8 * s + 5]); pw.w = cvtpk_s(C[8 * s + 6], C[8 * s + 7]);
                const bf16x8 pa = __builtin_bit_cast(bf16x8, pw);
#pragma unroll
                for (int dh = 0; dh < 2; ++dh) { const bf16x8 vf = *(const LAS bf16x8*)(bb + AB_V + (32 * dh + r32) * 144 + (32 * kh + 16 * s + 8 * hi) * 2);
                    o[dh] = __builtin_amdgcn_mfma_f32_32x32x16_bf16(pa, vf, o[dh], 0, 0, 0); }
            }
        }
        if (more) { LAS unsigned char* nb = lds + ((j + 1) & 1) * ABUF; *(LAS u32x4*)(nb + AB_K + srow * 144 + sch * 16) = kreg; *(LAS u32x4*)(nb + AB_V + srow * 144 + sch * 16) = vreg; if (tid < 64) *(LAS u32x4*)(nb + AB_A + tid * 16) = areg; }
        __syncthreads();
    }
    lsum += __shfl_xor(lsum, 32);
    LAS float* lw = (LAS float*)(lds + A_LW + wave * 128);
    if (hi == 0) lw[r32] = lsum;
    asm volatile("s_waitcnt lgkmcnt(0)" ::: "memory");
    bf16_t* op = mix + ((size_t)(b * S_ + 256 * qb + 32 * wave)) * D_ + h * 64 + r32;
#pragma unroll
    for (int i = 0; i < 16; ++i) { const int qq = crow(i, hi); const float rl = 1.f / lw[qq];
        op[(size_t)qq * D_] = (bf16_t)f2bf(o[0][i] * rl); op[(size_t)qq * D_ + 32] = (bf16_t)f2bf(o[1][i] * rl); }
    asm volatile("s_waitcnt lgkmcnt(0)" ::: "memory");
}

__device__ __forceinline__ void phase3(const Params& p, LAS unsigned char* lds, int tid, int lane, int wave) {
    float mq = 0.f, mk = 0.f;
    for (int i = 0; i < 64; ++i) { mq = fmaxf(mq, fabsf(p.qg[i])); mk = fmaxf(mk, fabsf(p.kg[i])); }
    const float mshift = 8.f * LOG2E * 1.03f * mq * mk;
    const int G = gridDim.x, bx = blockIdx.x; const int vcu = (G % 8 == 0) ? (bx % 8) * (G / 8) + bx / 8 : bx;
    for (int pr = vcu; pr < 256; pr += G) { const int bh = pr >> 2, s = pr & 3;
        attn_unit(p, lds, bh, 7 - s, mshift, tid, lane, wave);
        attn_unit(p, lds, bh, s, mshift, tid, lane, wave); }
    const bf16_t* Z = (const bf16_t*)(p.ws + WS_Z); const bf16_t* BG = (const bf16_t*)(p.ws + WS_BG); bf16_t* mix = (bf16_t*)(p.ws + WS_MIX);
    for (int it = bx * 512 + tid; it < (T_ / 8) * 64; it += G * 512) {
        const int rc = it >> 6, c0 = 8 * (it & 63), t0 = 8 * rc;
        float w0[8], w1[8], w2[8], z1[8], z2[8];
#pragma unroll
        for (int i = 0; i < 8; ++i) { w0[i] = p.cmw[c0 + i]; w1[i] = p.cmw[512 + c0 + i]; w2[i] = p.cmw[1024 + c0 + i]; z1[i] = 0.f; z2[i] = 0.f; }
        if (t0 & (S_ - 1)) { unpack8(*(const u32x4*)(Z + (size_t)(t0 - 2) * 512 + c0), z2); unpack8(*(const u32x4*)(Z + (size_t)(t0 - 1) * 512 + c0), z1); }
#pragma unroll
        for (int r = 0; r < 8; ++r) { float zc[8], bg[8], ov[8];
            unpack8(*(const u32x4*)(Z + (size_t)(t0 + r) * 512 + c0), zc); unpack8(*(const u32x4*)(BG + (size_t)(t0 + r) * 512 + c0), bg);
#pragma unroll
            for (int i = 0; i < 8; ++i) { ov[i] = bg[i] * (w0[i] * z2[i] + w1[i] * z1[i] + w2[i] * zc[i]); z2[i] = z1[i]; z1[i] = zc[i]; }
            *(u32x4*)(mix + (size_t)(t0 + r) * D_ + 512 + c0) = pack8(ov); }
    }
}

#define XB_TMO      128
#define XB_XCNT(j)  (256  + 64 * (j))
#define XB_XSUB(j)  (1280 + 64 * (j))
#define XB_XGEN(j)  (2304 + 64 * (j))
#define XB_TOP      3328
#define XB_TOPGEN   3392
#define XCD_BAR_WORDS 3456
#define XB_SPIN_CAP (1u << 18)

__device__ __forceinline__ unsigned xb_ld(unsigned* p)              { return __hip_atomic_load(p, __ATOMIC_RELAXED, __HIP_MEMORY_SCOPE_AGENT); }
__device__ __forceinline__ unsigned xb_add(unsigned* p, unsigned v) { return __hip_atomic_fetch_add(p, v, __ATOMIC_RELAXED, __HIP_MEMORY_SCOPE_AGENT); }
__device__ __forceinline__ unsigned xb_xcc_id() { return (unsigned)__builtin_amdgcn_s_getreg((3 << 11) | 20) & 0xFu; }
#define XB_SPIN(cond, bar) do { unsigned _sp = 0; while (cond) { __builtin_amdgcn_s_sleep(1); \
    if ((++_sp & 255u) == 0u) { if (xb_ld(&(bar)[XB_TMO])) break; if (_sp > XB_SPIN_CAP) { atomicAdd(&(bar)[XB_TMO], 1u); break; } } } } while (0)

struct XcdBarrier {
    unsigned* bar; unsigned x;
    volatile LAS unsigned* st;
};

__device__ __forceinline__ XcdBarrier xcd_barrier_post(unsigned* bar, volatile LAS unsigned* st) {
    XcdBarrier b; b.bar = bar; b.x = xb_xcc_id(); b.st = st;
    if (threadIdx.x == 0) (void)xb_add(&bar[XB_XCNT(b.x)], 1u);
    return b;
}
__device__ __forceinline__ void xcd_barrier_complete(unsigned* bar, unsigned x, unsigned& nloc, unsigned& nx) {
    const unsigned G = gridDim.x * gridDim.y * gridDim.z;
    unsigned sum, cnt, mine, sp = 0u;
    for (;;) {
        sum = 0u; cnt = 0u; mine = 0u;
#pragma unroll
        for (unsigned j = 0; j < 16; ++j) { const unsigned c = xb_ld(&bar[XB_XCNT(j)]); sum += c; cnt += (c > 0u) ? 1u : 0u; mine = (j == x) ? c : mine; }
        if (sum == G) break;
        __builtin_amdgcn_s_sleep(1);
        if ((++sp & 255u) == 0u) { if (xb_ld(&bar[XB_TMO])) break; if (sp > XB_SPIN_CAP) { atomicAdd(&bar[XB_TMO], 1u); break; } }
    }
    nloc = mine > 0u ? mine : 1u; nx = cnt > 0u ? cnt : 1u;
}

__device__ __forceinline__ void xcd_barrier(const XcdBarrier& b) {
    asm volatile("s_waitcnt vmcnt(0)" ::: "memory");
    __syncthreads();
    if (threadIdx.x == 0) {
        unsigned* bar = b.bar;
        __builtin_amdgcn_s_waitcnt(0);
        unsigned nloc = b.st[0], nx = b.st[1];
        if (nloc == 0u) { xcd_barrier_complete(bar, b.x, nloc, nx); b.st[0] = nloc; b.st[1] = nx; }
        const unsigned old = xb_add(&bar[XB_XSUB(b.x)], 1u);
        const unsigned gen = old / nloc;
        if (old + 1u == (gen + 1u) * nloc) {
            __builtin_amdgcn_fence(__ATOMIC_RELEASE, "agent");
            asm volatile("s_waitcnt vmcnt(0)" ::: "memory");
            const unsigned og = xb_add(&bar[XB_TOP], 1u);
            const unsigned tg = og / nx;
            if (og + 1u == (tg + 1u) * nx) xb_add(&bar[XB_TOPGEN], 1u);
            else XB_SPIN(xb_ld(&bar[XB_TOPGEN]) == tg, bar);
            __builtin_amdgcn_fence(__ATOMIC_ACQUIRE, "agent");
            xb_add(&bar[XB_XGEN(b.x)], 1u);
            asm volatile("s_waitcnt vmcnt(0)" ::: "memory");
        } else {
            XB_SPIN(xb_ld(&bar[XB_XGEN(b.x)]) == gen, bar);
            __builtin_amdgcn_fence(__ATOMIC_ACQUIRE, "agent");
            asm volatile("s_waitcnt vmcnt(0)" ::: "memory");
        }
    }
    __syncthreads();
}

__device__ __forceinline__ const void* ldarg(int byteoff) { const void* r;
    asm volatile("s_load_dwordx2 %0, %1, %2\n\ts_waitcnt lgkmcnt(0)" : "=s"(r) : "s"(__builtin_amdgcn_kernarg_segment_ptr()), "i"(byteoff) : "memory"); return r; }
#define LDA(i) ((const float*)ldarg(8 * (i)))
#define GASF __attribute__((address_space(1)))
__device__ __forceinline__ Params load_params() {
    unsigned long long v0, v1, v2, v3, v4, v5, v6, v7, v8, v9, v10, v11, v12, v13, v14, v15, v16;
    asm volatile("s_load_dwordx2 %0, %17, 0\n\ts_load_dwordx2 %1, %17, 8\n\ts_load_dwordx2 %2, %17, 16\n\ts_load_dwordx2 %3, %17, 24\n\ts_load_dwordx2 %4, %17, 32\n\ts_load_dwordx2 %5, %17, 40\n\t"
                 "s_load_dwordx2 %6, %17, 48\n\ts_load_dwordx2 %7, %17, 56\n\ts_load_dwordx2 %8, %17, 64\n\ts_load_dwordx2 %9, %17, 72\n\ts_load_dwordx2 %10, %17, 80\n\ts_load_dwordx2 %11, %17, 88\n\t"
                 "s_load_dwordx2 %12, %17, 96\n\ts_load_dwordx2 %13, %17, 104\n\ts_load_dwordx2 %14, %17, 112\n\ts_load_dwordx2 %15, %17, 120\n\ts_load_dwordx2 %16, %17, 128\n\ts_waitcnt lgkmcnt(0)"
                 : "=&s"(v0), "=&s"(v1), "=&s"(v2), "=&s"(v3), "=&s"(v4), "=&s"(v5), "=&s"(v6), "=&s"(v7), "=&s"(v8), "=&s"(v9),
                   "=&s"(v10), "=&s"(v11), "=&s"(v12), "=&s"(v13), "=&s"(v14), "=&s"(v15), "=&s"(v16)
                 : "s"(__builtin_amdgcn_kernarg_segment_ptr()) : "memory");
#define GP(v) ((const float*)(GASF const float*)(v))
    Params q; q.x = GP(v0); q.c = GP(v1); q.w_ada = GP(v2); q.b_ada = GP(v3); q.n1g = GP(v4); q.w_in = GP(v5); q.b_f = GP(v6); q.qg = GP(v7); q.kg = GP(v8); q.cmw = GP(v9);
    q.w_out = GP(v10); q.n2g = GP(v11); q.w_up = GP(v12); q.fcw = GP(v13); q.w_down = GP(v14); q.out = (float*)(GASF float*)(v15); q.ws = (unsigned char*)(GASF unsigned char*)(v16);
    return q; }
#ifndef PH
#define PH 255
#endif
#ifndef PROBE_DUP
#define PROBE_DUP 0
#endif
#ifndef LAST_PHASE
#define LAST_PHASE 99
#endif
__global__ void __launch_bounds__(512, 2) hymba_mega(Params p_arg) {
    extern __shared__ __attribute__((aligned(16))) unsigned char lds_raw[];
    cg::grid_group grid = cg::this_grid();
    LAS unsigned char* lds = (LAS unsigned char*)lds_raw;
    const int tid = threadIdx.x, lane = tid & 63, wave = __builtin_amdgcn_readfirstlane(tid >> 6);
    const int G = gridDim.x, bx = blockIdx.x;
    if (p_arg.ws == nullptr) grid.sync();
    if (tid < 2) ((volatile LAS unsigned*)(lds + 131072))[tid] = 0u;
    __syncthreads();
    const XcdBarrier xbar = xcd_barrier_post((unsigned*)((unsigned char*)(GASF unsigned char*)(unsigned long long)ldarg(8 * 16) + WS_BAR), (volatile LAS unsigned*)(lds + 131072));
#define GSYNC() xcd_barrier(xbar)

#if PH & 1
    { const Params p = load_params(); phase0(p, lds, tid, lane, wave); }
#endif
    GSYNC();
#if PROBE_DUP == 1
    { const Params p = load_params(); phase0(p, lds, tid, lane, wave); } GSYNC();
#endif
#if PROBE_DUP == 9
    GSYNC(); GSYNC(); GSYNC(); GSYNC(); GSYNC(); GSYNC(); GSYNC(); GSYNC(); GSYNC(); GSYNC();
#endif
#if PH & 2
    { const Params p = load_params(); phase1(p, lds, tid, lane, wave); }
#endif
    GSYNC();
#if PROBE_DUP == 2
    { const Params p = load_params(); phase1(p, lds, tid, lane, wave); } GSYNC();
#endif
#if PH & 4
    {
        const Params p = load_params();
        if (bx < 64) scan_item(p, lds, bx, tid, lane, wave);
        pg8::Gemm g{(const bf16_t*)(p.ws + WS_H), (const bf16_t*)(p.ws + WS_WIN), T_, 3072, 1024}; pg8::StaticOrder S; S.init(T_, 3072, G, bx);
        EpiIn E{(bf16_t*)(p.ws + WS_Q), (bf16_t*)(p.ws + WS_K), (bf16_t*)(p.ws + WS_VT), (bf16_t*)(p.ws + WS_Z), (bf16_t*)(p.ws + WS_BG), p.qg, p.kg};
        pg8::gemm_phase<EpiIn, pg8::StaticOrder, true, true>(lds, g, S, E);
    }
#endif
    GSYNC();
#if PH & 8
    { const Params p = load_params(); phase3(p, lds, tid, lane, wave); }
#endif
    GSYNC();
#if PH & 16
    {
        const Params p = load_params();
        pg8::Gemm g{(const bf16_t*)(p.ws + WS_MIX), (const bf16_t*)(p.ws + WS_WOUT), T_, 1024, 1024}; pg8::StaticOrder S; S.init(T_, 1024, G, bx);
        EpiOut E{p.x, (const float*)(p.ws + WS_MOD), p.n2g, p.out, (bf16_t*)(p.ws + WS_H), (float*)(p.ws + WS_ROWSS), (bf16_t*)(p.ws + WS_TAIL)};
        pg8::gemm_phase<EpiOut, pg8::StaticOrder, true, true>(lds, g, S, E);
#if PROBE_DUP == 7
        GSYNC();
        pg8::gemm_phase<EpiOut, pg8::StaticOrder, true, true>(lds, g, S, E);
#endif
    }
#endif
    GSYNC();
#if PH & 32
    {
        const Params p = load_params();
        pg8::Gemm g{(const bf16_t*)(p.ws + WS_H), (const bf16_t*)(p.ws + WS_WUP), 65 * 256, 2 * DFF, 1024};
        UpOrder S; S.init(65 * 256, 2 * DFF, G, bx); S.tail_off = (long)WS_TAIL - (long)WS_H;
        EpiUpF E{(const float*)(p.ws + WS_ROWSS), (const float*)(p.ws + WS_BIAS2), p.fcw, (bf16_t*)(p.ws + WS_ACT), (LAS float*)(lds + XCH_OFF)};
        pg8::gemm_phase<EpiUpF, UpOrder, true, true>(lds, g, S, E);
#if PROBE_DUP == 5
        GSYNC();
        pg8::gemm_phase<EpiUpF, UpOrder, true, true>(lds, g, S, E);
#endif
    }
#endif
    GSYNC();
#if PH & 128
    {
        const Params p = load_params();
        pg8::Gemm g{(const bf16_t*)(p.ws + WS_ACT), (const bf16_t*)(p.ws + WS_WDOWN), T_, 1024, DFF}; pg8::StaticOrder S; S.init(T_, 1024, G, bx);
#if PROBE_DUP == 8
        { EpiDown E0{(const float*)(p.ws + WS_MOD), p.out, (float*)(p.ws + WS_Q)};
          pg8::gemm_phase<EpiDown, pg8::StaticOrder, true, true>(lds, g, S, E0); GSYNC(); }
#endif
        EpiDown E{(const float*)(p.ws + WS_MOD), p.out, p.out};
        pg8::gemm_phase<EpiDown, pg8::StaticOrder, true, true>(lds, g, S, E);
    }
#endif
}

extern "C" void kernel_launch(void* const* d_in, const int* in_sizes, int n_in, void* d_out, int out_size, void* d_ws, size_t ws_size, hipStream_t stream) {
    static int grid = 0;
    if (grid == 0) {
        int dev = 0, cus = 0, per_cu = 0;
        hipGetDevice(&dev); hipDeviceGetAttribute(&cus, hipDeviceAttributeMultiprocessorCount, dev);
        if (hipFuncSetAttribute((const void*)hymba_mega, hipFuncAttributeMaxDynamicSharedMemorySize, LDS_BYTES) != hipSuccess) fprintf(stderr, "hipFuncSetAttribute failed\n");
        if (hipOccupancyMaxActiveBlocksPerMultiprocessor(&per_cu, (const void*)hymba_mega, 512, LDS_BYTES) != hipSuccess || per_cu < 1) { fprintf(stderr, "occupancy query: %d\n", per_cu); per_cu = 1; }
        (void)hipGetLastError();
        grid = cus > 0 ? cus : 256;
    }
    Params p{};
    p.x = (const float*)d_in[0]; p.c = (const float*)d_in[1]; p.w_ada = (const float*)d_in[2]; p.b_ada = (const float*)d_in[3]; p.n1g = (const float*)d_in[4];
    p.w_in = (const float*)d_in[5]; p.b_f = (const float*)d_in[6]; p.qg = (const float*)d_in[7]; p.kg = (const float*)d_in[8]; p.cmw = (const float*)d_in[9];
    p.w_out = (const float*)d_in[10]; p.n2g = (const float*)d_in[11]; p.w_up = (const float*)d_in[12]; p.fcw = (const float*)d_in[13]; p.w_down = (const float*)d_in[14];
    p.out = (float*)d_out; p.ws = (unsigned char*)d_ws;
    (void)hipMemsetAsync((unsigned char*)d_ws + WS_BAR, 0, 16384, stream);
    void* args[] = {&p};
    hipError_t e = hipLaunchCooperativeKernel((const void*)hymba_mega, dim3(grid), dim3(512), args, LDS_BYTES, stream);
    if (e != hipSuccess) fprintf(stderr, "cooperative launch failed: %s (grid %d)\n", hipGetErrorString(e), grid);
}
```

```cpp
#include <hip/hip_runtime.h>
#include <hip/hip_cooperative_groups.h>
#include <cstdio>
#include <cstdint>
namespace cg = cooperative_groups;
#ifndef PROBE_DUP
#define PROBE_DUP 0
#endif
namespace pg8 {
#define PG8_LAS __attribute__((address_space(3)))
typedef unsigned short bf16_t;
typedef short bf16x8 __attribute__((ext_vector_type(8)));
typedef float f32x4 __attribute__((ext_vector_type(4)));
typedef unsigned u32x4 __attribute__((ext_vector_type(4)));
constexpr int BM = 256, BK = 64, HALF = 128, HTB = HALF * BK * 2  , STAGE_BYTES = 8 * HTB, NXCD = 8, WGM = 8;

__host__ __device__ __forceinline__ int lds_byte(int r, int c) { const int st = (r >> 4) * 2 + (c >> 5), rr = r & 15, cc = c & 31, ob = rr * 64 + cc * 2; return st * 1024 + (ob ^ (((ob >> 9) & 1) << 5)); }
__host__ __device__ __forceinline__ void stage_rc(int b, int& R, int& C) { const int st = b / 1024, sb = b % 1024, swz = sb ^ (((sb >> 9) & 1) << 5); R = (st >> 1) * 16 + swz / 64; C = (st & 1) * 32 + (swz % 64) / 2; }
__host__ __device__ __forceinline__ int perm32(int rho) { const int n = rho >> 4, i = rho & 15; return 8 * (i >> 2) + 4 * n + (i & 3); }

struct Unit { int pm, pn; };
struct Gemm { const bf16_t* A; const bf16_t* Bt; int M, N, K; };

struct StaticOrder {
    int nM, nN, nwg, G, c;
    __host__ __device__ void init(int M, int N, int G_, int c_) { nM = M / BM; nN = N / BM; nwg = nM * nN; G = G_; c = c_; }
    __host__ __device__ bool next(int i, Unit& u) const {
        const long L = (long)i * G + c; if (L >= nwg) return false;
        int wgid = (int)L; { const int q = nwg / NXCD, r = nwg % NXCD, xcd = wgid % NXCD, off = wgid / NXCD; wgid = (xcd < r ? xcd * (q + 1) : r * (q + 1) + (xcd - r) * q) + off; }
        const int nig = WGM * nN, gid = wgid / nig, fm = gid * WGM, gsz = (nM - fm) < WGM ? (nM - fm) : WGM;
        u.pm = fm + ((wgid % nig) % gsz); u.pn = (wgid % nig) / gsz; return true;
    }
    __device__ __forceinline__ void a_ready(const Unit&) const {}
    __device__ __forceinline__ void done(const Unit&) const {}
    __device__ __forceinline__ long a_off(int pm, size_t tstep) const { return (long)pm * (long)tstep; }
};

__device__ __forceinline__ unsigned cvt_pk_bf16(float lo, float hi) { unsigned r; asm volatile("v_cvt_pk_bf16_f32 %0, %1, %2" : "=v"(r) : "v"(lo), "v"(hi)); return r; }
typedef float f32x2 __attribute__((ext_vector_type(2)));
template <class Epi, class Sched, bool ALIGN_EPI = false, bool SP2 = false>
__device__ __forceinline__ void gemm_phase(PG8_LAS unsigned char* lds, const Gemm g, const Sched& S, const Epi& E) {
    int tid_o = threadIdx.x; asm volatile("" : "+v"(tid_o));
    const int tid = tid_o & 511, wid = __builtin_amdgcn_readfirstlane(tid >> 6), lane = tid & 63, wr = wid >> 2, wc = wid & 3, fr = lane & 15, fq = lane >> 4;
    const int K = g.K, nt = K / BK;
    unsigned voffA[2], voffB[2];
#pragma unroll
    for (int i = 0; i < 2; ++i) { int R, C; stage_rc(tid * 16 + i * 8192, R, C); const int Rb = Epi::PERM ? ((R & ~31) + perm32(R & 31)) : R;
        voffA[i] = (unsigned)(R * K + C) * 2u; voffB[i] = (unsigned)(Rb * K + C) * 2u; }
    const size_t kstep = (size_t)(BK * 2);
    const size_t hstep = (size_t)HALF * K * 2;
    const size_t tstep = 2 * hstep;
    const unsigned ldsw = (unsigned)wid * 1024u;
    const int aoff = lds_byte(wr * 64 + fr, fq * 8), boff = lds_byte(wc * 32 + fr, fq * 8);
#define PG8_SA(b, h) (((b) * 2 + (h)) * HTB)
#define PG8_SB(b, h) ((4 + (b) * 2 + (h)) * HTB)
#define PG8_STAGE(bufoff, gbase, voff) do { _Pragma("unroll") for (int _i = 0; _i < 2; ++_i) \
        __builtin_amdgcn_global_load_lds((const unsigned*)((const char*)(gbase) + (voff)[_i]), (PG8_LAS unsigned*)(lds + (bufoff) + ldsw + _i * 8192), 16, 0, 0); } while (0)
#define PG8_LDA(dst, b, h) do { _Pragma("unroll") for (int m = 0; m < 4; ++m) _Pragma("unroll") for (int k = 0; k < 2; ++k) dst[m][k] = *(const PG8_LAS bf16x8*)(lds + PG8_SA(b, h) + aoff + m * 2048 + k * 1024); } while (0)
#define PG8_LDB(dst, b, h) do { _Pragma("unroll") for (int n = 0; n < 2; ++n) _Pragma("unroll") for (int k = 0; k < 2; ++k) dst[n][k] = *(const PG8_LAS bf16x8*)(lds + PG8_SB(b, h) + boff + n * 2048 + k * 1024); } while (0)
#define PG8_MMA(ai, bj, At, Bt) do { __builtin_amdgcn_s_setprio(1); _Pragma("unroll") for (int m = 0; m < 4; ++m) _Pragma("unroll") for (int n = 0; n < 2; ++n) _Pragma("unroll") for (int k = 0; k < 2; ++k) \
        acc[ai][bj][m][n] = __builtin_amdgcn_mfma_f32_16x16x32_bf16(Bt[n][k], At[m][k], acc[ai][bj][m][n], 0, 0, 0); __builtin_amdgcn_s_setprio(0); } while (0)
#define PG8_WAIT_V(n) asm volatile("s_waitcnt vmcnt(" #n ")" ::: "memory")
#define PG8_WAIT_L(n) asm volatile("s_waitcnt lgkmcnt(" #n ")" ::: "memory")
#define PG8_BAR __builtin_amdgcn_s_barrier()
#define PG8_SCHED __builtin_amdgcn_sched_barrier(0)
    Unit cur, nxt; int ui = 0;
    if (!S.next(0, cur)) return;
    f32x4 acc[2][2][4][2];
#pragma unroll
    for (int a = 0; a < 2; ++a)
#pragma unroll
        for (int b = 0; b < 2; ++b)
#pragma unroll
            for (int m = 0; m < 4; ++m)
#pragma unroll
                for (int n = 0; n < 2; ++n) acc[a][b][m][n] = (f32x4){0.f, 0.f, 0.f, 0.f};
    bf16x8 At[4][2], B0[2][2], B1[2][2];
    const char* cA = (const char*)g.A + S.a_off(cur.pm, tstep); const char* cB = (const char*)g.Bt + (size_t)cur.pn * tstep;
    S.a_ready(cur);
    if constexpr (SP2) {
        PG8_STAGE(PG8_SB(0, 0), cB, voffB); PG8_STAGE(PG8_SB(0, 1), cB + hstep, voffB); PG8_STAGE(PG8_SA(0, 0), cA, voffA); PG8_STAGE(PG8_SA(0, 1), cA + hstep, voffA);
        if (wr == 1) PG8_BAR;
        PG8_WAIT_V(2); PG8_BAR;
        PG8_STAGE(PG8_SB(1, 0), cB + kstep, voffB); PG8_STAGE(PG8_SA(1, 0), cA + kstep, voffA); PG8_STAGE(PG8_SB(1, 1), cB + hstep + kstep, voffB);
        PG8_WAIT_V(6); PG8_BAR;
    } else {
        PG8_STAGE(PG8_SB(0, 0), cB, voffB); PG8_STAGE(PG8_SA(0, 0), cA, voffA); PG8_STAGE(PG8_SB(0, 1), cB + hstep, voffB); PG8_STAGE(PG8_SA(0, 1), cA + hstep, voffA);
        if (wr == 1) PG8_BAR;
        PG8_WAIT_V(4); PG8_BAR;
        PG8_STAGE(PG8_SB(1, 0), cB + kstep, voffB); PG8_STAGE(PG8_SA(1, 0), cA + kstep, voffA); PG8_STAGE(PG8_SB(1, 1), cB + hstep + kstep, voffB);
        PG8_WAIT_V(6); PG8_BAR;
    }
    for (;;) {
        const bool has_next = S.next(ui + 1, nxt);
        const char* nA = has_next ? (const char*)g.A + S.a_off(nxt.pm, tstep) : cA; const char* nB = has_next ? (const char*)g.Bt + (size_t)nxt.pn * tstep : cB;
        for (int t = 0; t < nt; t += 2) {
            const bool last = (t == nt - 2);
            const char* a1 = cA + (size_t)(t + 1) * kstep;
            const char* a2 = last ? nA : cA + (size_t)(t + 2) * kstep; const char* b2 = last ? nB : cB + (size_t)(t + 2) * kstep;
            const char* a3 = a2 + kstep; const char* b3 = b2 + kstep;
            if (last && has_next) S.a_ready(nxt);
            if constexpr (SP2) {
            PG8_LDB(B0, 0, 0); PG8_LDB(B1, 0, 1); PG8_SCHED; PG8_LDA(At, 0, 0); PG8_STAGE(PG8_SA(1, 1), a1 + hstep, voffA);
            PG8_WAIT_V(8); PG8_WAIT_L(0); PG8_BAR; PG8_MMA(0, 0, At, B0); PG8_MMA(0, 1, At, B1); PG8_BAR; PG8_SCHED;
            PG8_LDA(At, 0, 1); PG8_STAGE(PG8_SB(0, 0), b2, voffB); PG8_STAGE(PG8_SB(0, 1), b2 + hstep, voffB); PG8_STAGE(PG8_SA(0, 0), a2, voffA);
            PG8_WAIT_V(8); PG8_WAIT_L(0); PG8_BAR; PG8_MMA(1, 0, At, B0); PG8_MMA(1, 1, At, B1); PG8_BAR; PG8_SCHED;
            PG8_LDB(B0, 1, 0); PG8_LDB(B1, 1, 1); PG8_SCHED; PG8_LDA(At, 1, 0); PG8_STAGE(PG8_SA(0, 1), a2 + hstep, voffA);
            PG8_WAIT_V(8); PG8_WAIT_L(0); PG8_BAR; PG8_MMA(0, 0, At, B0); PG8_MMA(0, 1, At, B1); PG8_BAR; PG8_SCHED;
            PG8_LDA(At, 1, 1); PG8_STAGE(PG8_SB(1, 0), b3, voffB); PG8_STAGE(PG8_SB(1, 1), b3 + hstep, voffB); PG8_STAGE(PG8_SA(1, 0), a3, voffA);
            PG8_WAIT_V(8); PG8_WAIT_L(0); PG8_BAR; PG8_MMA(1, 0, At, B0); PG8_MMA(1, 1, At, B1); PG8_BAR; PG8_SCHED;
            } else {
            PG8_LDB(B0, 0, 0); PG8_SCHED; PG8_LDA(At, 0, 0); PG8_STAGE(PG8_SA(1, 1), a1 + hstep, voffA);
            PG8_WAIT_L(8); PG8_BAR; PG8_WAIT_L(0); PG8_MMA(0, 0, At, B0); PG8_BAR; PG8_SCHED;
            PG8_LDB(B1, 0, 1); PG8_STAGE(PG8_SB(0, 0), b2, voffB);
            PG8_BAR; PG8_WAIT_L(0); PG8_MMA(0, 1, At, B1); PG8_BAR;
            PG8_LDA(At, 0, 1); PG8_STAGE(PG8_SA(0, 0), a2, voffA);
            PG8_BAR; PG8_WAIT_L(0); PG8_MMA(1, 0, At, B0); PG8_BAR; PG8_SCHED;
            PG8_STAGE(PG8_SB(0, 1), b2 + hstep, voffB);
            PG8_WAIT_V(6); PG8_BAR; PG8_MMA(1, 1, At, B1); PG8_BAR;
            PG8_LDB(B0, 1, 0); PG8_SCHED; PG8_LDA(At, 1, 0); PG8_STAGE(PG8_SA(0, 1), a2 + hstep, voffA);
            PG8_WAIT_L(8); PG8_BAR; PG8_WAIT_L(0); PG8_MMA(0, 0, At, B0); PG8_BAR; PG8_SCHED;
            PG8_LDB(B1, 1, 1); PG8_STAGE(PG8_SB(1, 0), b3, voffB);
            PG8_BAR; PG8_WAIT_L(0); PG8_MMA(0, 1, At, B1); PG8_BAR;
            PG8_LDA(At, 1, 1); PG8_STAGE(PG8_SA(1, 0), a3, voffA);
            PG8_BAR; PG8_WAIT_L(0); PG8_MMA(1, 0, At, B0); PG8_BAR; PG8_SCHED;
            PG8_STAGE(PG8_SB(1, 1), b3 + hstep, voffB);
            PG8_WAIT_V(6); PG8_BAR; PG8_MMA(1, 1, At, B1); PG8_BAR;
            }
        }
        if constexpr (ALIGN_EPI) { if (wr == 0) PG8_BAR; }
        if constexpr (!Epi::AFTER_DRAIN) { E(acc, cur, wr, wc, fr, fq); S.done(cur); }
        if (!has_next) break;
#pragma unroll
        for (int a = 0; a < 2; ++a)
#pragma unroll
            for (int b = 0; b < 2; ++b)
#pragma unroll
                for (int m = 0; m < 4; ++m)
#pragma unroll
                    for (int n = 0; n < 2; ++n) acc[a][b][m][n] = (f32x4){0.f, 0.f, 0.f, 0.f};
        cur = nxt; cA = nA; cB = nB; ++ui;
        if constexpr (ALIGN_EPI) { if (wr == 1) PG8_BAR; }
    }
    PG8_WAIT_V(0);
    if constexpr (!ALIGN_EPI) { if (wr == 0) PG8_BAR; }
    PG8_BAR;
    if constexpr (Epi::AFTER_DRAIN) { E.fused(acc, cur, wr, wc, fr, fq, lds, wid, lane); S.done(cur); }
#undef PG8_SA
#undef PG8_SB
#undef PG8_STAGE
#undef PG8_LDA
#undef PG8_LDB
#undef PG8_MMA
#undef PG8_WAIT_V
#undef PG8_WAIT_L
#undef PG8_BAR
#undef PG8_SCHED
}
}
#define LAS __attribute__((address_space(3)))
typedef unsigned short bf16_t;
typedef short bf16x8 __attribute__((ext_vector_type(8)));
typedef float f32x4 __attribute__((ext_vector_type(4)));
typedef float f32x16 __attribute__((ext_vector_type(16)));
typedef unsigned u32x4 __attribute__((ext_vector_type(4)));
typedef unsigned u32x2 __attribute__((ext_vector_type(2)));
constexpr int T_ = 16384, D_ = 1024, S_ = 2048, NH = 8, DFF = 2816, DIN = 3080, NMOD = 6144, HALFC = 1408;
constexpr float EPS = 1e-6f;
constexpr float LOG2E = 1.4426950408889634f;
constexpr float C2 = 0.125f * LOG2E;
constexpr size_t MiB = 1u << 20;
constexpr size_t WS_MOD = 0, WS_BIAS2 = 256 * 1024, WS_ROWSS = 31 * MiB, WS_BAR = 640 * 1024, WS_LOGF = 1 * MiB, WS_QAUG = 2 * MiB, WS_KAUG = 4 * MiB,
    WS_WIN = 6 * MiB, WS_WOUT = 12 * MiB, WS_WUP = 14 * MiB, WS_WDOWN = 25 * MiB, WS_H = 32 * MiB, WS_Q = 64 * MiB, WS_K = 80 * MiB,
    WS_VT = 96 * MiB, WS_Z = 112 * MiB, WS_BG = 128 * MiB, WS_MIX = 144 * MiB, WS_ACT = 160 * MiB, WS_TAIL = 30 * MiB + 512 * 1024;
constexpr int LDS_BYTES = 139328;
constexpr int XCH_OFF = 131072 + 64;

struct Params {
    const float *x, *c, *w_ada, *b_ada, *n1g, *w_in, *b_f, *qg, *kg, *cmw, *w_out, *n2g, *w_up, *fcw, *w_down;
    float* out; unsigned char* ws;
};

__device__ __forceinline__ float wave_sum(float v) {
#pragma unroll
    for (int o = 1; o < 64; o <<= 1) v += __shfl_xor(v, o);
    return v;
}
__device__ __forceinline__ unsigned f2bf(float f) { unsigned u = __builtin_bit_cast(unsigned, f); return (u + 0x7fffu + ((u >> 16) & 1u)) >> 16; }
__device__ __forceinline__ float bf2f(unsigned h) { return __builtin_bit_cast(float, h << 16); }
__device__ __forceinline__ unsigned pk2(float lo, float hi) { return pg8::cvt_pk_bf16(lo, hi); }
typedef float f32x2_t __attribute__((ext_vector_type(2))); typedef __bf16 bf16x2_t __attribute__((ext_vector_type(2)));
__device__ __forceinline__ unsigned cvtpk_s(float lo, float hi) { f32x2_t v = {lo, hi}; bf16x2_t b = __builtin_convertvector(v, bf16x2_t); return __builtin_bit_cast(unsigned, b); }
__device__ __forceinline__ void unpack8(u32x4 w, float (&f)[8]) {
    f[0] = bf2f(w.x & 0xffffu); f[1] = __builtin_bit_cast(float, w.x & 0xffff0000u);
    f[2] = bf2f(w.y & 0xffffu); f[3] = __builtin_bit_cast(float, w.y & 0xffff0000u);
    f[4] = bf2f(w.z & 0xffffu); f[5] = __builtin_bit_cast(float, w.z & 0xffff0000u);
    f[6] = bf2f(w.w & 0xffffu); f[7] = __builtin_bit_cast(float, w.w & 0xffff0000u);
}
__device__ __forceinline__ u32x4 pack8(const float (&f)[8]) { u32x4 w; w.x = pk2(f[0], f[1]); w.y = pk2(f[2], f[3]); w.z = pk2(f[4], f[5]); w.w = pk2(f[6], f[7]); return w; }

__device__ __forceinline__ void transpose_item(const float* W, int N, int K, bf16_t* WT, int dstrow0, int srccol0, int k0, LAS float* scr, int lane) {
    float tv[32];
    { const float* wp = W + (size_t)(k0 + (lane >> 5)) * N + srccol0 + (lane & 31);
#pragma unroll
      for (int i = 0; i < 32; ++i) tv[i] = wp[(size_t)(2 * i) * N]; }
#pragma unroll
    for (int i = 0; i < 32; ++i) scr[(2 * i + (lane >> 5)) * 33 + (lane & 31)] = tv[i];
    asm volatile("s_waitcnt lgkmcnt(0)" ::: "memory");
    const int c = lane & 7;
#pragma unroll
    for (int j = 0; j < 4; ++j) { const int n = (lane >> 3) + 8 * j; const LAS float* s = scr + (8 * c) * 33 + n;
        u32x4 o; o.x = pk2(s[0 * 33], s[1 * 33]); o.y = pk2(s[2 * 33], s[3 * 33]); o.z = pk2(s[4 * 33], s[5 * 33]); o.w = pk2(s[6 * 33], s[7 * 33]);
        *(u32x4*)(WT + (size_t)(dstrow0 + n) * K + k0 + 8 * c) = o; }
    asm volatile("s_waitcnt lgkmcnt(0)" ::: "memory");
}
__device__ __forceinline__ int win_src(int p0) {
    const int pn = p0 >> 8, c = p0 & 255, bj = c >> 7, wc = (c & 127) >> 5;
    if (pn < 6) return (pn >> 1) * 512 + (4 * (pn & 1) + wc) * 64 + 32 * bj;
    if (pn < 10) return (bj == 0 ? 1544 : 2568) + 128 * (pn - 6) + (c & 127);
    return 2056 + 256 * (pn - 10) + c;
}
__device__ __forceinline__ int wup_src(int p0) { const int j = p0 >> 8, c = p0 & 255; return (c < 128) ? 128 * j + c : DFF + 128 * j + (c - 128); }

__device__ __forceinline__ void gemv_item(const float* W, int N, int n0, const float* bias, const LAS float* vecs, LAS float* red, float* out, int tid) {
    const int cgp = tid & 7, kg = tid >> 3;
    float acc[8][4];
#pragma unroll
    for (int b = 0; b < 8; ++b)
#pragma unroll
        for (int j = 0; j < 4; ++j) acc[b][j] = 0.f;
#pragma unroll 4
    for (int i = 0; i < 16; ++i) { const int k = kg + 64 * i; const f32x4 w = *(const f32x4*)(W + (size_t)k * N + n0 + 4 * cgp);
#pragma unroll
        for (int b = 0; b < 8; ++b) { const float v = vecs[b * 1024 + k]; acc[b][0] += v * w.x; acc[b][1] += v * w.y; acc[b][2] += v * w.z; acc[b][3] += v * w.w; } }
#pragma unroll
    for (int b = 0; b < 8; ++b) *(LAS f32x4*)(red + (kg * 8 + b) * 32 + 4 * cgp) = (f32x4){acc[b][0], acc[b][1], acc[b][2], acc[b][3]};
    __syncthreads();
    if (tid < 256) { const int b = tid >> 5, col = tid & 31; float s = 0.f;
#pragma unroll 8
      for (int g = 0; g < 64; ++g) s += red[(g * 8 + b) * 32 + col];
      out[(size_t)b * N + n0 + col] = s + (bias ? bias[n0 + col] : 0.f); }
    __syncthreads();
}

__device__ __forceinline__ void transposes(const Params& p, LAS unsigned char* lds, int it_begin, int it_end, int gw, int NGW, int lane, int wave) {
    LAS float* scr = (LAS float*)(lds + wave * 8704);
    constexpr int I_IN = 16 * 96, I_OUT = 16 * 32, I_UP = 16 * 176;
    for (int it = it_begin + gw; it < it_end; it += NGW) {
        int r = it;
        if (r < I_IN) { const int kb = r / 96, nb = r % 96; transpose_item(p.w_in, DIN, 1024, (bf16_t*)(p.ws + WS_WIN), 32 * nb, win_src(32 * nb), 64 * kb, scr, lane); continue; } r -= I_IN;
        if (r < I_OUT) { const int kb = r / 32, nb = r % 32; transpose_item(p.w_out, 1024, 1024, (bf16_t*)(p.ws + WS_WOUT), 32 * nb, 32 * nb, 64 * kb, scr, lane); continue; } r -= I_OUT;
        if (r < I_UP) { const int kb = r / 176, nb = r % 176; transpose_item(p.w_up, 2 * DFF, 1024, (bf16_t*)(p.ws + WS_WUP), 32 * nb, wup_src(32 * nb), 64 * kb, scr, lane); continue; } r -= I_UP;
        { const int kb = r / 32, nb = r % 32; transpose_item(p.w_down, 1024, DFF, (bf16_t*)(p.ws + WS_WDOWN), 32 * nb, 32 * nb, 64 * kb, scr, lane); }
    }
}
constexpr int NIT_IN = 16 * 96, NIT_ALL = 16 * 96 + 16 * 32 + 16 * 176 + 44 * 32;
__device__ __forceinline__ void phase0(const Params& p, LAS unsigned char* lds, int tid, int lane, int wave) {
    float* mod = (float*)(p.ws + WS_MOD);
    const int ngemv = gridDim.x > 192 ? 192 : gridDim.x;
    if (blockIdx.x < ngemv) {
        LAS float* vecs = (LAS float*)lds; LAS float* red = (LAS float*)(lds + 32768);
        for (int i = tid; i < 8192; i += 512) { const float v = p.c[i]; vecs[i] = v / (1.f + __expf(-v)); }
        __syncthreads();
        for (int it = blockIdx.x; it < 192; it += ngemv) gemv_item(p.w_ada, NMOD, 32 * it, p.b_ada, vecs, red, mod, tid);
    } else {
        transposes(p, lds, 0, NIT_IN, (blockIdx.x - 192) * 8 + wave, (gridDim.x - 192) * 8, lane, wave);
    }
}

__device__ __forceinline__ void phase1(const Params& p, LAS unsigned char* lds, int tid, int lane, int wave) {
    const float* mod = (const float*)(p.ws + WS_MOD);
    if (blockIdx.x < 176) {
        LAS float* vecs = (LAS float*)lds; LAS float* red = (LAS float*)(lds + 32768);
        for (int i = tid; i < 8192; i += 512) vecs[i] = mod[(i >> 10) * NMOD + 3072 + (i & 1023)];
        __syncthreads();
        for (int it = blockIdx.x; it < 176; it += gridDim.x) gemv_item(p.w_up, 2 * DFF, 32 * it, nullptr, vecs, red, (float*)(p.ws + WS_BIAS2), tid);
    }
    transposes(p, lds, gridDim.x > 192 ? NIT_IN : 0, NIT_ALL, blockIdx.x * 8 + wave, gridDim.x * 8, lane, wave);
    __syncthreads();
    LAS float* wf = (LAS float*)lds;
    for (int i = tid; i < 8192; i += 512) { const int k = i >> 3, h = i & 7; wf[h * 1024 + k] = p.w_in[(size_t)k * DIN + 1536 + h]; }
    __syncthreads();
    bf16_t* hb = (bf16_t*)(p.ws + WS_H); float* logf = (float*)(p.ws + WS_LOGF);
    const int gw = blockIdx.x * 8 + wave, NGW = gridDim.x * 8;
    f32x4 vn[4];
    if (gw < T_) {
#pragma unroll
        for (int j = 0; j < 4; ++j) vn[j] = *(const f32x4*)(p.x + (size_t)gw * D_ + 4 * lane + 256 * j); }
    for (int row = gw; row < T_; row += NGW) {
        const int b = row >> 11; const float* mb = mod + b * NMOD;
        f32x4 v[4]; float ss = 0.f;
#pragma unroll
        for (int j = 0; j < 4; ++j) { v[j] = vn[j]; ss += (v[j].x * v[j].x + v[j].y * v[j].y) + (v[j].z * v[j].z + v[j].w * v[j].w); }
        if (row + NGW < T_) {
#pragma unroll
            for (int j = 0; j < 4; ++j) vn[j] = *(const f32x4*)(p.x + (size_t)(row + NGW) * D_ + 4 * lane + 256 * j); }
        const float rstd = rsqrtf(wave_sum(ss) * (1.f / D_) + EPS);
#pragma unroll
        for (int j = 0; j < 4; ++j) { const int col = 4 * lane + 256 * j;
            const f32x4 g = *(const f32x4*)(p.n1g + col), sc = *(const f32x4*)(mb + 1024 + col), sh = *(const f32x4*)(mb + col);
            v[j] = (v[j] * rstd) * g * (sc + 1.f) + sh;
            u32x2 w; w.x = pk2(v[j].x, v[j].y); w.y = pk2(v[j].z, v[j].w);
            *(u32x2*)(hb + (size_t)row * D_ + col) = w; }
        float fg[8];
#pragma unroll
        for (int h = 0; h < 8; ++h) { float s = 0.f;
#pragma unroll
            for (int j = 0; j < 4; ++j) { const f32x4 w = *(const LAS f32x4*)(wf + h * 1024 + 4 * lane + 256 * j); s += (v[j].x * w.x + v[j].y * w.y) + (v[j].z * w.z + v[j].w * w.w); }
            fg[h] = wave_sum(s); }
        float z = fg[0];
#pragma unroll
        for (int h = 1; h < 8; ++h) z = (lane == h) ? fg[h] : z;
        if (lane < 8) { z += p.b_f[lane]; logf[(size_t)row * 8 + lane] = fminf(z, 0.f) - log1pf(expf(-fabsf(z))); }
    }
    __syncthreads();
}

__device__ __forceinline__ void scan_item(const Params& p, LAS unsigned char* lds, int bh, int tid, int lane, int wave) {
    const float* logf = (const float*)(p.ws + WS_LOGF); const int b = bh >> 3, h = bh & 7;
    LAS float* wt = (LAS float*)lds;
    float a[4];
#pragma unroll
    for (int i = 0; i < 4; ++i) a[i] = logf[((size_t)(b * S_ + 4 * tid + i)) * 8 + h];
    a[1] += a[0]; a[2] += a[1]; a[3] += a[2];
    float sc = a[3];
#pragma unroll
    for (int o = 1; o < 64; o <<= 1) { const float y = __shfl_up(sc, o); if (lane >= o) sc += y; }
    if (lane == 63) wt[wave] = sc;
    __syncthreads();
    float off = sc - a[3];
    for (int w = 0; w < wave; ++w) off += wt[w];
    u32x4* qa = (u32x4*)(p.ws + WS_QAUG) + (size_t)bh * S_ + 4 * tid; u32x4* ka = (u32x4*)(p.ws + WS_KAUG) + (size_t)bh * S_ + 4 * tid;
#pragma unroll
    for (int i = 0; i < 4; ++i) { const float F = (off + a[i]) * LOG2E;
        const unsigned hi = f2bf(F); const float r1 = F - bf2f(hi); const unsigned mid = f2bf(r1); const float r2 = r1 - bf2f(mid); const unsigned lo = f2bf(r2);
        u32x4 q, k; q.x = hi | (mid << 16); q.y = lo | (0x3F80u << 16); q.z = 0x3F803F80u; q.w = 0u;
        k.x = 0x3F803F80u; k.y = 0x3F80u | ((hi ^ 0x8000u) << 16); k.z = (mid ^ 0x8000u) | ((lo ^ 0x8000u) << 16); k.w = 0u;
        qa[i] = q; ka[i] = k; }
    __syncthreads();
}
struct EpiIn {
    static constexpr bool PERM = true, AFTER_DRAIN = false;
    bf16_t *Q, *K, *Vt, *Z, *BG; const float *qg, *kg;
    __device__ __forceinline__ void operator()(const f32x4 (&acc)[2][2][4][2], const pg8::Unit& u, int wr, int wc, int fr, int fq) const {
        const int pn = u.pn; const int row0 = u.pm * 256 + wr * 64 + fr;
        if (pn < 4) {
            const bool isq = pn < 2; const float* g = isq ? qg : kg; bf16_t* dst = isq ? Q : K; const int head = 4 * (pn & 1) + wc; const float mul = isq ? C2 : 1.f;
            f32x4 gv[2][2];
#pragma unroll
            for (int bj = 0; bj < 2; ++bj)
#pragma unroll
                for (int n = 0; n < 2; ++n) gv[bj][n] = *(const f32x4*)(g + 32 * bj + 8 * fq + 4 * n) * mul;
#pragma unroll
            for (int ai = 0; ai < 2; ++ai)
#pragma unroll
                for (int m = 0; m < 4; ++m) {
                    float ss = 0.f;
#pragma unroll
                    for (int bj = 0; bj < 2; ++bj)
#pragma unroll
                        for (int n = 0; n < 2; ++n) { const f32x4 a = acc[ai][bj][m][n]; ss += (a.x * a.x + a.y * a.y) + (a.z * a.z + a.w * a.w); }
                    ss += __shfl_xor(ss, 16); ss += __shfl_xor(ss, 32);
                    const float rinv = rsqrtf(ss * (1.f / 64.f) + EPS);
                    const unsigned row = (unsigned)(row0 + ai * 128 + m * 16);
#pragma unroll
                    for (int bj = 0; bj < 2; ++bj) { const f32x4 v0 = acc[ai][bj][m][0] * rinv * gv[bj][0], v1 = acc[ai][bj][m][1] * rinv * gv[bj][1];
                        u32x4 w; w.x = pk2(v0.x, v0.y); w.y = pk2(v0.z, v0.w); w.z = pk2(v1.x, v1.y); w.w = pk2(v1.z, v1.w);
                        *(u32x4*)(dst + row * 512 + head * 64 + 32 * bj + 8 * fq) = w; }
                }
        } else if (pn < 6) {
            const int head = 4 * (pn & 1) + wc, b = u.pm >> 3;
            bf16_t* vb = Vt + (size_t)((b * 8 + head) * 64) * S_;
#pragma unroll
            for (int ai = 0; ai < 2; ++ai)
#pragma unroll
                for (int m = 0; m < 4; ++m) { const int t = (row0 + ai * 128 + m * 16) & (S_ - 1);
                    const int tp = (t & ~15) | (((t >> 2) & 1) << 3) | (((t >> 3) & 1) << 2) | (t & 3);
#pragma unroll
                    for (int bj = 0; bj < 2; ++bj)
#pragma unroll
                        for (int n = 0; n < 2; ++n) { const f32x4 a = acc[ai][bj][m][n]; const int d = 32 * bj + 8 * fq + 4 * n;
                            vb[(unsigned)((d + 0) * S_ + tp)] = (bf16_t)f2bf(a.x); vb[(unsigned)((d + 1) * S_ + tp)] = (bf16_t)f2bf(a.y);
                            vb[(unsigned)((d + 2) * S_ + tp)] = (bf16_t)f2bf(a.z); vb[(unsigned)((d + 3) * S_ + tp)] = (bf16_t)f2bf(a.w); }
                }
        } else if (pn < 10) {
            const int ch0 = 128 * (pn - 6) + 32 * wc + 8 * fq;
#pragma unroll
            for (int ai = 0; ai < 2; ++ai)
#pragma unroll
                for (int m = 0; m < 4; ++m) { const unsigned row = (unsigned)(row0 + ai * 128 + m * 16);
                    const f32x4 v0 = acc[ai][0][m][0] * acc[ai][1][m][0], v1 = acc[ai][0][m][1] * acc[ai][1][m][1];
                    u32x4 w; w.x = pk2(v0.x, v0.y); w.y = pk2(v0.z, v0.w); w.z = pk2(v1.x, v1.y); w.w = pk2(v1.z, v1.w);
                    *(u32x4*)(Z + row * 512 + ch0) = w; }
        } else {
#pragma unroll
            for (int ai = 0; ai < 2; ++ai)
#pragma unroll
                for (int m = 0; m < 4; ++m) { const unsigned row = (unsigned)(row0 + ai * 128 + m * 16);
#pragma unroll
                    for (int bj = 0; bj < 2; ++bj) { const f32x4 v0 = acc[ai][bj][m][0], v1 = acc[ai][bj][m][1];
                        u32x4 w; w.x = pk2(v0.x, v0.y); w.y = pk2(v0.z, v0.w); w.z = pk2(v1.x, v1.y); w.w = pk2(v1.z, v1.w);
                        *(u32x4*)(BG + row * 512 + 256 * (pn - 10) + 128 * bj + 32 * wc + 8 * fq) = w; } }
        }
    }
};
struct EpiOut {
    static constexpr bool PERM = true, AFTER_DRAIN = false;
    const float* x; const float* mod; const float* n2g; bf16_t* x1b; bf16_t* A2; float* rowss; bf16_t* A2tail;
    __device__ __forceinline__ void operator()(const f32x4 (&acc)[2][2][4][2], const pg8::Unit& u, int wr, int wc, int fr, int fq) const {
        const int b = u.pm >> 3, colb = u.pn * 256 + wc * 32 + 8 * fq; const int row0 = u.pm * 256 + wr * 64 + fr;
        const float* mb = mod + b * NMOD;
        f32x4 g1v[2][2], gm[2][2];
#pragma unroll
        for (int bj = 0; bj < 2; ++bj)
#pragma unroll
            for (int n = 0; n < 2; ++n) { const int col = colb + 128 * bj + 4 * n; g1v[bj][n] = *(const f32x4*)(mb + 2048 + col);
                gm[bj][n] = *(const f32x4*)(n2g + col) * (*(const f32x4*)(mb + 4096 + col) + 1.f); }
#pragma unroll
        for (int ai = 0; ai < 2; ++ai) {
            f32x4 xv[4][2][2];
#pragma unroll
            for (int m = 0; m < 4; ++m)
#pragma unroll
                for (int bj = 0; bj < 2; ++bj)
#pragma unroll
                    for (int n = 0; n < 2; ++n) xv[m][bj][n] = *(const f32x4*)(x + ((unsigned)(row0 + ai * 128 + m * 16) * D_ + colb + 128 * bj + 4 * n));
#pragma unroll
            for (int m = 0; m < 4; ++m) { const unsigned row = (unsigned)(row0 + ai * 128 + m * 16); float ss = 0.f;
#pragma unroll
                for (int bj = 0; bj < 2; ++bj) { f32x4 x1[2]; u32x4 xb;
#pragma unroll
                    for (int n = 0; n < 2; ++n) {
                        x1[n] = xv[m][bj][n] + g1v[bj][n] * acc[ai][bj][m][n];
                        ss += (x1[n].x * x1[n].x + x1[n].y * x1[n].y) + (x1[n].z * x1[n].z + x1[n].w * x1[n].w); if (n == 0) { xb.x = pk2(x1[0].x, x1[0].y); xb.y = pk2(x1[0].z, x1[0].w); } else { xb.z = pk2(x1[1].x, x1[1].y); xb.w = pk2(x1[1].z, x1[1].w); } x1[n] = x1[n] * gm[bj][n]; }
                    u32x4 w; w.x = pk2(x1[0].x, x1[0].y); w.y = pk2(x1[0].z, x1[0].w); w.z = pk2(x1[1].x, x1[1].y); w.w = pk2(x1[1].z, x1[1].w);
                    *(u32x4*)(A2 + row * D_ + colb + 128 * bj) = w;
                    *(u32x4*)(x1b + row * D_ + colb + 128 * bj) = xb;
                    { const unsigned t = row & (S_ - 1); if (t >= 2016u) *(u32x4*)(A2tail + ((row >> 11) * 32 + (t - 2016u)) * D_ + colb + 128 * bj) = w; } }
                ss += __shfl_xor(ss, 16); ss += __shfl_xor(ss, 32);
                if (fq == 0) rowss[row * 16 + u.pn * 4 + wc] = ss; }
            asm volatile("" ::: "memory");
        }
    }
};
struct EpiUp {
    static constexpr bool PERM = true, AFTER_DRAIN = false;
    const float* rowss; const float* bias2; bf16_t* U; int half;
    __device__ __forceinline__ void operator()(const f32x4 (&acc)[2][2][4][2], const pg8::Unit& u, int wr, int wc, int fr, int fq) const {
        const int b = u.pm >> 3; const int row0 = u.pm * 256 + wr * 64 + fr;
        f32x4 bv[2][2];
#pragma unroll
        for (int bj = 0; bj < 2; ++bj)
#pragma unroll
            for (int n = 0; n < 2; ++n) bv[bj][n] = *(const f32x4*)(bias2 + b * (2 * DFF) + bj * DFF + half * HALFC + 128 * u.pn + 32 * wc + 8 * fq + 4 * n);
#pragma unroll
        for (int ai = 0; ai < 2; ++ai)
#pragma unroll
            for (int m = 0; m < 4; ++m) { const unsigned row = (unsigned)(row0 + ai * 128 + m * 16); const f32x4 s4 = *(const f32x4*)(rowss + row * 16 + 4 * fq); float sq = (s4.x + s4.y) + (s4.z + s4.w); sq += __shfl_xor(sq, 16); sq += __shfl_xor(sq, 32);
                const float rstd = rsqrtf(sq * (1.f / D_) + EPS);
#pragma unroll
                for (int bj = 0; bj < 2; ++bj) { const f32x4 v0 = acc[ai][bj][m][0] * rstd + bv[bj][0], v1 = acc[ai][bj][m][1] * rstd + bv[bj][1];
                    u32x4 w; w.x = pk2(v0.x, v0.y); w.y = pk2(v0.z, v0.w); w.z = pk2(v1.x, v1.y); w.w = pk2(v1.z, v1.w);
                    *(u32x4*)(U + (row * DFF + 256 * u.pn + 128 * bj + 32 * wc + 8 * fq)) = w; } }
    }
};

__device__ __forceinline__ float dpp_f(float old, float src, int which) {
    const int o = __builtin_bit_cast(int, old), v = __builtin_bit_cast(int, src); int r;
    if (which == 0) r = __builtin_amdgcn_update_dpp(o, v, 0x111, 0xf, 0xf, false);
    else if (which == 1) r = __builtin_amdgcn_update_dpp(o, v, 0x112, 0xf, 0xf, false);
    else if (which == 2) r = __builtin_amdgcn_update_dpp(o, v, 0x121, 0xf, 0xf, false);
    else r = __builtin_amdgcn_update_dpp(o, v, 0x122, 0xf, 0xf, false);
    return __builtin_bit_cast(float, r);
}
struct UpOrder : pg8::StaticOrder {
    long tail_off;
    __device__ __forceinline__ long a_off(int pm, size_t) const { return pm < 64 ? ((long)((pm >> 3) * S_ + 254 * (pm & 7) - 2)) * (D_ * 2) : tail_off; }
};
struct EpiUpF {
    static constexpr bool PERM = true, AFTER_DRAIN = false;
    const float* rowss; const float* bias2; const float* fcw; bf16_t* act; LAS float* xch;
    __device__ __forceinline__ void operator()(f32x4 (&acc)[2][2][4][2], const pg8::Unit& u, int wr, int wc, int fr, int fq) const {
        if (u.pm == 64) run<true>(acc, u, wr, wc, fr, fq); else run<false>(acc, u, wr, wc, fr, fq);
    }
    template <bool tail> __device__ __forceinline__ void run(f32x4 (&acc)[2][2][4][2], const pg8::Unit& u, int wr, int wc, int fr_in, int fq_in) const {
        int fr = fr_in, fq = fq_in; asm volatile("" : "+v"(fr), "+v"(fq));
        fr &= 15; fq &= 3;
        const int pm = u.pm, pn = u.pn; const int breg = pm >> 3, ireg = pm & 7;
        const int rbase = wr * 64 + fr, colg = 32 * wc + 8 * fq, chan0 = 128 * pn + colg;
        const int tok0 = breg * S_ + 254 * ireg - 2;
        const bool zfirst = !tail && ireg == 0 && wr == 0 && fr < 2;
        float rstd[2][4];
#pragma unroll
        for (int ai = 0; ai < 2; ++ai)
#pragma unroll
            for (int m = 0; m < 4; ++m) {
                const int r = rbase + 128 * ai + 16 * m; int grow = tail ? (r >> 5) * S_ + 2016 + (r & 31) : tok0 + r; grow = grow < 0 ? 0 : grow;
                const f32x4 s4 = *(const f32x4*)(rowss + (unsigned)grow * 16 + 4 * fq); float sq = (s4.x + s4.y) + (s4.z + s4.w); sq += __shfl_xor(sq, 16); sq += __shfl_xor(sq, 32);
                rstd[ai][m] = rsqrtf(sq * (1.f / D_) + EPS);
            }
#pragma unroll
        for (int ai = 0; ai < 2; ++ai) { const float* bp = bias2 + (tail ? (4 * ai + 2 * wr + 1) : breg) * (2 * DFF) + chan0;
#pragma unroll
            for (int bj = 0; bj < 2; ++bj)
#pragma unroll
                for (int n = 0; n < 2; ++n) { const f32x4 v = acc[ai][bj][3][n] * rstd[ai][3] + *(const f32x4*)(bp + bj * DFF + 4 * n);
                    if (fr >= 14) *(LAS f32x4*)(xch + (((2 * ai + wr) * 2 + (fr - 14)) * 256 + 128 * bj + colg + 4 * n)) = v; } }
        asm volatile("s_waitcnt lgkmcnt(0)" ::: "memory"); __builtin_amdgcn_s_barrier(); asm volatile("" ::: "memory");
#pragma unroll
        for (int n = 0; n < 2; ++n) {
            const float* wp = fcw + chan0 + 4 * n;
            const f32x4 wg0 = *(const f32x4*)(wp), wg1 = *(const f32x4*)(wp + 2 * DFF), wg2 = *(const f32x4*)(wp + 4 * DFF);
            const f32x4 wv0 = *(const f32x4*)(wp + DFF), wv1 = *(const f32x4*)(wp + 3 * DFF), wv2 = *(const f32x4*)(wp + 5 * DFF);
            f32x4 bg = (f32x4){0.f, 0.f, 0.f, 0.f}, bvl = bg;
            if (!tail) { bg = *(const f32x4*)(bias2 + breg * (2 * DFF) + chan0 + 4 * n); bvl = *(const f32x4*)(bias2 + breg * (2 * DFF) + DFF + chan0 + 4 * n); }
#pragma unroll
            for (int ai = 0; ai < 2; ++ai) {
                const int slot = 2 * ai + wr - 1;
                f32x4 g14 = (f32x4){0.f, 0.f, 0.f, 0.f}, g15 = g14, v14 = g14, v15 = g14;
                if (slot >= 0) { const LAS float* xp = xch + (slot * 2) * 256 + colg + 4 * n;
                    g14 = *(const LAS f32x4*)(xp); g15 = *(const LAS f32x4*)(xp + 256); v14 = *(const LAS f32x4*)(xp + 128); v15 = *(const LAS f32x4*)(xp + 256 + 128); }
                f32x4 pg = g14, pv = g14;
#pragma unroll
                for (int m = 0; m < 4; ++m) {
                    const int r = rbase + 128 * ai + 16 * m;
                    if (tail) { const float* bp = bias2 + (4 * ai + 2 * wr + (m >> 1)) * (2 * DFF) + chan0 + 4 * n; bg = *(const f32x4*)(bp); bvl = *(const f32x4*)(bp + DFF); }
                    f32x4 cg_ = acc[ai][0][m][n] * rstd[ai][m] + bg, cv_ = acc[ai][1][m][n] * rstd[ai][m] + bvl;
                    if (ai == 0 && m == 0) { if (zfirst) { cg_ = (f32x4){0.f, 0.f, 0.f, 0.f}; cv_ = cg_; } }
                    float o[4];
#pragma unroll
                    for (int e = 0; e < 4; ++e) {
                        float o1g, o2g, o1v, o2v;
                        if (m == 0) { o1g = g15[e]; o2g = (fr == 0) ? g14[e] : g15[e]; o1v = v15[e]; o2v = (fr == 0) ? v14[e] : v15[e]; }
                        else { o1g = dpp_f(0.f, pg[e], 2); o2g = dpp_f(0.f, pg[e], 3); o1v = dpp_f(0.f, pv[e], 2); o2v = dpp_f(0.f, pv[e], 3); }
                        const float p1g = dpp_f(o1g, cg_[e], 0), p2g = dpp_f(o2g, cg_[e], 1), p1v = dpp_f(o1v, cv_[e], 0), p2v = dpp_f(o2v, cv_[e], 1);
                        const float G = wg0[e] * p2g + wg1[e] * p1g + wg2[e] * cg_[e], V = wv0[e] * p2v + wv1[e] * p1v + wv2[e] * cv_[e];
                        o[e] = G * __builtin_amdgcn_rcpf(1.f + __expf(-G)) * V;
                    }
                    pg = cg_; pv = cv_;
                    bool outv; int tg;
                    if (tail) { outv = (m & 1) != 0; tg = (r >> 5) * S_ + 2016 + (r & 31); } else { outv = r >= 2; tg = tok0 + r; }
                    if (outv) { u32x2 w; w.x = pk2(o[0], o[1]); w.y = pk2(o[2], o[3]); *(u32x2*)(act + ((unsigned)tg * DFF + chan0 + 4 * n)) = w; }
                    __builtin_amdgcn_sched_barrier(0);
                }
            }
        }
    }
};
struct EpiDown {
    static constexpr bool PERM = true, AFTER_DRAIN = false;
    const float* mod; const bf16_t* x1b; float* dst;
    __device__ __forceinline__ void operator()(const f32x4 (&acc)[2][2][4][2], const pg8::Unit& u, int wr, int wc, int fr, int fq) const {
        const int b = u.pm >> 3, colb = u.pn * 256 + wc * 32 + 8 * fq; const int row0 = u.pm * 256 + wr * 64 + fr;
        const float* mb = mod + b * NMOD + 5120;
        f32x4 g2v[2][2];
#pragma unroll
        for (int bj = 0; bj < 2; ++bj)
#pragma unroll
            for (int n = 0; n < 2; ++n) g2v[bj][n] = *(const f32x4*)(mb + colb + 128 * bj + 4 * n);
#pragma unroll
        for (int ai = 0; ai < 2; ++ai) {
            u32x4 xw[4][2];
#pragma unroll
            for (int m = 0; m < 4; ++m)
#pragma unroll
                for (int bj = 0; bj < 2; ++bj) xw[m][bj] = *(const u32x4*)(x1b + ((unsigned)(row0 + ai * 128 + m * 16) * D_ + colb + 128 * bj));
#pragma unroll
            for (int m = 0; m < 4; ++m) { const unsigned row = (unsigned)(row0 + ai * 128 + m * 16);
#pragma unroll
                for (int bj = 0; bj < 2; ++bj) { float xf[8]; unpack8(xw[m][bj], xf);
#pragma unroll
                    for (int n = 0; n < 2; ++n) { const unsigned o_ = row * D_ + colb + 128 * bj + 4 * n;
                        *(f32x4*)(dst + o_) = (f32x4){xf[4 * n], xf[4 * n + 1], xf[4 * n + 2], xf[4 * n + 3]} + g2v[bj][n] * acc[ai][bj][m][n]; } } }
            asm volatile("" ::: "memory");
        }
    }
};

__device__ __forceinline__ int crow(int r, int hi) { return (r & 3) + 8 * (r >> 2) + 4 * hi; }
constexpr int AB_K = 0, AB_V = 9216, AB_A = 18432, ABUF = 19456, A_LW = 2 * ABUF;
__device__ __forceinline__ void attn_unit(const Params& p, LAS unsigned char* lds, int bh, int qb, float mshift, int tid, int lane, int wave) {
    const int r32 = lane & 31, hi = lane >> 5, b = bh >> 3, h = bh & 7;
    const bf16_t* Qg = (const bf16_t*)(p.ws + WS_Q); const bf16_t* Kg = (const bf16_t*)(p.ws + WS_K); const bf16_t* Vg = (const bf16_t*)(p.ws + WS_VT);
    const u32x4* qaug = (const u32x4*)(p.ws + WS_QAUG) + (size_t)bh * S_; const u32x4* kaug = (const u32x4*)(p.ws + WS_KAUG) + (size_t)bh * S_;
    bf16_t* mix = (bf16_t*)(p.ws + WS_MIX);
    const int q_rel = 32 * wave + r32, tq = 256 * qb + q_rel;
    bf16x8 qr[4], qa;
    { const bf16_t* qp = Qg + ((size_t)(b * S_ + tq)) * 512 + h * 64 + 8 * hi;
#pragma unroll
      for (int d0 = 0; d0 < 4; ++d0) qr[d0] = *(const bf16x8*)(qp + 16 * d0);
      u32x4 t = qaug[tq]; if (hi) t = (u32x4){0u, 0u, 0u, 0u}; qa = __builtin_bit_cast(bf16x8, t); }
    f32x16 o[2]; float lsum = 0.f;
#pragma unroll
    for (int i = 0; i < 16; ++i) { o[0][i] = 0.f; o[1][i] = 0.f; }
    const int NT = 4 * (qb + 1);
    const int srow = tid >> 3, sch = tid & 7;
    const bf16_t* kp = Kg + ((size_t)(b * S_ + srow)) * 512 + h * 64 + 8 * sch;
    const bf16_t* vp = Vg + ((size_t)(bh * 64 + srow)) * S_ + 8 * sch;
    u32x4 kreg = *(const u32x4*)kp, vreg = *(const u32x4*)vp, areg = (u32x4){0u, 0u, 0u, 0u};
    if (tid < 64) areg = kaug[tid];
    { LAS unsigned char* bb = lds; *(LAS u32x4*)(bb + AB_K + srow * 144 + sch * 16) = kreg; *(LAS u32x4*)(bb + AB_V + srow * 144 + sch * 16) = vreg; if (tid < 64) *(LAS u32x4*)(bb + AB_A + tid * 16) = areg; }
    __syncthreads();
    for (int j = 0; j < NT; ++j) {
        const bool more = (j + 1 < NT);
        if (more) { kreg = *(const u32x4*)(kp + (size_t)(j + 1) * 64 * 512); vreg = *(const u32x4*)(vp + (j + 1) * 64); if (tid < 64) areg = kaug[(j + 1) * 64 + tid]; }
        const LAS unsigned char* bb = lds + (j & 1) * ABUF;
        const int jb = j - 4 * qb;
#pragma unroll
        for (int kh = 0; kh < 2; ++kh) {
            if (jb >= 0 && 64 * jb + 32 * kh > 32 * wave + 31) continue;
            f32x16 C;
#pragma unroll
            for (int i = 0; i < 16; ++i) C[i] = -mshift;
            const LAS unsigned char* kr = bb + AB_K + (32 * kh + r32) * 144 + hi * 16;
#pragma unroll
            for (int d0 = 0; d0 < 4; ++d0) { const bf16x8 a = *(const LAS bf16x8*)(kr + d0 * 32); C = __builtin_amdgcn_mfma_f32_32x32x16_bf16(a, qr[d0], C, 0, 0, 0); }
            { u32x4 t = *(const LAS u32x4*)(bb + AB_A + (32 * kh + r32) * 16); if (hi) t = (u32x4){0u, 0u, 0u, 0u};
              C = __builtin_amdgcn_mfma_f32_32x32x16_bf16(__builtin_bit_cast(bf16x8, t), qa, C, 0, 0, 0); }
            if (jb >= 0) {
#pragma unroll
                for (int i = 0; i < 16; ++i) { const int kv = 64 * jb + 32 * kh + crow(i, hi); if (kv > q_rel) C[i] = -INFINITY; }
            }
#pragma unroll
            for (int i = 0; i < 16; ++i) { C[i] = __builtin_amdgcn_exp2f(C[i]); lsum += C[i]; }
#pragma unroll
            for (int s = 0; s < 2; ++s) {
                u32x4 pw; pw.x = cvtpk_s(C[8 * s + 0], C[8 * s + 1]); pw.y = cvtpk_s(C[8 * s + 2], C[8 * s + 3]); pw.z = cvtpk_s(C[8 * s + 4], C[8 * s + 5]); pw.w = cvtpk_s(C[8 * s + 6], C[8 * s + 7]);
                const bf16x8 pa = __builtin_bit_cast(bf16x8, pw);
#pragma unroll
                for (int dh = 0; dh < 2; ++dh) { const bf16x8 vf = *(const LAS bf16x8*)(bb + AB_V + (32 * dh + r32) * 144 + (32 * kh + 16 * s + 8 * hi) * 2);
                    o[dh] = __builtin_amdgcn_mfma_f32_32x32x16_bf16(pa, vf, o[dh], 0, 0, 0); }
            }
        }
        if (more) { LAS unsigned char* nb = lds + ((j + 1) & 1) * ABUF; *(LAS u32x4*)(nb + AB_K + srow * 144 + sch * 16) = kreg; *(LAS u32x4*)(nb + AB_V + srow * 144 + sch * 16) = vreg; if (tid < 64) *(LAS u32x4*)(nb + AB_A + tid * 16) = areg; }
        __syncthreads();
    }
    lsum += __shfl_xor(lsum, 32);
    LAS float* lw = (LAS float*)(lds + A_LW + wave * 128);
    if (hi == 0) lw[r32] = lsum;
    asm volatile("s_waitcnt lgkmcnt(0)" ::: "memory");
    bf16_t* op = mix + ((size_t)(b * S_ + 256 * qb + 32 * wave)) * D_ + h * 64 + r32;
#pragma unroll
    for (int i = 0; i < 16; ++i) { const int qq = crow(i, hi); const float rl = 1.f / lw[qq];
        op[(size_t)qq * D_] = (bf16_t)f2bf(o[0][i] * rl); op[(size_t)qq * D_ + 32] = (bf16_t)f2bf(o[1][i] * rl); }
    asm volatile("s_waitcnt lgkmcnt(0)" ::: "memory");
}

__device__ __forceinline__ void phase3(const Params& p, LAS unsigned char* lds, int tid, int lane, int wave) {
    float mq = 0.f, mk = 0.f;
    for (int i = 0; i < 64; ++i) { mq = fmaxf(mq, fabsf(p.qg[i])); mk = fmaxf(mk, fabsf(p.kg[i])); }
    const float mshift = 8.f * LOG2E * 1.03f * mq * mk;
    const int G = gridDim.x, bx = blockIdx.x; const int vcu = (G % 8 == 0) ? (bx % 8) * (G / 8) + bx / 8 : bx;
    for (int pr = vcu; pr < 256; pr += G) { const int bh = pr >> 2, s = pr & 3;
#if PROBE_DUP == 4
        for (int rep = 0; rep < 4; ++rep) { int e = rep & 1; asm volatile("" : "+s"(e)); attn_unit(p, lds, bh, e ? s : 7 - s, mshift, tid, lane, wave); }
#else
        for (int rep = 0; rep < 2; ++rep) { int e = rep; asm volatile("" : "+s"(e)); attn_unit(p, lds, bh, e ? s : 7 - s, mshift, tid, lane, wave); }
#endif
    }
    const bf16_t* Z = (const bf16_t*)(p.ws + WS_Z); const bf16_t* BG = (const bf16_t*)(p.ws + WS_BG); bf16_t* mix = (bf16_t*)(p.ws + WS_MIX);
    for (int it = bx * 512 + tid; it < (T_ / 8) * 64; it += G * 512) {
        const int rc = it >> 6, c0 = 8 * (it & 63), t0 = 8 * rc;
        float w0[8], w1[8], w2[8], z1[8], z2[8];
#pragma unroll
        for (int i = 0; i < 8; ++i) { w0[i] = p.cmw[c0 + i]; w1[i] = p.cmw[512 + c0 + i]; w2[i] = p.cmw[1024 + c0 + i]; z1[i] = 0.f; z2[i] = 0.f; }
        if (t0 & (S_ - 1)) { unpack8(*(const u32x4*)(Z + (size_t)(t0 - 2) * 512 + c0), z2); unpack8(*(const u32x4*)(Z + (size_t)(t0 - 1) * 512 + c0), z1); }
#pragma unroll
        for (int r = 0; r < 8; ++r) { float zc[8], bg[8], ov[8];
            unpack8(*(const u32x4*)(Z + (size_t)(t0 + r) * 512 + c0), zc); unpack8(*(const u32x4*)(BG + (size_t)(t0 + r) * 512 + c0), bg);
#pragma unroll
            for (int i = 0; i < 8; ++i) { ov[i] = bg[i] * (w0[i] * z2[i] + w1[i] * z1[i] + w2[i] * zc[i]); z2[i] = z1[i]; z1[i] = zc[i]; }
            *(u32x4*)(mix + (size_t)(t0 + r) * D_ + 512 + c0) = pack8(ov); }
    }
}

#define XB_TMO      128
#define XB_XCNT(j)  (256  + 64 * (j))
#define XB_XSUB(j)  (1280 + 64 * (j))
#define XB_XGEN(j)  (2304 + 64 * (j))
#define XB_TOP      3328
#define XB_TOPGEN   3392
#define XCD_BAR_WORDS 3456
#define XB_SPIN_CAP (1u << 18)

__device__ __forceinline__ unsigned xb_ld(unsigned* p)              { return __hip_atomic_load(p, __ATOMIC_RELAXED, __HIP_MEMORY_SCOPE_AGENT); }
__device__ __forceinline__ unsigned xb_add(unsigned* p, unsigned v) { return __hip_atomic_fetch_add(p, v, __ATOMIC_RELAXED, __HIP_MEMORY_SCOPE_AGENT); }
__device__ __forceinline__ unsigned xb_xcc_id() { return (unsigned)__builtin_amdgcn_s_getreg((3 << 11) | 20) & 0xFu; }
#define XB_SPIN(cond, bar) do { unsigned _sp = 0; while (cond) { __builtin_amdgcn_s_sleep(1); \
    if ((++_sp & 255u) == 0u) { if (xb_ld(&(bar)[XB_TMO])) break; if (_sp > XB_SPIN_CAP) { atomicAdd(&(bar)[XB_TMO], 1u); break; } } } } while (0)

struct XcdBarrier {
    unsigned* bar; unsigned x;
    volatile LAS unsigned* st;
};

__device__ __forceinline__ XcdBarrier xcd_barrier_post(unsigned* bar, volatile LAS unsigned* st) {
    XcdBarrier b; b.bar = bar; b.x = xb_xcc_id(); b.st = st;
    if (threadIdx.x == 0) (void)xb_add(&bar[XB_XCNT(b.x)], 1u);
    return b;
}
__device__ __forceinline__ void xcd_barrier_complete(unsigned* bar, unsigned x, unsigned& nloc, unsigned& nx) {
    const unsigned G = gridDim.x * gridDim.y * gridDim.z;
    unsigned sum, cnt, mine, sp = 0u;
    for (;;) {
        sum = 0u; cnt = 0u; mine = 0u;
#pragma unroll
        for (unsigned j = 0; j < 16; ++j) { const unsigned c = xb_ld(&bar[XB_XCNT(j)]); sum += c; cnt += (c > 0u) ? 1u : 0u; mine = (j == x) ? c : mine; }
        if (sum == G) break;
        __builtin_amdgcn_s_sleep(1);
        if ((++sp & 255u) == 0u) { if (xb_ld(&bar[XB_TMO])) break; if (sp > XB_SPIN_CAP) { atomicAdd(&bar[XB_TMO], 1u); break; } }
    }
    nloc = mine > 0u ? mine : 1u; nx = cnt > 0u ? cnt : 1u;
}

__device__ __forceinline__ void xcd_barrier(const XcdBarrier& b) {
    asm volatile("s_waitcnt vmcnt(0)" ::: "memory");
    __syncthreads();
    if (threadIdx.x == 0) {
        unsigned* bar = b.bar;
        __builtin_amdgcn_s_waitcnt(0);
        unsigned nloc = b.st[0], nx = b.st[1];
        if (nloc == 0u) { xcd_barrier_complete(bar, b.x, nloc, nx); b.st[0] = nloc; b.st[1] = nx; }
        const unsigned old = xb_add(&bar[XB_XSUB(b.x)], 1u);
        const unsigned gen = old / nloc;
        if (old + 1u == (gen + 1u) * nloc) {
            __builtin_amdgcn_fence(__ATOMIC_RELEASE, "agent");
            asm volatile("s_waitcnt vmcnt(0)" ::: "memory");
            const unsigned og = xb_add(&bar[XB_TOP], 1u);
            const unsigned tg = og / nx;
            if (og + 1u == (tg + 1u) * nx) xb_add(&bar[XB_TOPGEN], 1u);
            else XB_SPIN(xb_ld(&bar[XB_TOPGEN]) == tg, bar);
            __builtin_amdgcn_fence(__ATOMIC_ACQUIRE, "agent");
            xb_add(&bar[XB_XGEN(b.x)], 1u);
            asm volatile("s_waitcnt vmcnt(0)" ::: "memory");
        } else {
            XB_SPIN(xb_ld(&bar[XB_XGEN(b.x)]) == gen, bar);
            __builtin_amdgcn_fence(__ATOMIC_ACQUIRE, "agent");
            asm volatile("s_waitcnt vmcnt(0)" ::: "memory");
        }
    }
    __syncthreads();
}

__device__ __forceinline__ const void* ldarg(int byteoff) { const void* r;
    asm volatile("s_load_dwordx2 %0, %1, %2\n\ts_waitcnt lgkmcnt(0)" : "=s"(r) : "s"(__builtin_amdgcn_kernarg_segment_ptr()), "i"(byteoff) : "memory"); return r; }
#define LDA(i) ((const float*)ldarg(8 * (i)))
#define GASF __attribute__((address_space(1)))
__device__ __forceinline__ Params load_params() {
    unsigned long long v0, v1, v2, v3, v4, v5, v6, v7, v8, v9, v10, v11, v12, v13, v14, v15, v16;
    asm volatile("s_load_dwordx2 %0, %17, 0\n\ts_load_dwordx2 %1, %17, 8\n\ts_load_dwordx2 %2, %17, 16\n\ts_load_dwordx2 %3, %17, 24\n\ts_load_dwordx2 %4, %17, 32\n\ts_load_dwordx2 %5, %17, 40\n\t"
                 "s_load_dwordx2 %6, %17, 48\n\ts_load_dwordx2 %7, %17, 56\n\ts_load_dwordx2 %8, %17, 64\n\ts_load_dwordx2 %9, %17, 72\n\ts_load_dwordx2 %10, %17, 80\n\ts_load_dwordx2 %11, %17, 88\n\t"
                 "s_load_dwordx2 %12, %17, 96\n\ts_load_dwordx2 %13, %17, 104\n\ts_load_dwordx2 %14, %17, 112\n\ts_load_dwordx2 %15, %17, 120\n\ts_load_dwordx2 %16, %17, 128\n\ts_waitcnt lgkmcnt(0)"
                 : "=&s"(v0), "=&s"(v1), "=&s"(v2), "=&s"(v3), "=&s"(v4), "=&s"(v5), "=&s"(v6), "=&s"(v7), "=&s"(v8), "=&s"(v9),
                   "=&s"(v10), "=&s"(v11), "=&s"(v12), "=&s"(v13), "=&s"(v14), "=&s"(v15), "=&s"(v16)
                 : "s"(__builtin_amdgcn_kernarg_segment_ptr()) : "memory");
#define GP(v) ((const float*)(GASF const float*)(v))
    Params q; q.x = GP(v0); q.c = GP(v1); q.w_ada = GP(v2); q.b_ada = GP(v3); q.n1g = GP(v4); q.w_in = GP(v5); q.b_f = GP(v6); q.qg = GP(v7); q.kg = GP(v8); q.cmw = GP(v9);
    q.w_out = GP(v10); q.n2g = GP(v11); q.w_up = GP(v12); q.fcw = GP(v13); q.w_down = GP(v14); q.out = (float*)(GASF float*)(v15); q.ws = (unsigned char*)(GASF unsigned char*)(v16);
    return q; }
#ifndef PH
#define PH 255
#endif
#ifndef LAST_PHASE
#define LAST_PHASE 99
#endif
__global__ void __launch_bounds__(512, 2) hymba_mega(Params p_arg) {
    extern __shared__ __attribute__((aligned(16))) unsigned char lds_raw[];
    cg::grid_group grid = cg::this_grid();
    LAS unsigned char* lds = (LAS unsigned char*)lds_raw;
    const int tid = threadIdx.x, lane = tid & 63, wave = __builtin_amdgcn_readfirstlane(tid >> 6);
    const int G = gridDim.x, bx = blockIdx.x;
    if (p_arg.ws == nullptr) grid.sync();
    if (tid < 2) ((volatile LAS unsigned*)(lds + 131072))[tid] = 0u;
    __syncthreads();
    const XcdBarrier xbar = xcd_barrier_post((unsigned*)((unsigned char*)(GASF unsigned char*)(unsigned long long)ldarg(8 * 16) + WS_BAR), (volatile LAS unsigned*)(lds + 131072));
#define GSYNC() xcd_barrier(xbar)

#if PH & 1
    { const Params p = load_params(); phase0(p, lds, tid, lane, wave); }
#endif
    GSYNC();
#if PROBE_DUP == 1
    { const Params p = load_params(); phase0(p, lds, tid, lane, wave); } GSYNC();
#endif
#if PROBE_DUP == 9
    GSYNC(); GSYNC(); GSYNC(); GSYNC(); GSYNC(); GSYNC(); GSYNC(); GSYNC(); GSYNC(); GSYNC();
#endif
#if PH & 2
    { const Params p = load_params(); phase1(p, lds, tid, lane, wave); }
#endif
    GSYNC();
#if PROBE_DUP == 2
    { const Params p = load_params(); phase1(p, lds, tid, lane, wave); } GSYNC();
#endif
#if PH & 4
    {
        const Params p = load_params();
        if (bx < 64) scan_item(p, lds, bx, tid, lane, wave);
        pg8::Gemm g{(const bf16_t*)(p.ws + WS_H), (const bf16_t*)(p.ws + WS_WIN), T_, 3072, 1024}; pg8::StaticOrder S; S.init(T_, 3072, G, bx);
        EpiIn E{(bf16_t*)(p.ws + WS_Q), (bf16_t*)(p.ws + WS_K), (bf16_t*)(p.ws + WS_VT), (bf16_t*)(p.ws + WS_Z), (bf16_t*)(p.ws + WS_BG), p.qg, p.kg};
        pg8::gemm_phase<EpiIn, pg8::StaticOrder, true, true>(lds, g, S, E);
    }
#endif
    GSYNC();
#if PH & 8
    { const Params p = load_params(); phase3(p, lds, tid, lane, wave); }
#endif
    GSYNC();
#if PH & 16
    {
        const Params p = load_params();
        pg8::Gemm g{(const bf16_t*)(p.ws + WS_MIX), (const bf16_t*)(p.ws + WS_WOUT), T_, 1024, 1024}; pg8::StaticOrder S; S.init(T_, 1024, G, bx);
        EpiOut E{p.x, (const float*)(p.ws + WS_MOD), p.n2g, (bf16_t*)(p.ws + WS_Q), (bf16_t*)(p.ws + WS_H), (float*)(p.ws + WS_ROWSS), (bf16_t*)(p.ws + WS_TAIL)};
        pg8::gemm_phase<EpiOut, pg8::StaticOrder, true, true>(lds, g, S, E);
#if PROBE_DUP == 7
        GSYNC();
        pg8::gemm_phase<EpiOut, pg8::StaticOrder, true, true>(lds, g, S, E);
#endif
    }
#endif
    GSYNC();
#if PH & 32
    {
        const Params p = load_params();
        pg8::Gemm g{(const bf16_t*)(p.ws + WS_H), (const bf16_t*)(p.ws + WS_WUP), 65 * 256, 2 * DFF, 1024};
        UpOrder S; S.init(65 * 256, 2 * DFF, G, bx); S.tail_off = (long)WS_TAIL - (long)WS_H;
        EpiUpF E{(const float*)(p.ws + WS_ROWSS), (const float*)(p.ws + WS_BIAS2), p.fcw, (bf16_t*)(p.ws + WS_ACT), (LAS float*)(lds + XCH_OFF)};
        pg8::gemm_phase<EpiUpF, UpOrder, true, true>(lds, g, S, E);
#if PROBE_DUP == 5
        GSYNC();
        pg8::gemm_phase<EpiUpF, UpOrder, true, true>(lds, g, S, E);
#endif
    }
#endif
    GSYNC();
#if PH & 128
    {
        const Params p = load_params();
        pg8::Gemm g{(const bf16_t*)(p.ws + WS_ACT), (const bf16_t*)(p.ws + WS_WDOWN), T_, 1024, DFF}; pg8::StaticOrder S; S.init(T_, 1024, G, bx);
#if PROBE_DUP == 8
        { EpiDown E0{(const float*)(p.ws + WS_MOD), (const bf16_t*)(p.ws + WS_Q), (float*)(p.ws + WS_K)};
          pg8::gemm_phase<EpiDown, pg8::StaticOrder, true, true>(lds, g, S, E0); GSYNC(); }
#endif
        EpiDown E{(const float*)(p.ws + WS_MOD), (const bf16_t*)(p.ws + WS_Q), p.out};
        pg8::gemm_phase<EpiDown, pg8::StaticOrder, true, true>(lds, g, S, E);
    }
#endif
}

extern "C" void kernel_launch(void* const* d_in, const int* in_sizes, int n_in, void* d_out, int out_size, void* d_ws, size_t ws_size, hipStream_t stream) {
    static int grid = 0;
    if (grid == 0) {
        int dev = 0, cus = 0, per_cu = 0;
        hipGetDevice(&dev); hipDeviceGetAttribute(&cus, hipDeviceAttributeMultiprocessorCount, dev);
        if (hipFuncSetAttribute((const void*)hymba_mega, hipFuncAttributeMaxDynamicSharedMemorySize, LDS_BYTES) != hipSuccess) fprintf(stderr, "hipFuncSetAttribute failed\n");
        if (hipOccupancyMaxActiveBlocksPerMultiprocessor(&per_cu, (const void*)hymba_mega, 512, LDS_BYTES) != hipSuccess || per_cu < 1) { fprintf(stderr, "occupancy query: %d\n", per_cu); per_cu = 1; }
        (void)hipGetLastError();
        grid = cus > 0 ? cus : 256;
    }
    Params p{};
    p.x = (const float*)d_in[0]; p.c = (const float*)d_in[1]; p.w_ada = (const float*)d_in[2]; p.b_ada = (const float*)d_in[3]; p.n1g = (const float*)d_in[4];
    p.w_in = (const float*)d_in[5]; p.b_f = (const float*)d_in[6]; p.qg = (const float*)d_in[7]; p.kg = (const float*)d_in[8]; p.cmw = (const float*)d_in[9];
    p.w_out = (const float*)d_in[10]; p.n2g = (const float*)d_in[11]; p.w_up = (const float*)d_in[12]; p.fcw = (const float*)d_in[13]; p.w_down = (const float*)d_in[14];
    p.out = (float*)d_out; p.ws = (unsigned char*)d_ws;
    (void)hipMemsetAsync((unsigned char*)d_ws + WS_BAR, 0, 16384, stream);
    void* args[] = {&p};
    hipError_t e = hipLaunchCooperativeKernel((const void*)hymba_mega, dim3(grid), dim3(512), args, LDS_BYTES, stream);
    if (e != hipSuccess) fprintf(stderr, "cooperative launch failed: %s (grid %d)\n", hipGetErrorString(e), grid);
}
```

```cpp
#include <hip/hip_runtime.h>
#include <hip/hip_cooperative_groups.h>
#include <cstdio>
#include <cstdint>
namespace cg = cooperative_groups;
#ifndef PROBE_DUP
#define PROBE_DUP 0
#endif
namespace pg8 {
#define PG8_LAS __attribute__((address_space(3)))
typedef unsigned short bf16_t;
typedef short bf16x8 __attribute__((ext_vector_type(8)));
typedef float f32x4 __attribute__((ext_vector_type(4)));
typedef unsigned u32x4 __attribute__((ext_vector_type(4)));
constexpr int BM = 256, BK = 64, HALF = 128, HTB = HALF * BK * 2  , STAGE_BYTES = 8 * HTB, NXCD = 8, WGM = 8;

__host__ __device__ __forceinline__ int lds_byte(int r, int c) { const int st = (r >> 4) * 2 + (c >> 5), rr = r & 15, cc = c & 31, ob = rr * 64 + cc * 2; return st * 1024 + (ob ^ (((ob >> 9) & 1) << 5)); }
__host__ __device__ __forceinline__ void stage_rc(int b, int& R, int& C) { const int st = b / 1024, sb = b % 1024, swz = sb ^ (((sb >> 9) & 1) << 5); R = (st >> 1) * 16 + swz / 64; C = (st & 1) * 32 + (swz % 64) / 2; }
__host__ __device__ __forceinline__ int perm32(int rho) { const int n = rho >> 4, i = rho & 15; return 8 * (i >> 2) + 4 * n + (i & 3); }

struct Unit { int pm, pn; };
struct Gemm { const bf16_t* A; const bf16_t* Bt; int M, N, K; };

struct StaticOrder {
    int nM, nN, nwg, G, c;
    __host__ __device__ void init(int M, int N, int G_, int c_) { nM = M / BM; nN = N / BM; nwg = nM * nN; G = G_; c = c_; }
    __host__ __device__ bool next(int i, Unit& u) const {
        const long L = (long)i * G + c; if (L >= nwg) return false;
        int wgid = (int)L; { const int q = nwg / NXCD, r = nwg % NXCD, xcd = wgid % NXCD, off = wgid / NXCD; wgid = (xcd < r ? xcd * (q + 1) : r * (q + 1) + (xcd - r) * q) + off; }
        const int nig = WGM * nN, gid = wgid / nig, fm = gid * WGM, gsz = (nM - fm) < WGM ? (nM - fm) : WGM;
        u.pm = fm + ((wgid % nig) % gsz); u.pn = (wgid % nig) / gsz; return true;
    }
    __device__ __forceinline__ void a_ready(const Unit&) const {}
    __device__ __forceinline__ void done(const Unit&) const {}
    __device__ __forceinline__ long a_off(int pm, size_t tstep) const { return (long)pm * (long)tstep; }
};

__device__ __forceinline__ unsigned cvt_pk_bf16(float lo, float hi) { unsigned r; asm volatile("v_cvt_pk_bf16_f32 %0, %1, %2" : "=v"(r) : "v"(lo), "v"(hi)); return r; }
typedef float f32x2 __attribute__((ext_vector_type(2)));
template <class Epi, class Sched, bool ALIGN_EPI = false, bool SP2 = false>
__device__ __forceinline__ void gemm_phase(PG8_LAS unsigned char* lds, const Gemm g, const Sched& S, const Epi& E) {
    int tid_o = threadIdx.x; asm volatile("" : "+v"(tid_o));
    const int tid = tid_o & 511, wid = __builtin_amdgcn_readfirstlane(tid >> 6), lane = tid & 63, wr = wid >> 2, wc = wid & 3, fr = lane & 15, fq = lane >> 4;
    const int K = g.K, nt = K / BK;
    unsigned voffA[2], voffB[2];
#pragma unroll
    for (int i = 0; i < 2; ++i) { int R, C; stage_rc(tid * 16 + i * 8192, R, C); const int Rb = Epi::PERM ? ((R & ~31) + perm32(R & 31)) : R;
        voffA[i] = (unsigned)(R * K + C) * 2u; voffB[i] = (unsigned)(Rb * K + C) * 2u; }
    const size_t kstep = (size_t)(BK * 2);
    const size_t hstep = (size_t)HALF * K * 2;
    const size_t tstep = 2 * hstep;
    const unsigned ldsw = (unsigned)wid * 1024u;
    const int aoff = lds_byte(wr * 64 + fr, fq * 8), boff = lds_byte(wc * 32 + fr, fq * 8);
#define PG8_SA(b, h) (((b) * 2 + (h)) * HTB)
#define PG8_SB(b, h) ((4 + (b) * 2 + (h)) * HTB)
#define PG8_STAGE(bufoff, gbase, voff) do { _Pragma("unroll") for (int _i = 0; _i < 2; ++_i) \
        __builtin_amdgcn_global_load_lds((const unsigned*)((const char*)(gbase) + (voff)[_i]), (PG8_LAS unsigned*)(lds + (bufoff) + ldsw + _i * 8192), 16, 0, 0); } while (0)
#define PG8_LDA(dst, b, h) do { _Pragma("unroll") for (int m = 0; m < 4; ++m) _Pragma("unroll") for (int k = 0; k < 2; ++k) dst[m][k] = *(const PG8_LAS bf16x8*)(lds + PG8_SA(b, h) + aoff + m * 2048 + k * 1024); } while (0)
#define PG8_LDB(dst, b, h) do { _Pragma("unroll") for (int n = 0; n < 2; ++n) _Pragma("unroll") for (int k = 0; k < 2; ++k) dst[n][k] = *(const PG8_LAS bf16x8*)(lds + PG8_SB(b, h) + boff + n * 2048 + k * 1024); } while (0)
#define PG8_MMA(ai, bj, At, Bt) do { __builtin_amdgcn_s_setprio(1); _Pragma("unroll") for (int m = 0; m < 4; ++m) _Pragma("unroll") for (int n = 0; n < 2; ++n) _Pragma("unroll") for (int k = 0; k < 2; ++k) \
        acc[ai][bj][m][n] = __builtin_amdgcn_mfma_f32_16x16x32_bf16(Bt[n][k], At[m][k], acc[ai][bj][m][n], 0, 0, 0); __builtin_amdgcn_s_setprio(0); } while (0)
#define PG8_WAIT_V(n) asm volatile("s_waitcnt vmcnt(" #n ")" ::: "memory")
#define PG8_WAIT_L(n) asm volatile("s_waitcnt lgkmcnt(" #n ")" ::: "memory")
#define PG8_BAR __builtin_amdgcn_s_barrier()
#define PG8_SCHED __builtin_amdgcn_sched_barrier(0)
    Unit cur, nxt; int ui = 0;
    if (!S.next(0, cur)) return;
    f32x4 acc[2][2][4][2];
#pragma unroll
    for (int a = 0; a < 2; ++a)
#pragma unroll
        for (int b = 0; b < 2; ++b)
#pragma unroll
            for (int m = 0; m < 4; ++m)
#pragma unroll
                for (int n = 0; n < 2; ++n) acc[a][b][m][n] = (f32x4){0.f, 0.f, 0.f, 0.f};
    bf16x8 At[4][2], B0[2][2], B1[2][2];
    const char* cA = (const char*)g.A + S.a_off(cur.pm, tstep); const char* cB = (const char*)g.Bt + (size_t)cur.pn * tstep;
    S.a_ready(cur);
    if constexpr (SP2) {
        PG8_STAGE(PG8_SB(0, 0), cB, voffB); PG8_STAGE(PG8_SB(0, 1), cB + hstep, voffB); PG8_STAGE(PG8_SA(0, 0), cA, voffA); PG8_STAGE(PG8_SA(0, 1), cA + hstep, voffA);
        if (wr == 1) PG8_BAR;
        PG8_WAIT_V(2); PG8_BAR;
        PG8_STAGE(PG8_SB(1, 0), cB + kstep, voffB); PG8_STAGE(PG8_SA(1, 0), cA + kstep, voffA); PG8_STAGE(PG8_SB(1, 1), cB + hstep + kstep, voffB);
        PG8_WAIT_V(6); PG8_BAR;
    } else {
        PG8_STAGE(PG8_SB(0, 0), cB, voffB); PG8_STAGE(PG8_SA(0, 0), cA, voffA); PG8_STAGE(PG8_SB(0, 1), cB + hstep, voffB); PG8_STAGE(PG8_SA(0, 1), cA + hstep, voffA);
        if (wr == 1) PG8_BAR;
        PG8_WAIT_V(4); PG8_BAR;
        PG8_STAGE(PG8_SB(1, 0), cB + kstep, voffB); PG8_STAGE(PG8_SA(1, 0), cA + kstep, voffA); PG8_STAGE(PG8_SB(1, 1), cB + hstep + kstep, voffB);
        PG8_WAIT_V(6); PG8_BAR;
    }
    for (;;) {
        const bool has_next = S.next(ui + 1, nxt);
        const char* nA = has_next ? (const char*)g.A + S.a_off(nxt.pm, tstep) : cA; const char* nB = has_next ? (const char*)g.Bt + (size_t)nxt.pn * tstep : cB;
        for (int t = 0; t < nt; t += 2) {
            const bool last = (t == nt - 2);
            const char* a1 = cA + (size_t)(t + 1) * kstep;
            const char* a2 = last ? nA : cA + (size_t)(t + 2) * kstep; const char* b2 = last ? nB : cB + (size_t)(t + 2) * kstep;
            const char* a3 = a2 + kstep; const char* b3 = b2 + kstep;
            if (last && has_next) S.a_ready(nxt);
            if constexpr (SP2) {
            PG8_LDB(B0, 0, 0); PG8_LDB(B1, 0, 1); PG8_SCHED; PG8_LDA(At, 0, 0); PG8_STAGE(PG8_SA(1, 1), a1 + hstep, voffA);
            PG8_WAIT_V(8); PG8_WAIT_L(0); PG8_BAR; PG8_MMA(0, 0, At, B0); PG8_MMA(0, 1, At, B1); PG8_BAR; PG8_SCHED;
            PG8_LDA(At, 0, 1); PG8_STAGE(PG8_SB(0, 0), b2, voffB); PG8_STAGE(PG8_SB(0, 1), b2 + hstep, voffB); PG8_STAGE(PG8_SA(0, 0), a2, voffA);
            PG8_WAIT_V(8); PG8_WAIT_L(0); PG8_BAR; PG8_MMA(1, 0, At, B0); PG8_MMA(1, 1, At, B1); PG8_BAR; PG8_SCHED;
            PG8_LDB(B0, 1, 0); PG8_LDB(B1, 1, 1); PG8_SCHED; PG8_LDA(At, 1, 0); PG8_STAGE(PG8_SA(0, 1), a2 + hstep, voffA);
            PG8_WAIT_V(8); PG8_WAIT_L(0); PG8_BAR; PG8_MMA(0, 0, At, B0); PG8_MMA(0, 1, At, B1); PG8_BAR; PG8_SCHED;
            PG8_LDA(At, 1, 1); PG8_STAGE(PG8_SB(1, 0), b3, voffB); PG8_STAGE(PG8_SB(1, 1), b3 + hstep, voffB); PG8_STAGE(PG8_SA(1, 0), a3, voffA);
            PG8_WAIT_V(8); PG8_WAIT_L(0); PG8_BAR; PG8_MMA(1, 0, At, B0); PG8_MMA(1, 1, At, B1); PG8_BAR; PG8_SCHED;
            } else {
            PG8_LDB(B0, 0, 0); PG8_SCHED; PG8_LDA(At, 0, 0); PG8_STAGE(PG8_SA(1, 1), a1 + hstep, voffA);
            PG8_WAIT_L(8); PG8_BAR; PG8_WAIT_L(0); PG8_MMA(0, 0, At, B0); PG8_BAR; PG8_SCHED;
            PG8_LDB(B1, 0, 1); PG8_STAGE(PG8_SB(0, 0), b2, voffB);
            PG8_BAR; PG8_WAIT_L(0); PG8_MMA(0, 1, At, B1); PG8_BAR;
            PG8_LDA(At, 0, 1); PG8_STAGE(PG8_SA(0, 0), a2, voffA);
            PG8_BAR; PG8_WAIT_L(0); PG8_MMA(1, 0, At, B0); PG8_BAR; PG8_SCHED;
            PG8_STAGE(PG8_SB(0, 1), b2 + hstep, voffB);
            PG8_WAIT_V(6); PG8_BAR; PG8_MMA(1, 1, At, B1); PG8_BAR;
            PG8_LDB(B0, 1, 0); PG8_SCHED; PG8_LDA(At, 1, 0); PG8_STAGE(PG8_SA(0, 1), a2 + hstep, voffA);
            PG8_WAIT_L(8); PG8_BAR; PG8_WAIT_L(0); PG8_MMA(0, 0, At, B0); PG8_BAR; PG8_SCHED;
            PG8_LDB(B1, 1, 1); PG8_STAGE(PG8_SB(1, 0), b3, voffB);
            PG8_BAR; PG8_WAIT_L(0); PG8_MMA(0, 1, At, B1); PG8_BAR;
            PG8_LDA(At, 1, 1); PG8_STAGE(PG8_SA(1, 0), a3, voffA);
            PG8_BAR; PG8_WAIT_L(0); PG8_MMA(1, 0, At, B0); PG8_BAR; PG8_SCHED;
            PG8_STAGE(PG8_SB(1, 1), b3 + hstep, voffB);
            PG8_WAIT_V(6); PG8_BAR; PG8_MMA(1, 1, At, B1); PG8_BAR;
            }
        }
        if constexpr (ALIGN_EPI) { if (wr == 0) PG8_BAR; }
        if constexpr (!Epi::AFTER_DRAIN) { E(acc, cur, wr, wc, fr, fq); S.done(cur); }
        if (!has_next) break;
#pragma unroll
        for (int a = 0; a < 2; ++a)
#pragma unroll
            for (int b = 0; b < 2; ++b)
#pragma unroll
                for (int m = 0; m < 4; ++m)
#pragma unroll
                    for (int n = 0; n < 2; ++n) acc[a][b][m][n] = (f32x4){0.f, 0.f, 0.f, 0.f};
        cur = nxt; cA = nA; cB = nB; ++ui;
        if constexpr (ALIGN_EPI) { if (wr == 1) PG8_BAR; }
    }
    PG8_WAIT_V(0);
    if constexpr (!ALIGN_EPI) { if (wr == 0) PG8_BAR; }
    PG8_BAR;
    if constexpr (Epi::AFTER_DRAIN) { E.fused(acc, cur, wr, wc, fr, fq, lds, wid, lane); S.done(cur); }
#undef PG8_SA
#undef PG8_SB
#undef PG8_STAGE
#undef PG8_LDA
#undef PG8_LDB
#undef PG8_MMA
#undef PG8_WAIT_V
#undef PG8_WAIT_L
#undef PG8_BAR
#undef PG8_SCHED
}
}
#define LAS __attribute__((address_space(3)))
typedef unsigned short bf16_t;
typedef short bf16x8 __attribute__((ext_vector_type(8)));
typedef float f32x4 __attribute__((ext_vector_type(4)));
typedef float f32x16 __attribute__((ext_vector_type(16)));
typedef unsigned u32x4 __attribute__((ext_vector_type(4)));
typedef unsigned u32x2 __attribute__((ext_vector_type(2)));
constexpr int T_ = 16384, D_ = 1024, S_ = 2048, NH = 8, DFF = 2816, DIN = 3080, NMOD = 6144, HALFC = 1408;
constexpr float EPS = 1e-6f;
constexpr float LOG2E = 1.4426950408889634f;
constexpr float C2 = 0.125f * LOG2E;
constexpr size_t MiB = 1u << 20;
constexpr size_t WS_MOD = 0, WS_BIAS2 = 256 * 1024, WS_ROWSS = 31 * MiB, WS_BAR = 640 * 1024, WS_LOGF = 1 * MiB, WS_QAUG = 2 * MiB, WS_KAUG = 4 * MiB,
    WS_WIN = 6 * MiB, WS_WOUT = 12 * MiB, WS_WUP = 14 * MiB, WS_WDOWN = 25 * MiB, WS_H = 32 * MiB, WS_Q = 64 * MiB, WS_K = 80 * MiB,
    WS_VT = 96 * MiB, WS_Z = 112 * MiB, WS_BG = 128 * MiB, WS_MIX = 144 * MiB, WS_ACT = 160 * MiB, WS_TAIL = 30 * MiB + 512 * 1024;
constexpr int LDS_BYTES = 139328;
constexpr int XCH_OFF = 131072 + 64;

struct Params {
    const float *x, *c, *w_ada, *b_ada, *n1g, *w_in, *b_f, *qg, *kg, *cmw, *w_out, *n2g, *w_up, *fcw, *w_down;
    float* out; unsigned char* ws;
};

__device__ __forceinline__ float wave_sum(float v) {
#pragma unroll
    for (int o = 1; o < 64; o <<= 1) v += __shfl_xor(v, o);
    return v;
}
__device__ __forceinline__ float xsum12(float v) {
    v += __builtin_bit_cast(float, __builtin_amdgcn_mov_dpp(__builtin_bit_cast(int, v), 0xB1, 0xf, 0xf, true));
    v += __builtin_bit_cast(float, __builtin_amdgcn_mov_dpp(__builtin_bit_cast(int, v), 0x4E, 0xf, 0xf, true));
    return v;
}
__device__ __forceinline__ unsigned f2bf(float f) { unsigned u = __builtin_bit_cast(unsigned, f); return (u + 0x7fffu + ((u >> 16) & 1u)) >> 16; }
__device__ __forceinline__ float bf2f(unsigned h) { return __builtin_bit_cast(float, h << 16); }
__device__ __forceinline__ unsigned pk2(float lo, float hi) { return pg8::cvt_pk_bf16(lo, hi); }
typedef float f32x2_t __attribute__((ext_vector_type(2))); typedef __bf16 bf16x2_t __attribute__((ext_vector_type(2)));
__device__ __forceinline__ unsigned cvtpk_s(float lo, float hi) { f32x2_t v = {lo, hi}; bf16x2_t b = __builtin_convertvector(v, bf16x2_t); return __builtin_bit_cast(unsigned, b); }
__device__ __forceinline__ void unpack8(u32x4 w, float (&f)[8]) {
    f[0] = bf2f(w.x & 0xffffu); f[1] = __builtin_bit_cast(float, w.x & 0xffff0000u);
    f[2] = bf2f(w.y & 0xffffu); f[3] = __builtin_bit_cast(float, w.y & 0xffff0000u);
    f[4] = bf2f(w.z & 0xffffu); f[5] = __builtin_bit_cast(float, w.z & 0xffff0000u);
    f[6] = bf2f(w.w & 0xffffu); f[7] = __builtin_bit_cast(float, w.w & 0xffff0000u);
}
__device__ __forceinline__ void st16wt(const void* base, unsigned off, u32x4 v) {
    const __amdgpu_buffer_rsrc_t rs = __builtin_amdgcn_make_buffer_rsrc(const_cast<void*>(base), 0, 0x7fffffff, 0x00020000);
    __builtin_amdgcn_raw_buffer_store_b128(v, rs, off, 0,   16);
}
__device__ __forceinline__ u32x4 pack8(const float (&f)[8]) { u32x4 w; w.x = pk2(f[0], f[1]); w.y = pk2(f[2], f[3]); w.z = pk2(f[4], f[5]); w.w = pk2(f[6], f[7]); return w; }

__device__ __forceinline__ void transpose_item(const float* W, int N, int K, bf16_t* WT, int dstrow0, int srccol0, int k0, LAS float* scr, int lane) {
    float tv[32];
    { const float* wp = W + (size_t)(k0 + (lane >> 5)) * N + srccol0 + (lane & 31);
#pragma unroll
      for (int i = 0; i < 32; ++i) tv[i] = __builtin_nontemporal_load(wp + (size_t)(2 * i) * N); }
#pragma unroll
    for (int i = 0; i < 32; ++i) scr[(2 * i + (lane >> 5)) * 33 + (lane & 31)] = tv[i];
    asm volatile("s_waitcnt lgkmcnt(0)" ::: "memory");
    const int c = lane & 7;
#pragma unroll
    for (int j = 0; j < 4; ++j) { const int n = (lane >> 3) + 8 * j; const LAS float* s = scr + (8 * c) * 33 + n;
        u32x4 o; o.x = pk2(s[0 * 33], s[1 * 33]); o.y = pk2(s[2 * 33], s[3 * 33]); o.z = pk2(s[4 * 33], s[5 * 33]); o.w = pk2(s[6 * 33], s[7 * 33]);
        st16wt(WT, (unsigned)(((dstrow0 + n) * K + k0 + 8 * c) * 2), o); }
    asm volatile("s_waitcnt lgkmcnt(0)" ::: "memory");
}
__device__ __forceinline__ int win_src(int p0) {
    const int pn = p0 >> 8, c = p0 & 255, bj = c >> 7, wc = (c & 127) >> 5;
    if (pn < 6) return (pn >> 1) * 512 + (4 * (pn & 1) + wc) * 64 + 32 * bj;
    if (pn < 10) return (bj == 0 ? 1544 : 2568) + 128 * (pn - 6) + (c & 127);
    return 2056 + 256 * (pn - 10) + c;
}
__device__ __forceinline__ int wup_src(int p0) { const int j = p0 >> 8, c = p0 & 255; return (c < 128) ? 128 * j + c : DFF + 128 * j + (c - 128); }

__device__ __forceinline__ void gemv_item(const float* W, int N, int n0, const float* bias, const LAS float* vecs, LAS float* red, float* out, int tid) {
    const int cgp = tid & 7, kg = tid >> 3;
    float acc[8][4];
#pragma unroll
    for (int b = 0; b < 8; ++b)
#pragma unroll
        for (int j = 0; j < 4; ++j) acc[b][j] = 0.f;
#pragma unroll 4
    for (int i = 0; i < 16; ++i) { const int k = kg + 64 * i; const f32x4 w = __builtin_nontemporal_load((const f32x4*)(W + (size_t)k * N + n0 + 4 * cgp));
#pragma unroll
        for (int b = 0; b < 8; ++b) { const float v = vecs[b * 1024 + k]; acc[b][0] += v * w.x; acc[b][1] += v * w.y; acc[b][2] += v * w.z; acc[b][3] += v * w.w; } }
#pragma unroll
    for (int b = 0; b < 8; ++b) *(LAS f32x4*)(red + (kg * 8 + b) * 32 + 4 * cgp) = (f32x4){acc[b][0], acc[b][1], acc[b][2], acc[b][3]};
    __syncthreads();
    if (tid < 256) { const int b = tid >> 5, col = tid & 31; float s = 0.f;
#pragma unroll 8
      for (int g = 0; g < 64; ++g) s += red[(g * 8 + b) * 32 + col];
      out[(size_t)b * N + n0 + col] = s + (bias ? bias[n0 + col] : 0.f); }
    __syncthreads();
}

__device__ __forceinline__ void transposes(const Params& p, LAS unsigned char* lds, int it_begin, int it_end, int gw, int NGW, int lane, int wave) {
    LAS float* scr = (LAS float*)(lds + wave * 8704);
    constexpr int I_IN = 16 * 96, I_OUT = 16 * 32, I_UP = 16 * 176;
    for (int it = it_begin + gw; it < it_end; it += NGW) {
        int r = it;
        if (r < I_IN) { const int kb = r / 96, nb = r % 96; transpose_item(p.w_in, DIN, 1024, (bf16_t*)(p.ws + WS_WIN), 32 * nb, win_src(32 * nb), 64 * kb, scr, lane); continue; } r -= I_IN;
        if (r < I_OUT) { const int kb = r / 32, nb = r % 32; transpose_item(p.w_out, 1024, 1024, (bf16_t*)(p.ws + WS_WOUT), 32 * nb, 32 * nb, 64 * kb, scr, lane); continue; } r -= I_OUT;
        if (r < I_UP) { const int kb = r / 176, nb = r % 176; transpose_item(p.w_up, 2 * DFF, 1024, (bf16_t*)(p.ws + WS_WUP), 32 * nb, wup_src(32 * nb), 64 * kb, scr, lane); continue; } r -= I_UP;
        { const int kb = r / 32, nb = r % 32; transpose_item(p.w_down, 1024, DFF, (bf16_t*)(p.ws + WS_WDOWN), 32 * nb, 32 * nb, 64 * kb, scr, lane); }
    }
}
constexpr int NIT_IN = 16 * 96, NIT_ALL = 16 * 96 + 16 * 32 + 16 * 176 + 44 * 32;
__device__ __forceinline__ void phase0(const Params& p, LAS unsigned char* lds, int tid, int lane, int wave) {
    float* mod = (float*)(p.ws + WS_MOD);
    const int ngemv = gridDim.x > 192 ? 192 : gridDim.x;
    if (blockIdx.x < ngemv) {
        LAS float* vecs = (LAS float*)lds; LAS float* red = (LAS float*)(lds + 32768);
        for (int i = tid; i < 8192; i += 512) { const float v = p.c[i]; vecs[i] = v / (1.f + __expf(-v)); }
        __syncthreads();
        for (int it = blockIdx.x; it < 192; it += ngemv) gemv_item(p.w_ada, NMOD, 32 * it, p.b_ada, vecs, red, mod, tid);
    } else {
        transposes(p, lds, 0, NIT_IN, (blockIdx.x - 192) * 8 + wave, (gridDim.x - 192) * 8, lane, wave);
    }
}

__device__ __forceinline__ void phase1(const Params& p, LAS unsigned char* lds, int tid, int lane, int wave) {
    const float* mod = (const float*)(p.ws + WS_MOD);
    if (blockIdx.x < 176) {
        LAS float* vecs = (LAS float*)lds; LAS float* red = (LAS float*)(lds + 32768);
        for (int i = tid; i < 8192; i += 512) vecs[i] = mod[(i >> 10) * NMOD + 3072 + (i & 1023)];
        __syncthreads();
        for (int it = blockIdx.x; it < 176; it += gridDim.x) gemv_item(p.w_up, 2 * DFF, 32 * it, nullptr, vecs, red, (float*)(p.ws + WS_BIAS2), tid);
    }
    transposes(p, lds, gridDim.x > 192 ? NIT_IN : 0, NIT_ALL, blockIdx.x * 8 + wave, gridDim.x * 8, lane, wave);
    __syncthreads();
    LAS float* wf = (LAS float*)lds;
    for (int i = tid; i < 8192; i += 512) { const int k = i >> 3, h = i & 7; wf[h * 1024 + k] = p.w_in[(size_t)k * DIN + 1536 + h]; }
    __syncthreads();
    bf16_t* hb = (bf16_t*)(p.ws + WS_H); float* logf = (float*)(p.ws + WS_LOGF);
    const int gw = blockIdx.x * 8 + wave, NGW = gridDim.x * 8;
    const int rpw = (T_ + NGW - 1) / NGW, r0 = gw * rpw, r1 = (r0 + rpw < T_) ? r0 + rpw : T_;
    const bool b5 = (lane & 32) != 0, b4 = (lane & 16) != 0, b3 = (lane & 8) != 0;
    f32x4 gmv[4], shv[4]; int bcur = -1;
    f32x4 vn[4];
    if (r0 < r1) {
#pragma unroll
        for (int j = 0; j < 4; ++j) vn[j] = __builtin_nontemporal_load((const f32x4*)(p.x + (size_t)r0 * D_ + 4 * lane + 256 * j)); }
    for (int row = r0; row < r1; ++row) {
        const int b = row >> 11;
        if (b != bcur) { bcur = b; const float* mb = mod + b * NMOD;
#pragma unroll
            for (int j = 0; j < 4; ++j) { const int col = 4 * lane + 256 * j; gmv[j] = *(const f32x4*)(p.n1g + col) * (*(const f32x4*)(mb + 1024 + col) + 1.f); shv[j] = *(const f32x4*)(mb + col); } }
        f32x4 v[4]; float ss = 0.f;
#pragma unroll
        for (int j = 0; j < 4; ++j) { v[j] = vn[j]; ss += (v[j].x * v[j].x + v[j].y * v[j].y) + (v[j].z * v[j].z + v[j].w * v[j].w); }
        if (row + 1 < r1) {
#pragma unroll
            for (int j = 0; j < 4; ++j) vn[j] = __builtin_nontemporal_load((const f32x4*)(p.x + (size_t)(row + 1) * D_ + 4 * lane + 256 * j)); }
        ss = xsum12(ss); ss += __shfl_xor(ss, 4); ss += __shfl_xor(ss, 8); ss += __shfl_xor(ss, 16); ss += __shfl_xor(ss, 32);
        const float rstd = rsqrtf(ss * (1.f / D_) + EPS);
#pragma unroll
        for (int j = 0; j < 4; ++j) { const int col = 4 * lane + 256 * j;
            v[j] = (v[j] * rstd) * gmv[j] + shv[j];
            u32x2 w; w.x = pk2(v[j].x, v[j].y); w.y = pk2(v[j].z, v[j].w);
            *(u32x2*)(hb + (size_t)row * D_ + col) = w; }
        float f[8];
#pragma unroll
        for (int h = 0; h < 8; ++h) { float sacc = 0.f;
#pragma unroll
            for (int j = 0; j < 4; ++j) { const f32x4 w = *(const LAS f32x4*)(wf + h * 1024 + 4 * lane + 256 * j); sacc += (v[j].x * w.x + v[j].y * w.y) + (v[j].z * w.z + v[j].w * w.w); }
            f[h] = sacc; }
        float g4[4], g2[2], z;
#pragma unroll
        for (int i = 0; i < 4; ++i) { const float send = b5 ? f[i] : f[4 + i], keep = b5 ? f[4 + i] : f[i]; g4[i] = keep + __shfl_xor(send, 32); }
#pragma unroll
        for (int i = 0; i < 2; ++i) { const float send = b4 ? g4[i] : g4[2 + i], keep = b4 ? g4[2 + i] : g4[i]; g2[i] = keep + __shfl_xor(send, 16); }
        { const float send = b3 ? g2[0] : g2[1], keep = b3 ? g2[1] : g2[0]; z = keep + __shfl_xor(send, 8); }
        z = xsum12(z); z += __shfl_xor(z, 4);
        if ((lane & 7) == 0) { const int h = lane >> 3; z += p.b_f[h]; logf[(size_t)row * 8 + h] = fminf(z, 0.f) - __logf(1.f + __expf(-fabsf(z))); }
    }
    __syncthreads();
}

__device__ __forceinline__ void scan_item(const Params& p, LAS unsigned char* lds, int bh, int tid, int lane, int wave) {
    const float* logf = (const float*)(p.ws + WS_LOGF); const int b = bh >> 3, h = bh & 7;
    LAS float* wt = (LAS float*)lds;
    float a[4];
#pragma unroll
    for (int i = 0; i < 4; ++i) a[i] = logf[((size_t)(b * S_ + 4 * tid + i)) * 8 + h];
    a[1] += a[0]; a[2] += a[1]; a[3] += a[2];
    float sc = a[3];
#pragma unroll
    for (int o = 1; o < 64; o <<= 1) { const float y = __shfl_up(sc, o); if (lane >= o) sc += y; }
    if (lane == 63) wt[wave] = sc;
    __syncthreads();
    float off = sc - a[3];
    for (int w = 0; w < wave; ++w) off += wt[w];
    u32x4* qa = (u32x4*)(p.ws + WS_QAUG) + (size_t)bh * S_ + 4 * tid; u32x4* ka = (u32x4*)(p.ws + WS_KAUG) + (size_t)bh * S_ + 4 * tid;
#pragma unroll
    for (int i = 0; i < 4; ++i) { const float F = (off + a[i]) * LOG2E;
        const unsigned hi = f2bf(F); const float r1 = F - bf2f(hi); const unsigned mid = f2bf(r1); const float r2 = r1 - bf2f(mid); const unsigned lo = f2bf(r2);
        u32x4 q, k; q.x = hi | (mid << 16); q.y = lo | (0x3F80u << 16); q.z = 0x3F803F80u; q.w = 0u;
        k.x = 0x3F803F80u; k.y = 0x3F80u | ((hi ^ 0x8000u) << 16); k.z = (mid ^ 0x8000u) | ((lo ^ 0x8000u) << 16); k.w = 0u;
        qa[i] = q; ka[i] = k; }
    __syncthreads();
}
struct EpiIn {
    static constexpr bool PERM = true, AFTER_DRAIN = false;
    bf16_t *Q, *K, *Vt, *Z, *BG; const float *qg, *kg;
    __device__ __forceinline__ void operator()(const f32x4 (&acc)[2][2][4][2], const pg8::Unit& u, int wr, int wc, int fr, int fq) const {
        const int pn = u.pn; const int row0 = u.pm * 256 + wr * 64 + fr;
        if (pn < 4) {
            const bool isq = pn < 2; const float* g = isq ? qg : kg; bf16_t* dst = isq ? Q : K; const int head = 4 * (pn & 1) + wc; const float mul = isq ? C2 : 1.f;
            f32x4 gv[2][2];
#pragma unroll
            for (int bj = 0; bj < 2; ++bj)
#pragma unroll
                for (int n = 0; n < 2; ++n) gv[bj][n] = *(const f32x4*)(g + 32 * bj + 8 * fq + 4 * n) * mul;
#pragma unroll
            for (int ai = 0; ai < 2; ++ai)
#pragma unroll
                for (int m = 0; m < 4; ++m) {
                    float ss = 0.f;
#pragma unroll
                    for (int bj = 0; bj < 2; ++bj)
#pragma unroll
                        for (int n = 0; n < 2; ++n) { const f32x4 a = acc[ai][bj][m][n]; ss += (a.x * a.x + a.y * a.y) + (a.z * a.z + a.w * a.w); }
                    ss += __shfl_xor(ss, 16); ss += __shfl_xor(ss, 32);
                    const float rinv = rsqrtf(ss * (1.f / 64.f) + EPS);
                    const unsigned row = (unsigned)(row0 + ai * 128 + m * 16);
#pragma unroll
                    for (int bj = 0; bj < 2; ++bj) { const f32x4 v0 = acc[ai][bj][m][0] * rinv * gv[bj][0], v1 = acc[ai][bj][m][1] * rinv * gv[bj][1];
                        u32x4 w; w.x = pk2(v0.x, v0.y); w.y = pk2(v0.z, v0.w); w.z = pk2(v1.x, v1.y); w.w = pk2(v1.z, v1.w);
                        st16wt(dst, (row * 512 + head * 64 + 32 * bj + 8 * fq) * 2u, w); }
                }
        } else if (pn < 6) {
            const int head = 4 * (pn & 1) + wc, b = u.pm >> 3;
            bf16_t* vb = Vt + (size_t)((b * 8 + head) * 64) * S_;
#pragma unroll
            for (int ai = 0; ai < 2; ++ai)
#pragma unroll
                for (int m = 0; m < 4; ++m) { const int t = (row0 + ai * 128 + m * 16) & (S_ - 1);
                    const int tp = (t & ~15) | (((t >> 2) & 1) << 3) | (((t >> 3) & 1) << 2) | (t & 3);
#pragma unroll
                    for (int bj = 0; bj < 2; ++bj)
#pragma unroll
                        for (int n = 0; n < 2; ++n) { const f32x4 a = acc[ai][bj][m][n]; const int d = 32 * bj + 8 * fq + 4 * n;
                            vb[(unsigned)((d + 0) * S_ + tp)] = (bf16_t)f2bf(a.x); vb[(unsigned)((d + 1) * S_ + tp)] = (bf16_t)f2bf(a.y);
                            vb[(unsigned)((d + 2) * S_ + tp)] = (bf16_t)f2bf(a.z); vb[(unsigned)((d + 3) * S_ + tp)] = (bf16_t)f2bf(a.w); }
                }
        } else if (pn < 10) {
            const int ch0 = 128 * (pn - 6) + 32 * wc + 8 * fq;
#pragma unroll
            for (int ai = 0; ai < 2; ++ai)
#pragma unroll
                for (int m = 0; m < 4; ++m) { const unsigned row = (unsigned)(row0 + ai * 128 + m * 16);
                    const f32x4 v0 = acc[ai][0][m][0] * acc[ai][1][m][0], v1 = acc[ai][0][m][1] * acc[ai][1][m][1];
                    u32x4 w; w.x = pk2(v0.x, v0.y); w.y = pk2(v0.z, v0.w); w.z = pk2(v1.x, v1.y); w.w = pk2(v1.z, v1.w);
                    st16wt(Z, (row * 512 + ch0) * 2u, w); }
        } else {
#pragma unroll
            for (int ai = 0; ai < 2; ++ai)
#pragma unroll
                for (int m = 0; m < 4; ++m) { const unsigned row = (unsigned)(row0 + ai * 128 + m * 16);
#pragma unroll
                    for (int bj = 0; bj < 2; ++bj) { const f32x4 v0 = acc[ai][bj][m][0], v1 = acc[ai][bj][m][1];
                        u32x4 w; w.x = pk2(v0.x, v0.y); w.y = pk2(v0.z, v0.w); w.z = pk2(v1.x, v1.y); w.w = pk2(v1.z, v1.w);
                        st16wt(BG, (row * 512 + 256 * (pn - 10) + 128 * bj + 32 * wc + 8 * fq) * 2u, w); } }
        }
    }
};
struct EpiOut {
    static constexpr bool PERM = true, AFTER_DRAIN = false;
    const float* x; const float* mod; const float* n2g; bf16_t* x1b; bf16_t* A2; float* rowss; bf16_t* A2tail;
    __device__ __forceinline__ void operator()(const f32x4 (&acc)[2][2][4][2], const pg8::Unit& u, int wr, int wc, int fr, int fq) const {
        const int b = u.pm >> 3, colb = u.pn * 256 + wc * 32 + 8 * fq; const int row0 = u.pm * 256 + wr * 64 + fr;
        const float* mb = mod + b * NMOD;
        f32x4 g1v[2][2], gm[2][2];
#pragma unroll
        for (int bj = 0; bj < 2; ++bj)
#pragma unroll
            for (int n = 0; n < 2; ++n) { const int col = colb + 128 * bj + 4 * n; g1v[bj][n] = *(const f32x4*)(mb + 2048 + col);
                gm[bj][n] = *(const f32x4*)(n2g + col) * (*(const f32x4*)(mb + 4096 + col) + 1.f); }
#pragma unroll
        for (int ai = 0; ai < 2; ++ai) {
            f32x4 xv[4][2][2];
#pragma unroll
            for (int m = 0; m < 4; ++m)
#pragma unroll
                for (int bj = 0; bj < 2; ++bj)
#pragma unroll
                    for (int n = 0; n < 2; ++n) xv[m][bj][n] = __builtin_nontemporal_load((const f32x4*)(x + ((unsigned)(row0 + ai * 128 + m * 16) * D_ + colb + 128 * bj + 4 * n)));
#pragma unroll
            for (int m = 0; m < 4; ++m) { const unsigned row = (unsigned)(row0 + ai * 128 + m * 16); float ss = 0.f;
#pragma unroll
                for (int bj = 0; bj < 2; ++bj) { f32x4 x1[2]; u32x4 xb;
#pragma unroll
                    for (int n = 0; n < 2; ++n) {
                        x1[n] = xv[m][bj][n] + g1v[bj][n] * acc[ai][bj][m][n];
                        ss += (x1[n].x * x1[n].x + x1[n].y * x1[n].y) + (x1[n].z * x1[n].z + x1[n].w * x1[n].w); if (n == 0) { xb.x = pk2(x1[0].x, x1[0].y); xb.y = pk2(x1[0].z, x1[0].w); } else { xb.z = pk2(x1[1].x, x1[1].y); xb.w = pk2(x1[1].z, x1[1].w); } x1[n] = x1[n] * gm[bj][n]; }
                    u32x4 w; w.x = pk2(x1[0].x, x1[0].y); w.y = pk2(x1[0].z, x1[0].w); w.z = pk2(x1[1].x, x1[1].y); w.w = pk2(x1[1].z, x1[1].w);
                    st16wt(A2, (row * D_ + colb + 128 * bj) * 2u, w);
                    st16wt(x1b, (row * D_ + colb + 128 * bj) * 2u, xb);
                    { const unsigned t = row & (S_ - 1); if (t >= 2016u) st16wt(A2tail, (((row >> 11) * 32 + (t - 2016u)) * D_ + colb + 128 * bj) * 2u, w); } }
                ss += __shfl_xor(ss, 16); ss += __shfl_xor(ss, 32);
                if (fq == 0) rowss[row * 16 + u.pn * 4 + wc] = ss; }
            asm volatile("" ::: "memory");
        }
    }
};
struct EpiUp {
    static constexpr bool PERM = true, AFTER_DRAIN = false;
    const float* rowss; const float* bias2; bf16_t* U; int half;
    __device__ __forceinline__ void operator()(const f32x4 (&acc)[2][2][4][2], const pg8::Unit& u, int wr, int wc, int fr, int fq) const {
        const int b = u.pm >> 3; const int row0 = u.pm * 256 + wr * 64 + fr;
        f32x4 bv[2][2];
#pragma unroll
        for (int bj = 0; bj < 2; ++bj)
#pragma unroll
            for (int n = 0; n < 2; ++n) bv[bj][n] = *(const f32x4*)(bias2 + b * (2 * DFF) + bj * DFF + half * HALFC + 128 * u.pn + 32 * wc + 8 * fq + 4 * n);
#pragma unroll
        for (int ai = 0; ai < 2; ++ai)
#pragma unroll
            for (int m = 0; m < 4; ++m) { const unsigned row = (unsigned)(row0 + ai * 128 + m * 16); const f32x4 s4 = *(const f32x4*)(rowss + row * 16 + 4 * fq); float sq = (s4.x + s4.y) + (s4.z + s4.w); sq += __shfl_xor(sq, 16); sq += __shfl_xor(sq, 32);
                const float rstd = rsqrtf(sq * (1.f / D_) + EPS);
#pragma unroll
                for (int bj = 0; bj < 2; ++bj) { const f32x4 v0 = acc[ai][bj][m][0] * rstd + bv[bj][0], v1 = acc[ai][bj][m][1] * rstd + bv[bj][1];
                    u32x4 w; w.x = pk2(v0.x, v0.y); w.y = pk2(v0.z, v0.w); w.z = pk2(v1.x, v1.y); w.w = pk2(v1.z, v1.w);
                    *(u32x4*)(U + (row * DFF + 256 * u.pn + 128 * bj + 32 * wc + 8 * fq)) = w; } }
    }
};

__device__ __forceinline__ float dpp_f(float old, float src, int which) {
    const int o = __builtin_bit_cast(int, old), v = __builtin_bit_cast(int, src); int r;
    if (which == 0) r = __builtin_amdgcn_update_dpp(o, v, 0x111, 0xf, 0xf, false);
    else if (which == 1) r = __builtin_amdgcn_update_dpp(o, v, 0x112, 0xf, 0xf, false);
    else if (which == 2) r = __builtin_amdgcn_mov_dpp(v, 0x121, 0xf, 0xf, true);
    else r = __builtin_amdgcn_mov_dpp(v, 0x122, 0xf, 0xf, true);
    return __builtin_bit_cast(float, r);
}
__device__ __forceinline__ float dppz(float src, int which) {
    const int v = __builtin_bit_cast(int, src); int r;
    if (which == 0) r = __builtin_amdgcn_update_dpp(0, v, 0x111, 0xf, 0xf, true);
    else if (which == 1) r = __builtin_amdgcn_update_dpp(0, v, 0x112, 0xf, 0xf, true);
    else if (which == 2) r = __builtin_amdgcn_mov_dpp(v, 0x121, 0xf, 0xf, true);
    else r = __builtin_amdgcn_mov_dpp(v, 0x122, 0xf, 0xf, true);
    return __builtin_bit_cast(float, r);
}
#define FMAC_DPP4(G, V, sg, sv, wa, wb, wc, wd, c1, c2) \
    asm("s_nop 1\n\tv_fmac_f32_dpp %0, %2, %4 " c1 " row_mask:0xf bank_mask:0xf bound_ctrl:1\n\tv_fmac_f32_dpp %0, %2, %5 " c2 " row_mask:0xf bank_mask:0xf bound_ctrl:1\n\t" \
        "v_fmac_f32_dpp %1, %3, %6 " c1 " row_mask:0xf bank_mask:0xf bound_ctrl:1\n\tv_fmac_f32_dpp %1, %3, %7 " c2 " row_mask:0xf bank_mask:0xf bound_ctrl:1" \
        : "+v"(G), "+v"(V) : "v"(sg), "v"(sv), "v"(wa), "v"(wb), "v"(wc), "v"(wd))
struct UpOrder : pg8::StaticOrder {
    long tail_off;
    __device__ __forceinline__ long a_off(int pm, size_t) const { return pm < 64 ? ((long)((pm >> 3) * S_ + 254 * (pm & 7) - 2)) * (D_ * 2) : tail_off; }
};
struct EpiUpF {
    static constexpr bool PERM = true, AFTER_DRAIN = false;
    const float* rowss; const float* bias2; const float* fcw; bf16_t* act; LAS float* xch;
    __device__ __forceinline__ void operator()(f32x4 (&acc)[2][2][4][2], const pg8::Unit& u, int wr, int wc, int fr, int fq) const {
        if (u.pm == 64) run<true>(acc, u, wr, wc, fr, fq); else run<false>(acc, u, wr, wc, fr, fq);
    }
    template <bool tail> __device__ __forceinline__ void run(f32x4 (&acc)[2][2][4][2], const pg8::Unit& u, int wr, int wc, int fr_in, int fq_in) const {
        int fr = fr_in, fq = fq_in; asm volatile("" : "+v"(fr), "+v"(fq));
        fr &= 15; fq &= 3;
        const int pm = u.pm, pn = u.pn; const int breg = pm >> 3, ireg = pm & 7;
        const int rbase = wr * 64 + fr, colg = 32 * wc + 8 * fq, chan0 = 128 * pn + colg;
        const int tok0 = breg * S_ + 254 * ireg - 2;
        const bool zfirst = !tail && ireg == 0 && wr == 0 && fr < 2;
        float rstd[2][4];
#pragma unroll
        for (int ai = 0; ai < 2; ++ai)
#pragma unroll
            for (int m = 0; m < 4; ++m) {
                const int r = rbase + 128 * ai + 16 * m; int grow = tail ? (r >> 5) * S_ + 2016 + (r & 31) : tok0 + r; grow = grow < 0 ? 0 : grow;
                const f32x4 s4 = *(const f32x4*)(rowss + (unsigned)grow * 16 + 4 * fq); float sq = (s4.x + s4.y) + (s4.z + s4.w); sq += __shfl_xor(sq, 16); sq += __shfl_xor(sq, 32);
                rstd[ai][m] = rsqrtf(sq * (1.f / D_) + EPS);
            }
#pragma unroll
        for (int ai = 0; ai < 2; ++ai) { const float* bp = bias2 + (tail ? (4 * ai + 2 * wr + 1) : breg) * (2 * DFF) + chan0;
#pragma unroll
            for (int bj = 0; bj < 2; ++bj)
#pragma unroll
                for (int n = 0; n < 2; ++n) { const f32x4 v = acc[ai][bj][3][n] * rstd[ai][3] + *(const f32x4*)(bp + bj * DFF + 4 * n);
                    if (fr >= 14) *(LAS f32x4*)(xch + (((2 * ai + wr) * 2 + (fr - 14)) * 256 + 128 * bj + colg + 4 * n)) = v; } }
        asm volatile("s_waitcnt lgkmcnt(0)" ::: "memory"); __builtin_amdgcn_s_barrier(); asm volatile("" ::: "memory");
#pragma unroll
        for (int n = 0; n < 2; ++n) {
            const float* wp = fcw + chan0 + 4 * n;
            const f32x4 wg0 = *(const f32x4*)(wp), wg1 = *(const f32x4*)(wp + 2 * DFF), wg2 = *(const f32x4*)(wp + 4 * DFF);
            const f32x4 wv0 = *(const f32x4*)(wp + DFF), wv1 = *(const f32x4*)(wp + 3 * DFF), wv2 = *(const f32x4*)(wp + 5 * DFF);
            f32x4 bg = (f32x4){0.f, 0.f, 0.f, 0.f}, bvl = bg;
            if (!tail) { bg = *(const f32x4*)(bias2 + breg * (2 * DFF) + chan0 + 4 * n); bvl = *(const f32x4*)(bias2 + breg * (2 * DFF) + DFF + chan0 + 4 * n); }
            f32x4 ag, bgm, av, bvm;
#pragma unroll
            for (int e = 0; e < 4; ++e) { ag[e] = fr == 0 ? wg1[e] : 0.f; bgm[e] = fr < 2 ? wg0[e] : 0.f; av[e] = fr == 0 ? wv1[e] : 0.f; bvm[e] = fr < 2 ? wv0[e] : 0.f; }
#pragma unroll
            for (int ai = 0; ai < 2; ++ai) {
                const int slot = 2 * ai + wr - 1;
                f32x4 g14 = (f32x4){0.f, 0.f, 0.f, 0.f}, g15 = g14, v14 = g14, v15 = g14;
                if (slot >= 0) { const LAS float* xp = xch + (slot * 2) * 256 + colg + 4 * n;
                    g14 = *(const LAS f32x4*)(xp); g15 = *(const LAS f32x4*)(xp + 256); v14 = *(const LAS f32x4*)(xp + 128); v15 = *(const LAS f32x4*)(xp + 256 + 128); }
                f32x4 pg = g14, pv = g14;
#pragma unroll
                for (int m = 0; m < 4; ++m) {
                    const int r = rbase + 128 * ai + 16 * m;
                    if (tail) { const float* bp = bias2 + (4 * ai + 2 * wr + (m >> 1)) * (2 * DFF) + chan0 + 4 * n; bg = *(const f32x4*)(bp); bvl = *(const f32x4*)(bp + DFF); }
                    f32x4 cg_ = acc[ai][0][m][n] * rstd[ai][m] + bg, cv_ = acc[ai][1][m][n] * rstd[ai][m] + bvl;
                    if (ai == 0 && m == 0) { if (zfirst) { cg_ = (f32x4){0.f, 0.f, 0.f, 0.f}; cv_ = cg_; } }
                    float o[4];
#pragma unroll
                    for (int e = 0; e < 4; ++e) {
                        float G = wg2[e] * cg_[e], V = wv2[e] * cv_[e];
                        FMAC_DPP4(G, V, cg_[e], cv_[e], wg1[e], wg0[e], wv1[e], wv0[e], "row_shr:1", "row_shr:2");
                        if (m == 0) { const float x2g = (fr == 0) ? g14[e] : g15[e], x2v = (fr == 0) ? v14[e] : v15[e];
                            G = __builtin_fmaf(g15[e], ag[e], G); G = __builtin_fmaf(x2g, bgm[e], G); V = __builtin_fmaf(v15[e], av[e], V); V = __builtin_fmaf(x2v, bvm[e], V); }
                        else { FMAC_DPP4(G, V, pg[e], pv[e], ag[e], bgm[e], av[e], bvm[e], "row_ror:1", "row_ror:2"); }
                        o[e] = G * __builtin_amdgcn_rcpf(1.f + __expf(-G)) * V;
                    }
                    pg = cg_; pv = cv_;
                    bool outv; int tg;
                    if (tail) { outv = (m & 1) != 0; tg = (r >> 5) * S_ + 2016 + (r & 31); } else { outv = r >= 2; tg = tok0 + r; }
                    if (outv) { u32x2 w; w.x = pk2(o[0], o[1]); w.y = pk2(o[2], o[3]); *(u32x2*)(act + ((unsigned)tg * DFF + chan0 + 4 * n)) = w; }
                    __builtin_amdgcn_sched_barrier(0);
                }
            }
        }
    }
};
struct EpiDown {
    static constexpr bool PERM = true, AFTER_DRAIN = false;
    const float* mod; const bf16_t* x1b; float* dst;
    __device__ __forceinline__ void operator()(const f32x4 (&acc)[2][2][4][2], const pg8::Unit& u, int wr, int wc, int fr, int fq) const {
        const int b = u.pm >> 3, colb = u.pn * 256 + wc * 32 + 8 * fq; const int row0 = u.pm * 256 + wr * 64 + fr;
        const float* mb = mod + b * NMOD + 5120;
        f32x4 g2v[2][2];
#pragma unroll
        for (int bj = 0; bj < 2; ++bj)
#pragma unroll
            for (int n = 0; n < 2; ++n) g2v[bj][n] = *(const f32x4*)(mb + colb + 128 * bj + 4 * n);
#pragma unroll
        for (int ai = 0; ai < 2; ++ai) {
            u32x4 xw[4][2];
#pragma unroll
            for (int m = 0; m < 4; ++m)
#pragma unroll
                for (int bj = 0; bj < 2; ++bj) xw[m][bj] = __builtin_nontemporal_load((const u32x4*)(x1b + ((unsigned)(row0 + ai * 128 + m * 16) * D_ + colb + 128 * bj)));
#pragma unroll
            for (int m = 0; m < 4; ++m) { const unsigned row = (unsigned)(row0 + ai * 128 + m * 16);
#pragma unroll
                for (int bj = 0; bj < 2; ++bj) { float xf[8]; unpack8(xw[m][bj], xf);
#pragma unroll
                    for (int n = 0; n < 2; ++n) { const unsigned o_ = row * D_ + colb + 128 * bj + 4 * n;
                        *(f32x4*)(dst + o_) = (f32x4){xf[4 * n], xf[4 * n + 1], xf[4 * n + 2], xf[4 * n + 3]} + g2v[bj][n] * acc[ai][bj][m][n]; } } }
            asm volatile("" ::: "memory");
        }
    }
};

__device__ __forceinline__ int crow(int r, int hi) { return (r & 3) + 8 * (r >> 2) + 4 * hi; }
constexpr int AB_K = 0, AB_V = 9216, AB_A = 18432, ABUF = 19456, A_LW = 2 * ABUF;
__device__ __forceinline__ void attn_unit(const Params& p, LAS unsigned char* lds, int bh, int qb, float mshift, int tid, int lane, int wave) {
    const int r32 = lane & 31, hi = lane >> 5, b = bh >> 3, h = bh & 7;
    const bf16_t* Qg = (const bf16_t*)(p.ws + WS_Q); const bf16_t* Kg = (const bf16_t*)(p.ws + WS_K); const bf16_t* Vg = (const bf16_t*)(p.ws + WS_VT);
    const u32x4* qaug = (const u32x4*)(p.ws + WS_QAUG) + (size_t)bh * S_; const u32x4* kaug = (const u32x4*)(p.ws + WS_KAUG) + (size_t)bh * S_;
    bf16_t* mix = (bf16_t*)(p.ws + WS_MIX);
    const int q_rel = 32 * wave + r32, tq = 256 * qb + q_rel;
    bf16x8 qr[4], qa;
    { const bf16_t* qp = Qg + ((size_t)(b * S_ + tq)) * 512 + h * 64 + 8 * hi;
#pragma unroll
      for (int d0 = 0; d0 < 4; ++d0) qr[d0] = *(const bf16x8*)(qp + 16 * d0);
      u32x4 t = qaug[tq]; if (hi) t = (u32x4){0u, 0u, 0u, 0u}; qa = __builtin_bit_cast(bf16x8, t); }
    f32x16 o[2]; float lsum = 0.f;
#pragma unroll
    for (int i = 0; i < 16; ++i) { o[0][i] = 0.f; o[1][i] = 0.f; }
    const int NT = 4 * (qb + 1);
    const int srow = tid >> 3, sch = tid & 7;
    const bf16_t* kp = Kg + ((size_t)(b * S_ + srow)) * 512 + h * 64 + 8 * sch;
    const bf16_t* vp = Vg + ((size_t)(bh * 64 + srow)) * S_ + 8 * sch;
    u32x4 kreg = *(const u32x4*)kp, vreg = *(const u32x4*)vp, areg = (u32x4){0u, 0u, 0u, 0u};
    if (tid < 64) areg = kaug[tid];
    { LAS unsigned char* bb = lds; *(LAS u32x4*)(bb + AB_K + srow * 144 + sch * 16) = kreg; *(LAS u32x4*)(bb + AB_V + srow * 144 + sch * 16) = vreg; if (tid < 64) *(LAS u32x4*)(bb + AB_A + tid * 16) = areg; }
    __syncthreads();
    for (int j = 0; j < NT; ++j) {
        const bool more = (j + 1 < NT);
        if (more) { kreg = *(const u32x4*)(kp + (size_t)(j + 1) * 64 * 512); vreg = *(const u32x4*)(vp + (j + 1) * 64); if (tid < 64) areg = kaug[(j + 1) * 64 + tid]; }
        const LAS unsigned char* bb = lds + (j & 1) * ABUF;
        const int jb = j - 4 * qb;
#pragma unroll
        for (int kh = 0; kh < 2; ++kh) {
            if (jb >= 0 && 64 * jb + 32 * kh > 32 * wave + 31) continue;
            f32x16 C;
#pragma unroll
            for (int i = 0; i < 16; ++i) C[i] = -mshift;
            const LAS unsigned char* kr = bb + AB_K + (32 * kh + r32) * 144 + hi * 16;
#pragma unroll
            for (int d0 = 0; d0 < 4; ++d0) { const bf16x8 a = *(const LAS bf16x8*)(kr + d0 * 32); C = __builtin_amdgcn_mfma_f32_32x32x16_bf16(a, qr[d0], C, 0, 0, 0); }
            { u32x4 t = *(const LAS u32x4*)(bb + AB_A + (32 * kh + r32) * 16); if (hi) t = (u32x4){0u, 0u, 0u, 0u};
              C = __builtin_amdgcn_mfma_f32_32x32x16_bf16(__builtin_bit_cast(bf16x8, t), qa, C, 0, 0, 0); }
            if (jb >= 0) {
#pragma unroll
                for (int i = 0; i < 16; ++i) { const int kv = 64 * jb + 32 * kh + crow(i, hi); if (kv > q_rel) C[i] = -INFINITY; }
            }
#pragma unroll
            for (int i = 0; i < 16; ++i) { C[i] = __builtin_amdgcn_exp2f(C[i]); lsum += C[i]; }
#pragma unroll
            for (int s = 0; s < 2; ++s) {
                u32x4 pw; pw.x = cvtpk_s(C[8 * s + 0], C[8 * s + 1]); pw.y = cvtpk_s(C[8 * s + 2], C[8 * s + 3]); pw.z = cvtpk_s(C[8 * s + 4], C[8 * s + 5]); pw.w = cvtpk_s(C[8 * s + 6], C[8 * s + 7]);
                const bf16x8 pa = __builtin_bit_cast(bf16x8, pw);
#pragma unroll
                for (int dh = 0; dh < 2; ++dh) { const bf16x8 vf = *(const LAS bf16x8*)(bb + AB_V + (32 * dh + r32) * 144 + (32 * kh + 16 * s + 8 * hi) * 2);
                    o[dh] = __builtin_amdgcn_mfma_f32_32x32x16_bf16(pa, vf, o[dh], 0, 0, 0); }
            }
        }
        if (more) { LAS unsigned char* nb = lds + ((j + 1) & 1) * ABUF; *(LAS u32x4*)(nb + AB_K + srow * 144 + sch * 16) = kreg; *(LAS u32x4*)(nb + AB_V + srow * 144 + sch * 16) = vreg; if (tid < 64) *(LAS u32x4*)(nb + AB_A + tid * 16) = areg; }
        __syncthreads();
    }
    lsum += __shfl_xor(lsum, 32);
    LAS float* lw = (LAS float*)(lds + A_LW + wave * 128);
    if (hi == 0) lw[r32] = lsum;
    asm volatile("s_waitcnt lgkmcnt(0)" ::: "memory");
    bf16_t* op = mix + ((size_t)(b * S_ + 256 * qb + 32 * wave)) * D_ + h * 64 + r32;
#pragma unroll
    for (int i = 0; i < 16; ++i) { const int qq = crow(i, hi); const float rl = 1.f / lw[qq];
        op[(size_t)qq * D_] = (bf16_t)f2bf(o[0][i] * rl); op[(size_t)qq * D_ + 32] = (bf16_t)f2bf(o[1][i] * rl); }
    asm volatile("s_waitcnt lgkmcnt(0)" ::: "memory");
}

__device__ __forceinline__ void phase3(const Params& p, LAS unsigned char* lds, int tid, int lane, int wave) {
    float mq = 0.f, mk = 0.f;
    for (int i = 0; i < 64; ++i) { mq = fmaxf(mq, fabsf(p.qg[i])); mk = fmaxf(mk, fabsf(p.kg[i])); }
    const float mshift = 8.f * LOG2E * 1.03f * mq * mk;
    const int G = gridDim.x, bx = blockIdx.x; const int vcu = (G % 8 == 0) ? (bx % 8) * (G / 8) + bx / 8 : bx;
    for (int pr = vcu; pr < 256; pr += G) { const int bh = pr >> 2, s = pr & 3;
#if PROBE_DUP == 4
        for (int rep = 0; rep < 4; ++rep) { int e = rep & 1; asm volatile("" : "+s"(e)); attn_unit(p, lds, bh, e ? s : 7 - s, mshift, tid, lane, wave); }
#else
        for (int rep = 0; rep < 2; ++rep) { int e = rep; asm volatile("" : "+s"(e)); attn_unit(p, lds, bh, e ? s : 7 - s, mshift, tid, lane, wave); }
#endif
    }
    const bf16_t* Z = (const bf16_t*)(p.ws + WS_Z); const bf16_t* BG = (const bf16_t*)(p.ws + WS_BG); bf16_t* mix = (bf16_t*)(p.ws + WS_MIX);
    for (int it = bx * 512 + tid; it < (T_ / 8) * 64; it += G * 512) {
        const int rc = it >> 6, c0 = 8 * (it & 63), t0 = 8 * rc;
        float w0[8], w1[8], w2[8], z1[8], z2[8];
#pragma unroll
        for (int i = 0; i < 8; ++i) { w0[i] = p.cmw[c0 + i]; w1[i] = p.cmw[512 + c0 + i]; w2[i] = p.cmw[1024 + c0 + i]; z1[i] = 0.f; z2[i] = 0.f; }
        if (t0 & (S_ - 1)) { unpack8(*(const u32x4*)(Z + (size_t)(t0 - 2) * 512 + c0), z2); unpack8(*(const u32x4*)(Z + (size_t)(t0 - 1) * 512 + c0), z1); }
#pragma unroll
        for (int r = 0; r < 8; ++r) { float zc[8], bg[8], ov[8];
            unpack8(*(const u32x4*)(Z + (size_t)(t0 + r) * 512 + c0), zc); unpack8(*(const u32x4*)(BG + (size_t)(t0 + r) * 512 + c0), bg);
#pragma unroll
            for (int i = 0; i < 8; ++i) { ov[i] = bg[i] * (w0[i] * z2[i] + w1[i] * z1[i] + w2[i] * zc[i]); z2[i] = z1[i]; z1[i] = zc[i]; }
            st16wt(mix, (unsigned)(((t0 + r) * D_ + 512 + c0) * 2), pack8(ov)); }
    }
}

#define XB_TMO      128
#define XB_XCNT(j)  (256  + 64 * (j))
#define XB_XSUB(j)  (1280 + 64 * (j))
#define XB_XGEN(j)  (2304 + 64 * (j))
#define XB_TOP      3328
#define XB_TOPGEN   3392
#define XCD_BAR_WORDS 3456
#define XB_SPIN_CAP (1u << 18)

__device__ __forceinline__ unsigned xb_ld(unsigned* p)              { return __hip_atomic_load(p, __ATOMIC_RELAXED, __HIP_MEMORY_SCOPE_AGENT); }
__device__ __forceinline__ unsigned xb_add(unsigned* p, unsigned v) { return __hip_atomic_fetch_add(p, v, __ATOMIC_RELAXED, __HIP_MEMORY_SCOPE_AGENT); }
__device__ __forceinline__ unsigned xb_xcc_id() { return (unsigned)__builtin_amdgcn_s_getreg((3 << 11) | 20) & 0xFu; }
#define XB_SPIN(cond, bar) do { unsigned _sp = 0; while (cond) { __builtin_amdgcn_s_sleep(1); \
    if ((++_sp & 255u) == 0u) { if (xb_ld(&(bar)[XB_TMO])) break; if (_sp > XB_SPIN_CAP) { atomicAdd(&(bar)[XB_TMO], 1u); break; } } } } while (0)

struct XcdBarrier {
    unsigned* bar; unsigned x;
    volatile LAS unsigned* st;
};

__device__ __forceinline__ XcdBarrier xcd_barrier_post(unsigned* bar, volatile LAS unsigned* st) {
    XcdBarrier b; b.bar = bar; b.x = xb_xcc_id(); b.st = st;
    if (threadIdx.x == 0) (void)xb_add(&bar[XB_XCNT(b.x)], 1u);
    return b;
}
__device__ __forceinline__ void xcd_barrier_complete(unsigned* bar, unsigned x, unsigned& nloc, unsigned& nx) {
    const unsigned G = gridDim.x * gridDim.y * gridDim.z;
    unsigned sum, cnt, mine, sp = 0u;
    for (;;) {
        sum = 0u; cnt = 0u; mine = 0u;
#pragma unroll
        for (unsigned j = 0; j < 16; ++j) { const unsigned c = xb_ld(&bar[XB_XCNT(j)]); sum += c; cnt += (c > 0u) ? 1u : 0u; mine = (j == x) ? c : mine; }
        if (sum == G) break;
        __builtin_amdgcn_s_sleep(1);
        if ((++sp & 255u) == 0u) { if (xb_ld(&bar[XB_TMO])) break; if (sp > XB_SPIN_CAP) { atomicAdd(&bar[XB_TMO], 1u); break; } }
    }
    nloc = mine > 0u ? mine : 1u; nx = cnt > 0u ? cnt : 1u;
}

__device__ __forceinline__ void xcd_barrier(const XcdBarrier& b) {
    asm volatile("s_waitcnt vmcnt(0)" ::: "memory");
    __syncthreads();
    if (threadIdx.x == 0) {
        unsigned* bar = b.bar;
        __builtin_amdgcn_s_waitcnt(0);
        unsigned nloc = b.st[0], nx = b.st[1];
        if (nloc == 0u) { xcd_barrier_complete(bar, b.x, nloc, nx); b.st[0] = nloc; b.st[1] = nx; }
        const unsigned old = xb_add(&bar[XB_XSUB(b.x)], 1u);
        const unsigned gen = old / nloc;
        if (old + 1u == (gen + 1u) * nloc) {
            __builtin_amdgcn_fence(__ATOMIC_RELEASE, "agent");
            asm volatile("s_waitcnt vmcnt(0)" ::: "memory");
            const unsigned og = xb_add(&bar[XB_TOP], 1u);
            const unsigned tg = og / nx;
            if (og + 1u == (tg + 1u) * nx) xb_add(&bar[XB_TOPGEN], 1u);
            else XB_SPIN(xb_ld(&bar[XB_TOPGEN]) == tg, bar);
            __builtin_amdgcn_fence(__ATOMIC_ACQUIRE, "agent");
            xb_add(&bar[XB_XGEN(b.x)], 1u);
            asm volatile("s_waitcnt vmcnt(0)" ::: "memory");
        } else {
            XB_SPIN(xb_ld(&bar[XB_XGEN(b.x)]) == gen, bar);
            __builtin_amdgcn_fence(__ATOMIC_ACQUIRE, "agent");
            asm volatile("s_waitcnt vmcnt(0)" ::: "memory");
        }
    }
    __syncthreads();
}

__device__ __forceinline__ const void* ldarg(int byteoff) { const void* r;
    asm volatile("s_load_dwordx2 %0, %1, %2\n\ts_waitcnt lgkmcnt(0)" : "=s"(r) : "s"(__builtin_amdgcn_kernarg_segment_ptr()), "i"(byteoff) : "memory"); return r; }
#define LDA(i) ((const float*)ldarg(8 * (i)))
#define GASF __attribute__((address_space(1)))
__device__ __forceinline__ Params load_params() {
    unsigned long long v0, v1, v2, v3, v4, v5, v6, v7, v8, v9, v10, v11, v12, v13, v14, v15, v16;
    asm volatile("s_load_dwordx2 %0, %17, 0\n\ts_load_dwordx2 %1, %17, 8\n\ts_load_dwordx2 %2, %17, 16\n\ts_load_dwordx2 %3, %17, 24\n\ts_load_dwordx2 %4, %17, 32\n\ts_load_dwordx2 %5, %17, 40\n\t"
                 "s_load_dwordx2 %6, %17, 48\n\ts_load_dwordx2 %7, %17, 56\n\ts_load_dwordx2 %8, %17, 64\n\ts_load_dwordx2 %9, %17, 72\n\ts_load_dwordx2 %10, %17, 80\n\ts_load_dwordx2 %11, %17, 88\n\t"
                 "s_load_dwordx2 %12, %17, 96\n\ts_load_dwordx2 %13, %17, 104\n\ts_load_dwordx2 %14, %17, 112\n\ts_load_dwordx2 %15, %17, 120\n\ts_load_dwordx2 %16, %17, 128\n\ts_waitcnt lgkmcnt(0)"
                 : "=&s"(v0), "=&s"(v1), "=&s"(v2), "=&s"(v3), "=&s"(v4), "=&s"(v5), "=&s"(v6), "=&s"(v7), "=&s"(v8), "=&s"(v9),
                   "=&s"(v10), "=&s"(v11), "=&s"(v12), "=&s"(v13), "=&s"(v14), "=&s"(v15), "=&s"(v16)
                 : "s"(__builtin_amdgcn_kernarg_segment_ptr()) : "memory");
#define GP(v) ((const float*)(GASF const float*)(v))
    Params q; q.x = GP(v0); q.c = GP(v1); q.w_ada = GP(v2); q.b_ada = GP(v3); q.n1g = GP(v4); q.w_in = GP(v5); q.b_f = GP(v6); q.qg = GP(v7); q.kg = GP(v8); q.cmw = GP(v9);
    q.w_out = GP(v10); q.n2g = GP(v11); q.w_up = GP(v12); q.fcw = GP(v13); q.w_down = GP(v14); q.out = (float*)(GASF float*)(v15); q.ws = (unsigned char*)(GASF unsigned char*)(v16);
    return q; }
#ifndef PH
#define PH 255
#endif
#ifndef LAST_PHASE
#define LAST_PHASE 99
#endif
__global__ void __launch_bounds__(512, 2) hymba_mega(Params p_arg) {
    extern __shared__ __attribute__((aligned(16))) unsigned char lds_raw[];
    cg::grid_group grid = cg::this_grid();
    LAS unsigned char* lds = (LAS unsigned char*)lds_raw;
    const int tid = threadIdx.x, lane = tid & 63, wave = __builtin_amdgcn_readfirstlane(tid >> 6);
    const int G = gridDim.x, bx = blockIdx.x;
    if (p_arg.ws == nullptr) grid.sync();
    if (tid < 2) ((volatile LAS unsigned*)(lds + 131072))[tid] = 0u;
    __syncthreads();
    const XcdBarrier xbar = xcd_barrier_post((unsigned*)((unsigned char*)(GASF unsigned char*)(unsigned long long)ldarg(8 * 16) + WS_BAR), (volatile LAS unsigned*)(lds + 131072));
#define GSYNC() xcd_barrier(xbar)

#if PH & 1
    { const Params p = load_params(); phase0(p, lds, tid, lane, wave); }
#endif
    GSYNC();
#if PROBE_DUP == 1
    { const Params p = load_params(); phase0(p, lds, tid, lane, wave); } GSYNC();
#endif
#if PROBE_DUP == 9
    GSYNC(); GSYNC(); GSYNC(); GSYNC(); GSYNC(); GSYNC(); GSYNC(); GSYNC(); GSYNC(); GSYNC();
#endif
#if PH & 2
    { const Params p = load_params(); phase1(p, lds, tid, lane, wave); }
#endif
    GSYNC();
#if PROBE_DUP == 2
    { const Params p = load_params(); phase1(p, lds, tid, lane, wave); } GSYNC();
#endif
#if PH & 4
    {
        const Params p = load_params();
        if (bx < 64) scan_item(p, lds, bx, tid, lane, wave);
        pg8::Gemm g{(const bf16_t*)(p.ws + WS_H), (const bf16_t*)(p.ws + WS_WIN), T_, 3072, 1024}; pg8::StaticOrder S; S.init(T_, 3072, G, bx);
        EpiIn E{(bf16_t*)(p.ws + WS_Q), (bf16_t*)(p.ws + WS_K), (bf16_t*)(p.ws + WS_VT), (bf16_t*)(p.ws + WS_Z), (bf16_t*)(p.ws + WS_BG), p.qg, p.kg};
        pg8::gemm_phase<EpiIn, pg8::StaticOrder, false, true>(lds, g, S, E);
    }
#endif
    GSYNC();
#if PH & 8
    { const Params p = load_params(); phase3(p, lds, tid, lane, wave); }
#endif
    GSYNC();
#if PH & 16
    {
        const Params p = load_params();
        pg8::Gemm g{(const bf16_t*)(p.ws + WS_MIX), (const bf16_t*)(p.ws + WS_WOUT), T_, 1024, 1024}; pg8::StaticOrder S; S.init(T_, 1024, G, bx);
        EpiOut E{p.x, (const float*)(p.ws + WS_MOD), p.n2g, (bf16_t*)(p.ws + WS_Q), (bf16_t*)(p.ws + WS_H), (float*)(p.ws + WS_ROWSS), (bf16_t*)(p.ws + WS_TAIL)};
        pg8::gemm_phase<EpiOut, pg8::StaticOrder, true, true>(lds, g, S, E);
#if PROBE_DUP == 7
        GSYNC();
        pg8::gemm_phase<EpiOut, pg8::StaticOrder, true, true>(lds, g, S, E);
#endif
    }
#endif
    GSYNC();
#if PH & 32
    {
        const Params p = load_params();
        pg8::Gemm g{(const bf16_t*)(p.ws + WS_H), (const bf16_t*)(p.ws + WS_WUP), 65 * 256, 2 * DFF, 1024};
        UpOrder S; S.init(65 * 256, 2 * DFF, G, bx); S.tail_off = (long)WS_TAIL - (long)WS_H;
        EpiUpF E{(const float*)(p.ws + WS_ROWSS), (const float*)(p.ws + WS_BIAS2), p.fcw, (bf16_t*)(p.ws + WS_ACT), (LAS float*)(lds + XCH_OFF)};
        pg8::gemm_phase<EpiUpF, UpOrder, true, true>(lds, g, S, E);
#if PROBE_DUP == 5
        GSYNC();
        pg8::gemm_phase<EpiUpF, UpOrder, true, true>(lds, g, S, E);
#endif
    }
#endif
    GSYNC();
#if PH & 128
    {
        const Params p = load_params();
        pg8::Gemm g{(const bf16_t*)(p.ws + WS_ACT), (const bf16_t*)(p.ws + WS_WDOWN), T_, 1024, DFF}; pg8::StaticOrder S; S.init(T_, 1024, G, bx);
#if PROBE_DUP == 8
        { EpiDown E0{(const float*)(p.ws + WS_MOD), (const bf16_t*)(p.ws + WS_Q), (float*)(p.ws + WS_K)};
          pg8::gemm_phase<EpiDown, pg8::StaticOrder, true, true>(lds, g, S, E0); GSYNC(); }
#endif
        EpiDown E{(const float*)(p.ws + WS_MOD), (const bf16_t*)(p.ws + WS_Q), p.out};
        pg8::gemm_phase<EpiDown, pg8::StaticOrder, true, true>(lds, g, S, E);
    }
#endif
}

extern "C" void kernel_launch(void* const* d_in, const int* in_sizes, int n_in, void* d_out, int out_size, void* d_ws, size_t ws_size, hipStream_t stream) {
    static int grid = 0;
    if (grid == 0) {
        int dev = 0, cus = 0, per_cu = 0;
        hipGetDevice(&dev); hipDeviceGetAttribute(&cus, hipDeviceAttributeMultiprocessorCount, dev);
        if (hipFuncSetAttribute((const void*)hymba_mega, hipFuncAttributeMaxDynamicSharedMemorySize, LDS_BYTES) != hipSuccess) fprintf(stderr, "hipFuncSetAttribute failed\n");
        if (hipOccupancyMaxActiveBlocksPerMultiprocessor(&per_cu, (const void*)hymba_mega, 512, LDS_BYTES) != hipSuccess || per_cu < 1) { fprintf(stderr, "occupancy query: %d\n", per_cu); per_cu = 1; }
        (void)hipGetLastError();
        grid = cus > 0 ? cus : 256;
    }
    Params p{};
    p.x = (const float*)d_in[0]; p.c = (const float*)d_in[1]; p.w_ada = (const float*)d_in[2]; p.b_ada = (const float*)d_in[3]; p.n1g = (const float*)d_in[4];
    p.w_in = (const float*)d_in[5]; p.b_f = (const float*)d_in[6]; p.qg = (const float*)d_in[7]; p.kg = (const float*)d_in[8]; p.cmw = (const float*)d_in[9];
    p.w_out = (const float*)d_in[10]; p.n2g = (const float*)d_in[11]; p.w_up = (const float*)d_in[12]; p.fcw = (const float*)d_in[13]; p.w_down = (const float*)d_in[14];
    p.out = (float*)d_out; p.ws = (unsigned char*)d_ws;
    (void)hipMemsetAsync((unsigned char*)d_ws + WS_BAR, 0, 16384, stream);
    void* args[] = {&p};
    hipError_t e = hipLaunchCooperativeKernel((const void*)hymba_mega, dim3(grid), dim3(512), args, LDS_BYTES, stream);
    if (e != hipSuccess) fprintf(stderr, "cooperative launch failed: %s (grid %d)\n", hipGetErrorString(e), grid);
}
```

```cpp
#include <hip/hip_runtime.h>
#include <hip/hip_cooperative_groups.h>
#include <cstdio>
#include <cstdint>
namespace cg = cooperative_groups;
#ifndef PROBE_DUP
#define PROBE_DUP 0
#endif
namespace pg8 {
#define PG8_LAS __attribute__((address_space(3)))
typedef unsigned short bf16_t;
typedef short bf16x8 __attribute__((ext_vector_type(8)));
typedef float f32x4 __attribute__((ext_vector_type(4)));
typedef unsigned u32x4 __attribute__((ext_vector_type(4)));
constexpr int BM = 256, BK = 64, HALF = 128, HTB = HALF * BK * 2  , STAGE_BYTES = 8 * HTB, NXCD = 8, WGM = 8;

__host__ __device__ __forceinline__ int lds_byte(int r, int c) { const int st = (r >> 4) * 2 + (c >> 5), rr = r & 15, cc = c & 31, ob = rr * 64 + cc * 2; return st * 1024 + (ob ^ (((ob >> 9) & 1) << 5)); }
__host__ __device__ __forceinline__ void stage_rc(int b, int& R, int& C) { const int st = b / 1024, sb = b % 1024, swz = sb ^ (((sb >> 9) & 1) << 5); R = (st >> 1) * 16 + swz / 64; C = (st & 1) * 32 + (swz % 64) / 2; }
__host__ __device__ __forceinline__ int perm32(int rho) { const int n = rho >> 4, i = rho & 15; return 8 * (i >> 2) + 4 * n + (i & 3); }

struct Unit { int pm, pn; };
struct Gemm { const bf16_t* A; const bf16_t* Bt; int M, N, K; };

struct StaticOrder {
    int nM, nN, nwg, G, c;
    __host__ __device__ void init(int M, int N, int G_, int c_) { nM = M / BM; nN = N / BM; nwg = nM * nN; G = G_; c = c_; }
    __host__ __device__ bool next(int i, Unit& u) const {
        const long L = (long)i * G + c; if (L >= nwg) return false;
        int wgid = (int)L; { const int q = nwg / NXCD, r = nwg % NXCD, xcd = wgid % NXCD, off = wgid / NXCD; wgid = (xcd < r ? xcd * (q + 1) : r * (q + 1) + (xcd - r) * q) + off; }
        const int nig = WGM * nN, gid = wgid / nig, fm = gid * WGM, gsz = (nM - fm) < WGM ? (nM - fm) : WGM;
        u.pm = fm + ((wgid % nig) % gsz); u.pn = (wgid % nig) / gsz; return true;
    }
    __device__ __forceinline__ void a_ready(const Unit&) const {}
    __device__ __forceinline__ void done(const Unit&) const {}
    __device__ __forceinline__ long a_off(int pm, size_t tstep) const { return (long)pm * (long)tstep; }
};

__device__ __forceinline__ unsigned cvt_pk_bf16(float lo, float hi) { unsigned r; asm volatile("v_cvt_pk_bf16_f32 %0, %1, %2" : "=v"(r) : "v"(lo), "v"(hi)); return r; }
typedef float f32x2 __attribute__((ext_vector_type(2)));
template <class Epi, class Sched, bool ALIGN_EPI = false, bool SP2 = false>
__device__ __forceinline__ void gemm_phase(PG8_LAS unsigned char* lds, const Gemm g, const Sched& S, const Epi& E) {
    int tid_o = threadIdx.x; asm volatile("" : "+v"(tid_o));
    const int tid = tid_o & 511, wid = __builtin_amdgcn_readfirstlane(tid >> 6), lane = tid & 63, wr = wid >> 2, wc = wid & 3, fr = lane & 15, fq = lane >> 4;
    const int K = g.K, nt = K / BK;
    unsigned voffA[2], voffB[2];
#pragma unroll
    for (int i = 0; i < 2; ++i) { int R, C; stage_rc(tid * 16 + i * 8192, R, C); const int Rb = Epi::PERM ? ((R & ~31) + perm32(R & 31)) : R;
        voffA[i] = (unsigned)(R * K + C) * 2u; voffB[i] = (unsigned)(Rb * K + C) * 2u; }
    const size_t kstep = (size_t)(BK * 2);
    const size_t hstep = (size_t)HALF * K * 2;
    const size_t tstep = 2 * hstep;
    const unsigned ldsw = (unsigned)wid * 1024u;
    const int aoff = lds_byte(wr * 64 + fr, fq * 8), boff = lds_byte(wc * 32 + fr, fq * 8);
#define PG8_SA(b, h) (((b) * 2 + (h)) * HTB)
#define PG8_SB(b, h) ((4 + (b) * 2 + (h)) * HTB)
#define PG8_STAGE(bufoff, gbase, voff) do { _Pragma("unroll") for (int _i = 0; _i < 2; ++_i) \
        __builtin_amdgcn_global_load_lds((const unsigned*)((const char*)(gbase) + (voff)[_i]), (PG8_LAS unsigned*)(lds + (bufoff) + ldsw + _i * 8192), 16, 0, 0); } while (0)
#define PG8_LDA(dst, b, h) do { _Pragma("unroll") for (int m = 0; m < 4; ++m) _Pragma("unroll") for (int k = 0; k < 2; ++k) dst[m][k] = *(const PG8_LAS bf16x8*)(lds + PG8_SA(b, h) + aoff + m * 2048 + k * 1024); } while (0)
#define PG8_LDB(dst, b, h) do { _Pragma("unroll") for (int n = 0; n < 2; ++n) _Pragma("unroll") for (int k = 0; k < 2; ++k) dst[n][k] = *(const PG8_LAS bf16x8*)(lds + PG8_SB(b, h) + boff + n * 2048 + k * 1024); } while (0)
#define PG8_MMA(ai, bj, At, Bt) do { __builtin_amdgcn_s_setprio(1); _Pragma("unroll") for (int m = 0; m < 4; ++m) _Pragma("unroll") for (int n = 0; n < 2; ++n) _Pragma("unroll") for (int k = 0; k < 2; ++k) \
        acc[ai][bj][m][n] = __builtin_amdgcn_mfma_f32_16x16x32_bf16(Bt[n][k], At[m][k], acc[ai][bj][m][n], 0, 0, 0); __builtin_amdgcn_s_setprio(0); } while (0)
#define PG8_WAIT_V(n) asm volatile("s_waitcnt vmcnt(" #n ")" ::: "memory")
#define PG8_WAIT_L(n) asm volatile("s_waitcnt lgkmcnt(" #n ")" ::: "memory")
#define PG8_BAR __builtin_amdgcn_s_barrier()
#define PG8_SCHED __builtin_amdgcn_sched_barrier(0)
    Unit cur, nxt; int ui = 0;
    if (!S.next(0, cur)) return;
    f32x4 acc[2][2][4][2];
#pragma unroll
    for (int a = 0; a < 2; ++a)
#pragma unroll
        for (int b = 0; b < 2; ++b)
#pragma unroll
            for (int m = 0; m < 4; ++m)
#pragma unroll
                for (int n = 0; n < 2; ++n) acc[a][b][m][n] = (f32x4){0.f, 0.f, 0.f, 0.f};
    bf16x8 At[4][2], B0[2][2], B1[2][2];
    const char* cA = (const char*)g.A + S.a_off(cur.pm, tstep); const char* cB = (const char*)g.Bt + (size_t)cur.pn * tstep;
    S.a_ready(cur);
    if constexpr (SP2) {
        PG8_STAGE(PG8_SB(0, 0), cB, voffB); PG8_STAGE(PG8_SB(0, 1), cB + hstep, voffB); PG8_STAGE(PG8_SA(0, 0), cA, voffA); PG8_STAGE(PG8_SA(0, 1), cA + hstep, voffA);
        if (wr == 1) PG8_BAR;
        PG8_WAIT_V(2); PG8_BAR;
        PG8_STAGE(PG8_SB(1, 0), cB + kstep, voffB); PG8_STAGE(PG8_SA(1, 0), cA + kstep, voffA); PG8_STAGE(PG8_SB(1, 1), cB + hstep + kstep, voffB);
        PG8_WAIT_V(6); PG8_BAR;
    } else {
        PG8_STAGE(PG8_SB(0, 0), cB, voffB); PG8_STAGE(PG8_SA(0, 0), cA, voffA); PG8_STAGE(PG8_SB(0, 1), cB + hstep, voffB); PG8_STAGE(PG8_SA(0, 1), cA + hstep, voffA);
        if (wr == 1) PG8_BAR;
        PG8_WAIT_V(4); PG8_BAR;
        PG8_STAGE(PG8_SB(1, 0), cB + kstep, voffB); PG8_STAGE(PG8_SA(1, 0), cA + kstep, voffA); PG8_STAGE(PG8_SB(1, 1), cB + hstep + kstep, voffB);
        PG8_WAIT_V(6); PG8_BAR;
    }
    for (;;) {
        const bool has_next = S.next(ui + 1, nxt);
        const char* nA = has_next ? (const char*)g.A + S.a_off(nxt.pm, tstep) : cA; const char* nB = has_next ? (const char*)g.Bt + (size_t)nxt.pn * tstep : cB;
        for (int t = 0; t < nt; t += 2) {
            const bool last = (t == nt - 2);
            const char* a1 = cA + (size_t)(t + 1) * kstep;
            const char* a2 = last ? nA : cA + (size_t)(t + 2) * kstep; const char* b2 = last ? nB : cB + (size_t)(t + 2) * kstep;
            const char* a3 = a2 + kstep; const char* b3 = b2 + kstep;
            if (last && has_next) S.a_ready(nxt);
            if constexpr (SP2) {
            PG8_LDB(B0, 0, 0); PG8_LDB(B1, 0, 1); PG8_SCHED; PG8_LDA(At, 0, 0); PG8_STAGE(PG8_SA(1, 1), a1 + hstep, voffA);
            PG8_WAIT_V(8); PG8_WAIT_L(0); PG8_BAR; PG8_MMA(0, 0, At, B0); PG8_MMA(0, 1, At, B1); PG8_BAR; PG8_SCHED;
            PG8_LDA(At, 0, 1); PG8_STAGE(PG8_SB(0, 0), b2, voffB); PG8_STAGE(PG8_SB(0, 1), b2 + hstep, voffB); PG8_STAGE(PG8_SA(0, 0), a2, voffA);
            PG8_WAIT_V(8); PG8_WAIT_L(0); PG8_BAR; PG8_MMA(1, 0, At, B0); PG8_MMA(1, 1, At, B1); PG8_BAR; PG8_SCHED;
            PG8_LDB(B0, 1, 0); PG8_LDB(B1, 1, 1); PG8_SCHED; PG8_LDA(At, 1, 0); PG8_STAGE(PG8_SA(0, 1), a2 + hstep, voffA);
            PG8_WAIT_V(8); PG8_WAIT_L(0); PG8_BAR; PG8_MMA(0, 0, At, B0); PG8_MMA(0, 1, At, B1); PG8_BAR; PG8_SCHED;
            PG8_LDA(At, 1, 1); PG8_STAGE(PG8_SB(1, 0), b3, voffB); PG8_STAGE(PG8_SB(1, 1), b3 + hstep, voffB); PG8_STAGE(PG8_SA(1, 0), a3, voffA);
            PG8_WAIT_V(8); PG8_WAIT_L(0); PG8_BAR; PG8_MMA(1, 0, At, B0); PG8_MMA(1, 1, At, B1); PG8_BAR; PG8_SCHED;
            } else {
            PG8_LDB(B0, 0, 0); PG8_SCHED; PG8_LDA(At, 0, 0); PG8_STAGE(PG8_SA(1, 1), a1 + hstep, voffA);
            PG8_WAIT_L(8); PG8_BAR; PG8_WAIT_L(0); PG8_MMA(0, 0, At, B0); PG8_BAR; PG8_SCHED;
            PG8_LDB(B1, 0, 1); PG8_STAGE(PG8_SB(0, 0), b2, voffB);
            PG8_BAR; PG8_WAIT_L(0); PG8_MMA(0, 1, At, B1); PG8_BAR;
            PG8_LDA(At, 0, 1); PG8_STAGE(PG8_SA(0, 0), a2, voffA);
            PG8_BAR; PG8_WAIT_L(0); PG8_MMA(1, 0, At, B0); PG8_BAR; PG8_SCHED;
            PG8_STAGE(PG8_SB(0, 1), b2 + hstep, voffB);
            PG8_WAIT_V(6); PG8_BAR; PG8_MMA(1, 1, At, B1); PG8_BAR;
            PG8_LDB(B0, 1, 0); PG8_SCHED; PG8_LDA(At, 1, 0); PG8_STAGE(PG8_SA(0, 1), a2 + hstep, voffA);
            PG8_WAIT_L(8); PG8_BAR; PG8_WAIT_L(0); PG8_MMA(0, 0, At, B0); PG8_BAR; PG8_SCHED;
            PG8_LDB(B1, 1, 1); PG8_STAGE(PG8_SB(1, 0), b3, voffB);
            PG8_BAR; PG8_WAIT_L(0); PG8_MMA(0, 1, At, B1); PG8_BAR;
            PG8_LDA(At, 1, 1); PG8_STAGE(PG8_SA(1, 0), a3, voffA);
            PG8_BAR; PG8_WAIT_L(0); PG8_MMA(1, 0, At, B0); PG8_BAR; PG8_SCHED;
            PG8_STAGE(PG8_SB(1, 1), b3 + hstep, voffB);
            PG8_WAIT_V(6); PG8_BAR; PG8_MMA(1, 1, At, B1); PG8_BAR;
            }
        }
        if constexpr (ALIGN_EPI) { if (wr == 0) PG8_BAR; }
        if constexpr (!Epi::AFTER_DRAIN) { E(acc, cur, wr, wc, fr, fq); S.done(cur); }
        if (!has_next) break;
#pragma unroll
        for (int a = 0; a < 2; ++a)
#pragma unroll
            for (int b = 0; b < 2; ++b)
#pragma unroll
                for (int m = 0; m < 4; ++m)
#pragma unroll
                    for (int n = 0; n < 2; ++n) acc[a][b][m][n] = (f32x4){0.f, 0.f, 0.f, 0.f};
        cur = nxt; cA = nA; cB = nB; ++ui;
        if constexpr (ALIGN_EPI) { if (wr == 1) PG8_BAR; }
    }
    PG8_WAIT_V(0);
    if constexpr (!ALIGN_EPI) { if (wr == 0) PG8_BAR; }
    PG8_BAR;
    if constexpr (Epi::AFTER_DRAIN) { E.fused(acc, cur, wr, wc, fr, fq, lds, wid, lane); S.done(cur); }
#undef PG8_SA
#undef PG8_SB
#undef PG8_STAGE
#undef PG8_LDA
#undef PG8_LDB
#undef PG8_MMA
#undef PG8_WAIT_V
#undef PG8_WAIT_L
#undef PG8_BAR
#undef PG8_SCHED
}
}
#define LAS __attribute__((address_space(3)))
typedef unsigned short bf16_t;
typedef short bf16x8 __attribute__((ext_vector_type(8)));
typedef float f32x4 __attribute__((ext_vector_type(4)));
typedef float f32x16 __attribute__((ext_vector_type(16)));
typedef unsigned u32x4 __attribute__((ext_vector_type(4)));
typedef unsigned u32x2 __attribute__((ext_vector_type(2)));
constexpr int T_ = 16384, D_ = 1024, S_ = 2048, NH = 8, DFF = 2816, DIN = 3080, NMOD = 6144, HALFC = 1408;
constexpr float EPS = 1e-6f;
constexpr float LOG2E = 1.4426950408889634f;
constexpr float C2 = 0.125f * LOG2E;
constexpr size_t MiB = 1u << 20;
constexpr size_t WS_MOD = 0, WS_BIAS2 = 256 * 1024, WS_ROWSS = 31 * MiB, WS_BAR = 640 * 1024, WS_LOGF = 1 * MiB, WS_QAUG = 2 * MiB, WS_KAUG = 4 * MiB,
    WS_WIN = 6 * MiB, WS_WOUT = 12 * MiB, WS_WUP = 14 * MiB, WS_WDOWN = 25 * MiB, WS_H = 32 * MiB, WS_Q = 64 * MiB, WS_K = 80 * MiB,
    WS_VT = 96 * MiB, WS_Z = 112 * MiB, WS_BG = 128 * MiB, WS_MIX = 144 * MiB, WS_ACT = 160 * MiB, WS_TAIL = 30 * MiB + 512 * 1024;
constexpr int LDS_BYTES = 139328;
constexpr int XCH_OFF = 131072 + 64;

struct Params {
    const float *x, *c, *w_ada, *b_ada, *n1g, *w_in, *b_f, *qg, *kg, *cmw, *w_out, *n2g, *w_up, *fcw, *w_down;
    float* out; unsigned char* ws;
};

__device__ __forceinline__ float wave_sum(float v) {
#pragma unroll
    for (int o = 1; o < 64; o <<= 1) v += __shfl_xor(v, o);
    return v;
}
__device__ __forceinline__ float xsum12(float v) {
    v += __builtin_bit_cast(float, __builtin_amdgcn_mov_dpp(__builtin_bit_cast(int, v), 0xB1, 0xf, 0xf, true));
    v += __builtin_bit_cast(float, __builtin_amdgcn_mov_dpp(__builtin_bit_cast(int, v), 0x4E, 0xf, 0xf, true));
    return v;
}
__device__ __forceinline__ unsigned f2bf(float f) { unsigned u = __builtin_bit_cast(unsigned, f); return (u + 0x7fffu + ((u >> 16) & 1u)) >> 16; }
__device__ __forceinline__ float bf2f(unsigned h) { return __builtin_bit_cast(float, h << 16); }
__device__ __forceinline__ unsigned pk2(float lo, float hi) { return pg8::cvt_pk_bf16(lo, hi); }
typedef float f32x2_t __attribute__((ext_vector_type(2))); typedef __bf16 bf16x2_t __attribute__((ext_vector_type(2)));
__device__ __forceinline__ unsigned cvtpk_s(float lo, float hi) { f32x2_t v = {lo, hi}; bf16x2_t b = __builtin_convertvector(v, bf16x2_t); return __builtin_bit_cast(unsigned, b); }
__device__ __forceinline__ void unpack8(u32x4 w, float (&f)[8]) {
    f[0] = bf2f(w.x & 0xffffu); f[1] = __builtin_bit_cast(float, w.x & 0xffff0000u);
    f[2] = bf2f(w.y & 0xffffu); f[3] = __builtin_bit_cast(float, w.y & 0xffff0000u);
    f[4] = bf2f(w.z & 0xffffu); f[5] = __builtin_bit_cast(float, w.z & 0xffff0000u);
    f[6] = bf2f(w.w & 0xffffu); f[7] = __builtin_bit_cast(float, w.w & 0xffff0000u);
}
__device__ __forceinline__ void st16wt(const void* base, unsigned off, u32x4 v) {
    const __amdgpu_buffer_rsrc_t rs = __builtin_amdgcn_make_buffer_rsrc(const_cast<void*>(base), 0, 0x7fffffff, 0x00020000);
    __builtin_amdgcn_raw_buffer_store_b128(v, rs, off, 0,   16);
}
__device__ __forceinline__ u32x4 pack8(const float (&f)[8]) { u32x4 w; w.x = pk2(f[0], f[1]); w.y = pk2(f[2], f[3]); w.z = pk2(f[4], f[5]); w.w = pk2(f[6], f[7]); return w; }

__device__ __forceinline__ void transpose_item(const float* W, int N, int K, bf16_t* WT, int dstrow0, int srccol0, int k0, LAS float* scr, int lane) {
    float tv[32];
    { const float* wp = W + (size_t)(k0 + (lane >> 5)) * N + srccol0 + (lane & 31);
#pragma unroll
      for (int i = 0; i < 32; ++i) tv[i] = __builtin_nontemporal_load(wp + (size_t)(2 * i) * N); }
#pragma unroll
    for (int i = 0; i < 32; ++i) scr[(2 * i + (lane >> 5)) * 33 + (lane & 31)] = tv[i];
    asm volatile("s_waitcnt lgkmcnt(0)" ::: "memory");
    const int c = lane & 7;
#pragma unroll
    for (int j = 0; j < 4; ++j) { const int n = (lane >> 3) + 8 * j; const LAS float* s = scr + (8 * c) * 33 + n;
        u32x4 o; o.x = pk2(s[0 * 33], s[1 * 33]); o.y = pk2(s[2 * 33], s[3 * 33]); o.z = pk2(s[4 * 33], s[5 * 33]); o.w = pk2(s[6 * 33], s[7 * 33]);
        st16wt(WT, (unsigned)(((dstrow0 + n) * K + k0 + 8 * c) * 2), o); }
    asm volatile("s_waitcnt lgkmcnt(0)" ::: "memory");
}
__device__ __forceinline__ int win_src(int p0) {
    const int pn = p0 >> 8, c = p0 & 255, bj = c >> 7, wc = (c & 127) >> 5;
    if (pn < 6) return (pn >> 1) * 512 + (4 * (pn & 1) + wc) * 64 + 32 * bj;
    if (pn < 10) return (bj == 0 ? 1544 : 2568) + 128 * (pn - 6) + (c & 127);
    return 2056 + 256 * (pn - 10) + c;
}
__device__ __forceinline__ int wup_src(int p0) { const int j = p0 >> 8, c = p0 & 255; return (c < 128) ? 128 * j + c : DFF + 128 * j + (c - 128); }

__device__ __forceinline__ void gemv_item(const float* W, int N, int n0, const float* bias, const LAS float* vecs, LAS float* red, float* out, int tid) {
    const int cgp = tid & 7, kg = tid >> 3;
    float acc[8][4];
#pragma unroll
    for (int b = 0; b < 8; ++b)
#pragma unroll
        for (int j = 0; j < 4; ++j) acc[b][j] = 0.f;
#pragma unroll 4
    for (int i = 0; i < 16; ++i) { const int k = kg + 64 * i; const f32x4 w = __builtin_nontemporal_load((const f32x4*)(W + (size_t)k * N + n0 + 4 * cgp));
#pragma unroll
        for (int b = 0; b < 8; ++b) { const float v = vecs[b * 1024 + k]; acc[b][0] += v * w.x; acc[b][1] += v * w.y; acc[b][2] += v * w.z; acc[b][3] += v * w.w; } }
#pragma unroll
    for (int b = 0; b < 8; ++b) *(LAS f32x4*)(red + (kg * 8 + b) * 32 + 4 * cgp) = (f32x4){acc[b][0], acc[b][1], acc[b][2], acc[b][3]};
    __syncthreads();
    if (tid < 256) { const int b = tid >> 5, col = tid & 31; float s = 0.f;
#pragma unroll 8
      for (int g = 0; g < 64; ++g) s += red[(g * 8 + b) * 32 + col];
      out[(size_t)b * N + n0 + col] = s + (bias ? bias[n0 + col] : 0.f); }
    __syncthreads();
}

__device__ __forceinline__ void transposes(const Params& p, LAS unsigned char* lds, int it_begin, int it_end, int gw, int NGW, int lane, int wave) {
    LAS float* scr = (LAS float*)(lds + wave * 8704);
    constexpr int I_IN = 16 * 96, I_OUT = 16 * 32, I_UP = 16 * 176;
    for (int it = it_begin + gw; it < it_end; it += NGW) {
        int r = it;
        if (r < I_IN) { const int kb = r / 96, nb = r % 96; transpose_item(p.w_in, DIN, 1024, (bf16_t*)(p.ws + WS_WIN), 32 * nb, win_src(32 * nb), 64 * kb, scr, lane); continue; } r -= I_IN;
        if (r < I_OUT) { const int kb = r / 32, nb = r % 32; transpose_item(p.w_out, 1024, 1024, (bf16_t*)(p.ws + WS_WOUT), 32 * nb, 32 * nb, 64 * kb, scr, lane); continue; } r -= I_OUT;
        if (r < I_UP) { const int kb = r / 176, nb = r % 176; transpose_item(p.w_up, 2 * DFF, 1024, (bf16_t*)(p.ws + WS_WUP), 32 * nb, wup_src(32 * nb), 64 * kb, scr, lane); continue; } r -= I_UP;
        { const int kb = r / 32, nb = r % 32; transpose_item(p.w_down, 1024, DFF, (bf16_t*)(p.ws + WS_WDOWN), 32 * nb, 32 * nb, 64 * kb, scr, lane); }
    }
}
constexpr int NIT_IN = 16 * 96, NIT_ALL = 16 * 96 + 16 * 32 + 16 * 176 + 44 * 32;
__device__ __forceinline__ void phase0(const Params& p, LAS unsigned char* lds, int tid, int lane, int wave) {
    float* mod = (float*)(p.ws + WS_MOD);
    const int ngemv = gridDim.x > 192 ? 192 : gridDim.x;
    if (blockIdx.x < ngemv) {
        LAS float* vecs = (LAS float*)lds; LAS float* red = (LAS float*)(lds + 32768);
        for (int i = tid; i < 8192; i += 512) { const float v = p.c[i]; vecs[i] = v / (1.f + __expf(-v)); }
        __syncthreads();
        for (int it = blockIdx.x; it < 192; it += ngemv) gemv_item(p.w_ada, NMOD, 32 * it, p.b_ada, vecs, red, mod, tid);
    } else {
        transposes(p, lds, 0, NIT_IN, (blockIdx.x - 192) * 8 + wave, (gridDim.x - 192) * 8, lane, wave);
    }
}

__device__ __forceinline__ void phase1(const Params& p, LAS unsigned char* lds, int tid, int lane, int wave) {
    const float* mod = (const float*)(p.ws + WS_MOD);
    if (blockIdx.x < 176) {
        LAS float* vecs = (LAS float*)lds; LAS float* red = (LAS float*)(lds + 32768);
        for (int i = tid; i < 8192; i += 512) vecs[i] = mod[(i >> 10) * NMOD + 3072 + (i & 1023)];
        __syncthreads();
        for (int it = blockIdx.x; it < 176; it += gridDim.x) gemv_item(p.w_up, 2 * DFF, 32 * it, nullptr, vecs, red, (float*)(p.ws + WS_BIAS2), tid);
    }
    transposes(p, lds, gridDim.x > 192 ? NIT_IN : 0, NIT_ALL, blockIdx.x * 8 + wave, gridDim.x * 8, lane, wave);
    __syncthreads();
    LAS float* wf = (LAS float*)lds;
    for (int i = tid; i < 8192; i += 512) { const int k = i >> 3, h = i & 7; wf[h * 1024 + k] = p.w_in[(size_t)k * DIN + 1536 + h]; }
    __syncthreads();
    bf16_t* hb = (bf16_t*)(p.ws + WS_H); float* logf = (float*)(p.ws + WS_LOGF);
    const int gw = blockIdx.x * 8 + wave, NGW = gridDim.x * 8;
    const int rpw = (((T_ + NGW - 1) / NGW) + 1) & ~1  , r0 = gw * rpw, r1 = (r0 + rpw < T_) ? r0 + rpw : T_;
    const bool b5 = (lane & 32) != 0, b4 = (lane & 16) != 0, b3 = (lane & 8) != 0;
    f32x4 gmv[4], shv[4]; int bcur = -1;
    f32x4 vn[2][4];
#define ROW2(rw, q) (((rw) + (q) < r1) ? (rw) + (q) : (rw))
    if (r0 < r1) {
#pragma unroll
        for (int q = 0; q < 2; ++q)
#pragma unroll
            for (int j = 0; j < 4; ++j) vn[q][j] = __builtin_nontemporal_load((const f32x4*)(p.x + (size_t)ROW2(r0, q) * D_ + 4 * lane + 256 * j)); }
    for (int row = r0; row < r1; row += 2) {
        const int b = row >> 11;
        if (b != bcur) { bcur = b; const float* mb = mod + b * NMOD;
#pragma unroll
            for (int j = 0; j < 4; ++j) { const int col = 4 * lane + 256 * j; gmv[j] = *(const f32x4*)(p.n1g + col) * (*(const f32x4*)(mb + 1024 + col) + 1.f); shv[j] = *(const f32x4*)(mb + col); } }
        f32x4 v[2][4]; float ss[2];
#pragma unroll
        for (int q = 0; q < 2; ++q) { ss[q] = 0.f;
#pragma unroll
            for (int j = 0; j < 4; ++j) { v[q][j] = vn[q][j]; ss[q] += (v[q][j].x * v[q][j].x + v[q][j].y * v[q][j].y) + (v[q][j].z * v[q][j].z + v[q][j].w * v[q][j].w); } }
        if (row + 2 < r1) {
#pragma unroll
            for (int q = 0; q < 2; ++q)
#pragma unroll
                for (int j = 0; j < 4; ++j) vn[q][j] = __builtin_nontemporal_load((const f32x4*)(p.x + (size_t)ROW2(row + 2, q) * D_ + 4 * lane + 256 * j)); }
#pragma unroll
        for (int q = 0; q < 2; ++q) ss[q] = xsum12(ss[q]);
#pragma unroll
        for (int o = 4; o < 64; o <<= 1) { ss[0] += __shfl_xor(ss[0], o); ss[1] += __shfl_xor(ss[1], o); }
#pragma unroll
        for (int q = 0; q < 2; ++q) { const float rstd = rsqrtf(ss[q] * (1.f / D_) + EPS); const int rq = ROW2(row, q);
#pragma unroll
            for (int j = 0; j < 4; ++j) { const int col = 4 * lane + 256 * j;
                v[q][j] = (v[q][j] * rstd) * gmv[j] + shv[j];
                u32x2 w; w.x = pk2(v[q][j].x, v[q][j].y); w.y = pk2(v[q][j].z, v[q][j].w);
                *(u32x2*)(hb + (size_t)rq * D_ + col) = w; } }
        float f[2][8];
#pragma unroll
        for (int h = 0; h < 8; ++h) { float s0 = 0.f, s1 = 0.f;
#pragma unroll
            for (int j = 0; j < 4; ++j) { const f32x4 w = *(const LAS f32x4*)(wf + h * 1024 + 4 * lane + 256 * j);
                s0 += (v[0][j].x * w.x + v[0][j].y * w.y) + (v[0][j].z * w.z + v[0][j].w * w.w); s1 += (v[1][j].x * w.x + v[1][j].y * w.y) + (v[1][j].z * w.z + v[1][j].w * w.w); }
            f[0][h] = s0; f[1][h] = s1; }
        float g4[2][4], g2[2][2], z[2];
#pragma unroll
        for (int i = 0; i < 4; ++i)
#pragma unroll
            for (int q = 0; q < 2; ++q) { const float send = b5 ? f[q][i] : f[q][4 + i], keep = b5 ? f[q][4 + i] : f[q][i]; g4[q][i] = keep + __shfl_xor(send, 32); }
#pragma unroll
        for (int i = 0; i < 2; ++i)
#pragma unroll
            for (int q = 0; q < 2; ++q) { const float send = b4 ? g4[q][i] : g4[q][2 + i], keep = b4 ? g4[q][2 + i] : g4[q][i]; g2[q][i] = keep + __shfl_xor(send, 16); }
#pragma unroll
        for (int q = 0; q < 2; ++q) { const float send = b3 ? g2[q][0] : g2[q][1], keep = b3 ? g2[q][1] : g2[q][0]; z[q] = keep + __shfl_xor(send, 8); }
#pragma unroll
        for (int q = 0; q < 2; ++q) z[q] = xsum12(z[q]);
        z[0] += __shfl_xor(z[0], 4); z[1] += __shfl_xor(z[1], 4);
        if ((lane & 7) == 0) { const int h = lane >> 3; const float bf_ = p.b_f[h];
#pragma unroll
            for (int q = 0; q < 2; ++q) { const float zz = z[q] + bf_; logf[(size_t)ROW2(row, q) * 8 + h] = fminf(zz, 0.f) - __logf(1.f + __expf(-fabsf(zz))); } }
    }
#undef ROW2
    __syncthreads();
}

__device__ __forceinline__ void scan_item(const Params& p, LAS unsigned char* lds, int bh, int tid, int lane, int wave) {
    const float* logf = (const float*)(p.ws + WS_LOGF); const int b = bh >> 3, h = bh & 7;
    LAS float* wt = (LAS float*)lds;
    float a[4];
#pragma unroll
    for (int i = 0; i < 4; ++i) a[i] = logf[((size_t)(b * S_ + 4 * tid + i)) * 8 + h];
    a[1] += a[0]; a[2] += a[1]; a[3] += a[2];
    float sc = a[3];
#pragma unroll
    for (int o = 1; o < 64; o <<= 1) { const float y = __shfl_up(sc, o); if (lane >= o) sc += y; }
    if (lane == 63) wt[wave] = sc;
    __syncthreads();
    float off = sc - a[3];
    for (int w = 0; w < wave; ++w) off += wt[w];
    u32x4* qa = (u32x4*)(p.ws + WS_QAUG) + (size_t)bh * S_ + 4 * tid; u32x4* ka = (u32x4*)(p.ws + WS_KAUG) + (size_t)bh * S_ + 4 * tid;
#pragma unroll
    for (int i = 0; i < 4; ++i) { const float F = (off + a[i]) * LOG2E;
        const unsigned hi = f2bf(F); const float r1 = F - bf2f(hi); const unsigned mid = f2bf(r1); const float r2 = r1 - bf2f(mid); const unsigned lo = f2bf(r2);
        u32x4 q, k; q.x = hi | (mid << 16); q.y = lo | (0x3F80u << 16); q.z = 0x3F803F80u; q.w = 0u;
        k.x = 0x3F803F80u; k.y = 0x3F80u | ((hi ^ 0x8000u) << 16); k.z = (mid ^ 0x8000u) | ((lo ^ 0x8000u) << 16); k.w = 0u;
        qa[i] = q; ka[i] = k; }
    __syncthreads();
}
struct EpiIn {
    static constexpr bool PERM = true, AFTER_DRAIN = false;
    bf16_t *Q, *K, *Vt, *Z, *BG; const float *qg, *kg;
    __device__ __forceinline__ void operator()(const f32x4 (&acc)[2][2][4][2], const pg8::Unit& u, int wr, int wc, int fr, int fq) const {
        const int pn = u.pn; const int row0 = u.pm * 256 + wr * 64 + fr;
        if (pn < 4) {
            const bool isq = pn < 2; const float* g = isq ? qg : kg; bf16_t* dst = isq ? Q : K; const int head = 4 * (pn & 1) + wc; const float mul = isq ? C2 : 1.f;
            f32x4 gv[2][2];
#pragma unroll
            for (int bj = 0; bj < 2; ++bj)
#pragma unroll
                for (int n = 0; n < 2; ++n) gv[bj][n] = *(const f32x4*)(g + 32 * bj + 8 * fq + 4 * n) * mul;
#pragma unroll
            for (int ai = 0; ai < 2; ++ai)
#pragma unroll
                for (int m = 0; m < 4; ++m) {
                    float ss = 0.f;
#pragma unroll
                    for (int bj = 0; bj < 2; ++bj)
#pragma unroll
                        for (int n = 0; n < 2; ++n) { const f32x4 a = acc[ai][bj][m][n]; ss += (a.x * a.x + a.y * a.y) + (a.z * a.z + a.w * a.w); }
                    ss += __shfl_xor(ss, 16); ss += __shfl_xor(ss, 32);
                    const float rinv = rsqrtf(ss * (1.f / 64.f) + EPS);
                    const unsigned row = (unsigned)(row0 + ai * 128 + m * 16);
#pragma unroll
                    for (int bj = 0; bj < 2; ++bj) { const f32x4 v0 = acc[ai][bj][m][0] * rinv * gv[bj][0], v1 = acc[ai][bj][m][1] * rinv * gv[bj][1];
                        u32x4 w; w.x = pk2(v0.x, v0.y); w.y = pk2(v0.z, v0.w); w.z = pk2(v1.x, v1.y); w.w = pk2(v1.z, v1.w);
                        st16wt(dst, (row * 512 + head * 64 + 32 * bj + 8 * fq) * 2u, w); }
                }
        } else if (pn < 6) {
            const int head = 4 * (pn & 1) + wc, b = u.pm >> 3;
            bf16_t* vb = Vt + (size_t)((b * 8 + head) * 64) * S_;
#pragma unroll
            for (int ai = 0; ai < 2; ++ai)
#pragma unroll
                for (int m = 0; m < 4; ++m) { const int t = (row0 + ai * 128 + m * 16) & (S_ - 1);
                    const int tp = (t & ~15) | (((t >> 2) & 1) << 3) | (((t >> 3) & 1) << 2) | (t & 3);
#pragma unroll
                    for (int bj = 0; bj < 2; ++bj)
#pragma unroll
                        for (int n = 0; n < 2; ++n) { const f32x4 a = acc[ai][bj][m][n]; const int d = 32 * bj + 8 * fq + 4 * n;
                            vb[(unsigned)((d + 0) * S_ + tp)] = (bf16_t)f2bf(a.x); vb[(unsigned)((d + 1) * S_ + tp)] = (bf16_t)f2bf(a.y);
                            vb[(unsigned)((d + 2) * S_ + tp)] = (bf16_t)f2bf(a.z); vb[(unsigned)((d + 3) * S_ + tp)] = (bf16_t)f2bf(a.w); }
                }
        } else if (pn < 10) {
            const int ch0 = 128 * (pn - 6) + 32 * wc + 8 * fq;
#pragma unroll
            for (int ai = 0; ai < 2; ++ai)
#pragma unroll
                for (int m = 0; m < 4; ++m) { const unsigned row = (unsigned)(row0 + ai * 128 + m * 16);
                    const f32x4 v0 = acc[ai][0][m][0] * acc[ai][1][m][0], v1 = acc[ai][0][m][1] * acc[ai][1][m][1];
                    u32x4 w; w.x = pk2(v0.x, v0.y); w.y = pk2(v0.z, v0.w); w.z = pk2(v1.x, v1.y); w.w = pk2(v1.z, v1.w);
                    st16wt(Z, (row * 512 + ch0) * 2u, w); }
        } else {
#pragma unroll
            for (int ai = 0; ai < 2; ++ai)
#pragma unroll
                for (int m = 0; m < 4; ++m) { const unsigned row = (unsigned)(row0 + ai * 128 + m * 16);
#pragma unroll
                    for (int bj = 0; bj < 2; ++bj) { const f32x4 v0 = acc[ai][bj][m][0], v1 = acc[ai][bj][m][1];
                        u32x4 w; w.x = pk2(v0.x, v0.y); w.y = pk2(v0.z, v0.w); w.z = pk2(v1.x, v1.y); w.w = pk2(v1.z, v1.w);
                        st16wt(BG, (row * 512 + 256 * (pn - 10) + 128 * bj + 32 * wc + 8 * fq) * 2u, w); } }
        }
    }
};
struct EpiOut {
    static constexpr bool PERM = true, AFTER_DRAIN = false;
    const float* x; const float* mod; const float* n2g; bf16_t* x1b; bf16_t* A2; float* rowss; bf16_t* A2tail;
    __device__ __forceinline__ void operator()(const f32x4 (&acc)[2][2][4][2], const pg8::Unit& u, int wr, int wc, int fr, int fq) const {
        const int b = u.pm >> 3, colb = u.pn * 256 + wc * 32 + 8 * fq; const int row0 = u.pm * 256 + wr * 64 + fr;
        const float* mb = mod + b * NMOD;
        f32x4 g1v[2][2], gm[2][2];
#pragma unroll
        for (int bj = 0; bj < 2; ++bj)
#pragma unroll
            for (int n = 0; n < 2; ++n) { const int col = colb + 128 * bj + 4 * n; g1v[bj][n] = *(const f32x4*)(mb + 2048 + col);
                gm[bj][n] = *(const f32x4*)(n2g + col) * (*(const f32x4*)(mb + 4096 + col) + 1.f); }
#pragma unroll
        for (int ai = 0; ai < 2; ++ai) {
            f32x4 xv[4][2][2];
#pragma unroll
            for (int m = 0; m < 4; ++m)
#pragma unroll
                for (int bj = 0; bj < 2; ++bj)
#pragma unroll
                    for (int n = 0; n < 2; ++n) xv[m][bj][n] = __builtin_nontemporal_load((const f32x4*)(x + ((unsigned)(row0 + ai * 128 + m * 16) * D_ + colb + 128 * bj + 4 * n)));
#pragma unroll
            for (int m = 0; m < 4; ++m) { const unsigned row = (unsigned)(row0 + ai * 128 + m * 16); float ss = 0.f;
#pragma unroll
                for (int bj = 0; bj < 2; ++bj) { f32x4 x1[2]; u32x4 xb;
#pragma unroll
                    for (int n = 0; n < 2; ++n) {
                        x1[n] = xv[m][bj][n] + g1v[bj][n] * acc[ai][bj][m][n];
                        ss += (x1[n].x * x1[n].x + x1[n].y * x1[n].y) + (x1[n].z * x1[n].z + x1[n].w * x1[n].w); if (n == 0) { xb.x = pk2(x1[0].x, x1[0].y); xb.y = pk2(x1[0].z, x1[0].w); } else { xb.z = pk2(x1[1].x, x1[1].y); xb.w = pk2(x1[1].z, x1[1].w); } x1[n] = x1[n] * gm[bj][n]; }
                    u32x4 w; w.x = pk2(x1[0].x, x1[0].y); w.y = pk2(x1[0].z, x1[0].w); w.z = pk2(x1[1].x, x1[1].y); w.w = pk2(x1[1].z, x1[1].w);
                    st16wt(A2, (row * D_ + colb + 128 * bj) * 2u, w);
                    st16wt(x1b, (row * D_ + colb + 128 * bj) * 2u, xb);
                    { const unsigned t = row & (S_ - 1); if (t >= 2016u) st16wt(A2tail, (((row >> 11) * 32 + (t - 2016u)) * D_ + colb + 128 * bj) * 2u, w); } }
                ss += __shfl_xor(ss, 16); ss += __shfl_xor(ss, 32);
                if (fq == 0) rowss[row * 16 + u.pn * 4 + wc] = ss; }
            asm volatile("" ::: "memory");
        }
    }
};
struct EpiUp {
    static constexpr bool PERM = true, AFTER_DRAIN = false;
    const float* rowss; const float* bias2; bf16_t* U; int half;
    __device__ __forceinline__ void operator()(const f32x4 (&acc)[2][2][4][2], const pg8::Unit& u, int wr, int wc, int fr, int fq) const {
        const int b = u.pm >> 3; const int row0 = u.pm * 256 + wr * 64 + fr;
        f32x4 bv[2][2];
#pragma unroll
        for (int bj = 0; bj < 2; ++bj)
#pragma unroll
            for (int n = 0; n < 2; ++n) bv[bj][n] = *(const f32x4*)(bias2 + b * (2 * DFF) + bj * DFF + half * HALFC + 128 * u.pn + 32 * wc + 8 * fq + 4 * n);
#pragma unroll
        for (int ai = 0; ai < 2; ++ai)
#pragma unroll
            for (int m = 0; m < 4; ++m) { const unsigned row = (unsigned)(row0 + ai * 128 + m * 16); const f32x4 s4 = *(const f32x4*)(rowss + row * 16 + 4 * fq); float sq = (s4.x + s4.y) + (s4.z + s4.w); sq += __shfl_xor(sq, 16); sq += __shfl_xor(sq, 32);
                const float rstd = rsqrtf(sq * (1.f / D_) + EPS);
#pragma unroll
                for (int bj = 0; bj < 2; ++bj) { const f32x4 v0 = acc[ai][bj][m][0] * rstd + bv[bj][0], v1 = acc[ai][bj][m][1] * rstd + bv[bj][1];
                    u32x4 w; w.x = pk2(v0.x, v0.y); w.y = pk2(v0.z, v0.w); w.z = pk2(v1.x, v1.y); w.w = pk2(v1.z, v1.w);
                    *(u32x4*)(U + (row * DFF + 256 * u.pn + 128 * bj + 32 * wc + 8 * fq)) = w; } }
    }
};

__device__ __forceinline__ float dpp_f(float old, float src, int which) {
    const int o = __builtin_bit_cast(int, old), v = __builtin_bit_cast(int, src); int r;
    if (which == 0) r = __builtin_amdgcn_update_dpp(o, v, 0x111, 0xf, 0xf, false);
    else if (which == 1) r = __builtin_amdgcn_update_dpp(o, v, 0x112, 0xf, 0xf, false);
    else if (which == 2) r = __builtin_amdgcn_mov_dpp(v, 0x121, 0xf, 0xf, true);
    else r = __builtin_amdgcn_mov_dpp(v, 0x122, 0xf, 0xf, true);
    return __builtin_bit_cast(float, r);
}
__device__ __forceinline__ float dppz(float src, int which) {
    const int v = __builtin_bit_cast(int, src); int r;
    if (which == 0) r = __builtin_amdgcn_update_dpp(0, v, 0x111, 0xf, 0xf, true);
    else if (which == 1) r = __builtin_amdgcn_update_dpp(0, v, 0x112, 0xf, 0xf, true);
    else if (which == 2) r = __builtin_amdgcn_mov_dpp(v, 0x121, 0xf, 0xf, true);
    else r = __builtin_amdgcn_mov_dpp(v, 0x122, 0xf, 0xf, true);
    return __builtin_bit_cast(float, r);
}
#define FMAC_DPP4(G, V, sg, sv, wa, wb, wc, wd, c1, c2) \
    asm("s_nop 1\n\tv_fmac_f32_dpp %0, %2, %4 " c1 " row_mask:0xf bank_mask:0xf bound_ctrl:1\n\tv_fmac_f32_dpp %0, %2, %5 " c2 " row_mask:0xf bank_mask:0xf bound_ctrl:1\n\t" \
        "v_fmac_f32_dpp %1, %3, %6 " c1 " row_mask:0xf bank_mask:0xf bound_ctrl:1\n\tv_fmac_f32_dpp %1, %3, %7 " c2 " row_mask:0xf bank_mask:0xf bound_ctrl:1" \
        : "+v"(G), "+v"(V) : "v"(sg), "v"(sv), "v"(wa), "v"(wb), "v"(wc), "v"(wd))
struct UpOrder : pg8::StaticOrder {
    long tail_off;
    __device__ __forceinline__ long a_off(int pm, size_t) const { return pm < 64 ? ((long)((pm >> 3) * S_ + 254 * (pm & 7) - 2)) * (D_ * 2) : tail_off; }
};
struct EpiUpF {
    static constexpr bool PERM = true, AFTER_DRAIN = false;
    const float* rowss; const float* bias2; const float* fcw; bf16_t* act; LAS float* xch;
    __device__ __forceinline__ void operator()(f32x4 (&acc)[2][2][4][2], const pg8::Unit& u, int wr, int wc, int fr, int fq) const {
        if (u.pm == 64) run<true>(acc, u, wr, wc, fr, fq); else run<false>(acc, u, wr, wc, fr, fq);
    }
    template <bool tail> __device__ __forceinline__ void run(f32x4 (&acc)[2][2][4][2], const pg8::Unit& u, int wr, int wc, int fr_in, int fq_in) const {
        int fr = fr_in, fq = fq_in; asm volatile("" : "+v"(fr), "+v"(fq));
        fr &= 15; fq &= 3;
        const int pm = u.pm, pn = u.pn; const int breg = pm >> 3, ireg = pm & 7;
        const int rbase = wr * 64 + fr, colg = 32 * wc + 8 * fq, chan0 = 128 * pn + colg;
        const int tok0 = breg * S_ + 254 * ireg - 2;
        const bool zfirst = !tail && ireg == 0 && wr == 0 && fr < 2;
        float rstd[2][4];
#pragma unroll
        for (int ai = 0; ai < 2; ++ai)
#pragma unroll
            for (int m = 0; m < 4; ++m) {
                const int r = rbase + 128 * ai + 16 * m; int grow = tail ? (r >> 5) * S_ + 2016 + (r & 31) : tok0 + r; grow = grow < 0 ? 0 : grow;
                const f32x4 s4 = *(const f32x4*)(rowss + (unsigned)grow * 16 + 4 * fq); float sq = (s4.x + s4.y) + (s4.z + s4.w); sq += __shfl_xor(sq, 16); sq += __shfl_xor(sq, 32);
                rstd[ai][m] = rsqrtf(sq * (1.f / D_) + EPS);
            }
#pragma unroll
        for (int ai = 0; ai < 2; ++ai) { const float* bp = bias2 + (tail ? (4 * ai + 2 * wr + 1) : breg) * (2 * DFF) + chan0;
#pragma unroll
            for (int bj = 0; bj < 2; ++bj)
#pragma unroll
                for (int n = 0; n < 2; ++n) { const f32x4 v = acc[ai][bj][3][n] * rstd[ai][3] + *(const f32x4*)(bp + bj * DFF + 4 * n);
                    if (fr >= 14) *(LAS f32x4*)(xch + (((2 * ai + wr) * 2 + (fr - 14)) * 256 + 128 * bj + colg + 4 * n)) = v; } }
        asm volatile("s_waitcnt lgkmcnt(0)" ::: "memory"); __builtin_amdgcn_s_barrier(); asm volatile("" ::: "memory");
#pragma unroll
        for (int n = 0; n < 2; ++n) {
            const float* wp = fcw + chan0 + 4 * n;
            const f32x4 wg0 = *(const f32x4*)(wp), wg1 = *(const f32x4*)(wp + 2 * DFF), wg2 = *(const f32x4*)(wp + 4 * DFF);
            const f32x4 wv0 = *(const f32x4*)(wp + DFF), wv1 = *(const f32x4*)(wp + 3 * DFF), wv2 = *(const f32x4*)(wp + 5 * DFF);
            f32x4 bg = (f32x4){0.f, 0.f, 0.f, 0.f}, bvl = bg;
            if (!tail) { bg = *(const f32x4*)(bias2 + breg * (2 * DFF) + chan0 + 4 * n); bvl = *(const f32x4*)(bias2 + breg * (2 * DFF) + DFF + chan0 + 4 * n); }
            f32x4 ag, bgm, av, bvm;
#pragma unroll
            for (int e = 0; e < 4; ++e) { ag[e] = fr == 0 ? wg1[e] : 0.f; bgm[e] = fr < 2 ? wg0[e] : 0.f; av[e] = fr == 0 ? wv1[e] : 0.f; bvm[e] = fr < 2 ? wv0[e] : 0.f; }
#pragma unroll
            for (int ai = 0; ai < 2; ++ai) {
                const int slot = 2 * ai + wr - 1;
                f32x4 g14 = (f32x4){0.f, 0.f, 0.f, 0.f}, g15 = g14, v14 = g14, v15 = g14;
                if (slot >= 0) { const LAS float* xp = xch + (slot * 2) * 256 + colg + 4 * n;
                    g14 = *(const LAS f32x4*)(xp); g15 = *(const LAS f32x4*)(xp + 256); v14 = *(const LAS f32x4*)(xp + 128); v15 = *(const LAS f32x4*)(xp + 256 + 128); }
                f32x4 pg = g14, pv = g14;
#pragma unroll
                for (int m = 0; m < 4; ++m) {
                    const int r = rbase + 128 * ai + 16 * m;
                    if (tail) { const float* bp = bias2 + (4 * ai + 2 * wr + (m >> 1)) * (2 * DFF) + chan0 + 4 * n; bg = *(const f32x4*)(bp); bvl = *(const f32x4*)(bp + DFF); }
                    f32x4 cg_ = acc[ai][0][m][n] * rstd[ai][m] + bg, cv_ = acc[ai][1][m][n] * rstd[ai][m] + bvl;
                    if (ai == 0 && m == 0) { if (zfirst) { cg_ = (f32x4){0.f, 0.f, 0.f, 0.f}; cv_ = cg_; } }
                    float o[4];
#pragma unroll
                    for (int e = 0; e < 4; ++e) {
                        float G = wg2[e] * cg_[e], V = wv2[e] * cv_[e];
                        FMAC_DPP4(G, V, cg_[e], cv_[e], wg1[e], wg0[e], wv1[e], wv0[e], "row_shr:1", "row_shr:2");
                        if (m == 0) { const float x2g = (fr == 0) ? g14[e] : g15[e], x2v = (fr == 0) ? v14[e] : v15[e];
                            G = __builtin_fmaf(g15[e], ag[e], G); G = __builtin_fmaf(x2g, bgm[e], G); V = __builtin_fmaf(v15[e], av[e], V); V = __builtin_fmaf(x2v, bvm[e], V); }
                        else { FMAC_DPP4(G, V, pg[e], pv[e], ag[e], bgm[e], av[e], bvm[e], "row_ror:1", "row_ror:2"); }
                        o[e] = G * __builtin_amdgcn_rcpf(1.f + __expf(-G)) * V;
                    }
                    pg = cg_; pv = cv_;
                    bool outv; int tg;
                    if (tail) { outv = (m & 1) != 0; tg = (r >> 5) * S_ + 2016 + (r & 31); } else { outv = r >= 2; tg = tok0 + r; }
                    if (outv) { u32x2 w; w.x = pk2(o[0], o[1]); w.y = pk2(o[2], o[3]); *(u32x2*)(act + ((unsigned)tg * DFF + chan0 + 4 * n)) = w; }
                    __builtin_amdgcn_sched_barrier(0);
                }
            }
        }
    }
};
struct EpiDown {
    static constexpr bool PERM = true, AFTER_DRAIN = false;
    const float* mod; const bf16_t* x1b; float* dst;
    __device__ __forceinline__ void operator()(const f32x4 (&acc)[2][2][4][2], const pg8::Unit& u, int wr, int wc, int fr, int fq) const {
        const int b = u.pm >> 3, colb = u.pn * 256 + wc * 32 + 8 * fq; const int row0 = u.pm * 256 + wr * 64 + fr;
        const float* mb = mod + b * NMOD + 5120;
        f32x4 g2v[2][2];
#pragma unroll
        for (int bj = 0; bj < 2; ++bj)
#pragma unroll
            for (int n = 0; n < 2; ++n) g2v[bj][n] = *(const f32x4*)(mb + colb + 128 * bj + 4 * n);
#pragma unroll
        for (int ai = 0; ai < 2; ++ai) {
            u32x4 xw[4][2];
#pragma unroll
            for (int m = 0; m < 4; ++m)
#pragma unroll
                for (int bj = 0; bj < 2; ++bj) xw[m][bj] = __builtin_nontemporal_load((const u32x4*)(x1b + ((unsigned)(row0 + ai * 128 + m * 16) * D_ + colb + 128 * bj)));
#pragma unroll
            for (int m = 0; m < 4; ++m) { const unsigned row = (unsigned)(row0 + ai * 128 + m * 16);
#pragma unroll
                for (int bj = 0; bj < 2; ++bj) { float xf[8]; unpack8(xw[m][bj], xf);
#pragma unroll
                    for (int n = 0; n < 2; ++n) { const unsigned o_ = row * D_ + colb + 128 * bj + 4 * n;
                        *(f32x4*)(dst + o_) = (f32x4){xf[4 * n], xf[4 * n + 1], xf[4 * n + 2], xf[4 * n + 3]} + g2v[bj][n] * acc[ai][bj][m][n]; } } }
            asm volatile("" ::: "memory");
        }
    }
};

__device__ __forceinline__ int crow(int r, int hi) { return (r & 3) + 8 * (r >> 2) + 4 * hi; }
constexpr int AB_K = 0, AB_V = 9216, AB_A = 18432, ABUF = 19456, A_LW = 2 * ABUF;
__device__ __forceinline__ void attn_unit(const Params& p, LAS unsigned char* lds, int bh, int qb, float mshift, int tid, int lane, int wave) {
    const int r32 = lane & 31, hi = lane >> 5, b = bh >> 3, h = bh & 7;
    const bf16_t* Qg = (const bf16_t*)(p.ws + WS_Q); const bf16_t* Kg = (const bf16_t*)(p.ws + WS_K); const bf16_t* Vg = (const bf16_t*)(p.ws + WS_VT);
    const u32x4* qaug = (const u32x4*)(p.ws + WS_QAUG) + (size_t)bh * S_; const u32x4* kaug = (const u32x4*)(p.ws + WS_KAUG) + (size_t)bh * S_;
    bf16_t* mix = (bf16_t*)(p.ws + WS_MIX);
    const int q_rel = 32 * wave + r32, tq = 256 * qb + q_rel;
    bf16x8 qr[4], qa;
    { const bf16_t* qp = Qg + ((size_t)(b * S_ + tq)) * 512 + h * 64 + 8 * hi;
#pragma unroll
      for (int d0 = 0; d0 < 4; ++d0) qr[d0] = *(const bf16x8*)(qp + 16 * d0);
      u32x4 t = qaug[tq]; if (hi) t = (u32x4){0u, 0u, 0u, 0u}; qa = __builtin_bit_cast(bf16x8, t); }
    f32x16 o[2]; float lsum = 0.f;
#pragma unroll
    for (int i = 0; i < 16; ++i) { o[0][i] = 0.f; o[1][i] = 0.f; }
    const int NT = 4 * (qb + 1);
    const int srow = tid >> 3, sch = tid & 7;
    const bf16_t* kp = Kg + ((size_t)(b * S_ + srow)) * 512 + h * 64 + 8 * sch;
    const bf16_t* vp = Vg + ((size_t)(bh * 64 + srow)) * S_ + 8 * sch;
    u32x4 kreg = *(const u32x4*)kp, vreg = *(const u32x4*)vp, areg = (u32x4){0u, 0u, 0u, 0u};
    if (tid < 64) areg = kaug[tid];
    { LAS unsigned char* bb = lds; *(LAS u32x4*)(bb + AB_K + srow * 144 + sch * 16) = kreg; *(LAS u32x4*)(bb + AB_V + srow * 144 + sch * 16) = vreg; if (tid < 64) *(LAS u32x4*)(bb + AB_A + tid * 16) = areg; }
    __syncthreads();
    for (int j = 0; j < NT; ++j) {
        const bool more = (j + 1 < NT);
        if (more) { kreg = *(const u32x4*)(kp + (size_t)(j + 1) * 64 * 512); vreg = *(const u32x4*)(vp + (j + 1) * 64); if (tid < 64) areg = kaug[(j + 1) * 64 + tid]; }
        const LAS unsigned char* bb = lds + (j & 1) * ABUF;
        const int jb = j - 4 * qb;
#pragma unroll
        for (int kh = 0; kh < 2; ++kh) {
            if (jb >= 0 && 64 * jb + 32 * kh > 32 * wave + 31) continue;
            f32x16 C;
#pragma unroll
            for (int i = 0; i < 16; ++i) C[i] = -mshift;
            const LAS unsigned char* kr = bb + AB_K + (32 * kh + r32) * 144 + hi * 16;
#pragma unroll
            for (int d0 = 0; d0 < 4; ++d0) { const bf16x8 a = *(const LAS bf16x8*)(kr + d0 * 32); C = __builtin_amdgcn_mfma_f32_32x32x16_bf16(a, qr[d0], C, 0, 0, 0); }
            { u32x4 t = *(const LAS u32x4*)(bb + AB_A + (32 * kh + r32) * 16); if (hi) t = (u32x4){0u, 0u, 0u, 0u};
              C = __builtin_amdgcn_mfma_f32_32x32x16_bf16(__builtin_bit_cast(bf16x8, t), qa, C, 0, 0, 0); }
            if (jb >= 0) {
#pragma unroll
                for (int i = 0; i < 16; ++i) { const int kv = 64 * jb + 32 * kh + crow(i, hi); if (kv > q_rel) C[i] = -INFINITY; }
            }
#pragma unroll
            for (int i = 0; i < 16; ++i) { C[i] = __builtin_amdgcn_exp2f(C[i]); lsum += C[i]; }
#pragma unroll
            for (int s = 0; s < 2; ++s) {
                u32x4 pw; pw.x = cvtpk_s(C[8 * s + 0], C[8 * s + 1]); pw.y = cvtpk_s(C[8 * s + 2], C[8 * s + 3]); pw.z = cvtpk_s(C[8 * s + 4], C[8 * s + 5]); pw.w = cvtpk_s(C[8 * s + 6], C[8 * s + 7]);
                const bf16x8 pa = __builtin_bit_cast(bf16x8, pw);
#pragma unroll
                for (int dh = 0; dh < 2; ++dh) { const bf16x8 vf = *(const LAS bf16x8*)(bb + AB_V + (32 * dh + r32) * 144 + (32 * kh + 16 * s + 8 * hi) * 2);
                    o[dh] = __builtin_amdgcn_mfma_f32_32x32x16_bf16(pa, vf, o[dh], 0, 0, 0); }
            }
        }
        if (more) { LAS unsigned char* nb = lds + ((j + 1) & 1) * ABUF; *(LAS u32x4*)(nb + AB_K + srow * 144 + sch * 16) = kreg; *(LAS u32x4*)(nb + AB_V + srow * 144 + sch * 16) = vreg; if (tid < 64) *(LAS u32x4*)(nb + AB_A + tid * 16) = areg; }
        __syncthreads();
    }
    lsum += __shfl_xor(lsum, 32);
    LAS float* lw = (LAS float*)(lds + A_LW + wave * 128);
    if (hi == 0) lw[r32] = lsum;
    asm volatile("s_waitcnt lgkmcnt(0)" ::: "memory");
    bf16_t* op = mix + ((size_t)(b * S_ + 256 * qb + 32 * wave)) * D_ + h * 64 + r32;
#pragma unroll
    for (int i = 0; i < 16; ++i) { const int qq = crow(i, hi); const float rl = 1.f / lw[qq];
        op[(size_t)qq * D_] = (bf16_t)f2bf(o[0][i] * rl); op[(size_t)qq * D_ + 32] = (bf16_t)f2bf(o[1][i] * rl); }
    asm volatile("s_waitcnt lgkmcnt(0)" ::: "memory");
}

__device__ __forceinline__ void phase3(const Params& p, LAS unsigned char* lds, int tid, int lane, int wave) {
    float mq = 0.f, mk = 0.f;
    for (int i = 0; i < 64; ++i) { mq = fmaxf(mq, fabsf(p.qg[i])); mk = fmaxf(mk, fabsf(p.kg[i])); }
    const float mshift = 8.f * LOG2E * 1.03f * mq * mk;
    const int G = gridDim.x, bx = blockIdx.x; const int vcu = (G % 8 == 0) ? (bx % 8) * (G / 8) + bx / 8 : bx;
    for (int pr = vcu; pr < 256; pr += G) { const int bh = pr >> 2, s = pr & 3;
#if PROBE_DUP == 4
        for (int rep = 0; rep < 4; ++rep) { int e = rep & 1; asm volatile("" : "+s"(e)); attn_unit(p, lds, bh, e ? s : 7 - s, mshift, tid, lane, wave); }
#else
        for (int rep = 0; rep < 2; ++rep) { int e = rep; asm volatile("" : "+s"(e)); attn_unit(p, lds, bh, e ? s : 7 - s, mshift, tid, lane, wave); }
#endif
    }
    const bf16_t* Z = (const bf16_t*)(p.ws + WS_Z); const bf16_t* BG = (const bf16_t*)(p.ws + WS_BG); bf16_t* mix = (bf16_t*)(p.ws + WS_MIX);
    for (int it = bx * 512 + tid; it < (T_ / 8) * 64; it += G * 512) {
        const int rc = it >> 6, c0 = 8 * (it & 63), t0 = 8 * rc;
        float w0[8], w1[8], w2[8], z1[8], z2[8];
#pragma unroll
        for (int i = 0; i < 8; ++i) { w0[i] = p.cmw[c0 + i]; w1[i] = p.cmw[512 + c0 + i]; w2[i] = p.cmw[1024 + c0 + i]; z1[i] = 0.f; z2[i] = 0.f; }
        if (t0 & (S_ - 1)) { unpack8(*(const u32x4*)(Z + (size_t)(t0 - 2) * 512 + c0), z2); unpack8(*(const u32x4*)(Z + (size_t)(t0 - 1) * 512 + c0), z1); }
#pragma unroll
        for (int r = 0; r < 8; ++r) { float zc[8], bg[8], ov[8];
            unpack8(*(const u32x4*)(Z + (size_t)(t0 + r) * 512 + c0), zc); unpack8(*(const u32x4*)(BG + (size_t)(t0 + r) * 512 + c0), bg);
#pragma unroll
            for (int i = 0; i < 8; ++i) { ov[i] = bg[i] * (w0[i] * z2[i] + w1[i] * z1[i] + w2[i] * zc[i]); z2[i] = z1[i]; z1[i] = zc[i]; }
            st16wt(mix, (unsigned)(((t0 + r) * D_ + 512 + c0) * 2), pack8(ov)); }
    }
}

#define XB_TMO      128
#define XB_XCNT(j)  (256  + 64 * (j))
#define XB_XSUB(j)  (1280 + 64 * (j))
#define XB_XGEN(j)  (2304 + 64 * (j))
#define XB_TOP      3328
#define XB_TOPGEN   3392
#define XCD_BAR_WORDS 3456
#define XB_SPIN_CAP (1u << 18)

__device__ __forceinline__ unsigned xb_ld(unsigned* p)              { return __hip_atomic_load(p, __ATOMIC_RELAXED, __HIP_MEMORY_SCOPE_AGENT); }
__device__ __forceinline__ unsigned xb_add(unsigned* p, unsigned v) { return __hip_atomic_fetch_add(p, v, __ATOMIC_RELAXED, __HIP_MEMORY_SCOPE_AGENT); }
__device__ __forceinline__ unsigned xb_xcc_id() { return (unsigned)__builtin_amdgcn_s_getreg((3 << 11) | 20) & 0xFu; }
#define XB_SPIN(cond, bar) do { unsigned _sp = 0; while (cond) { __builtin_amdgcn_s_sleep(1); \
    if ((++_sp & 255u) == 0u) { if (xb_ld(&(bar)[XB_TMO])) break; if (_sp > XB_SPIN_CAP) { atomicAdd(&(bar)[XB_TMO], 1u); break; } } } } while (0)

struct XcdBarrier {
    unsigned* bar; unsigned x;
    volatile LAS unsigned* st;
};

__device__ __forceinline__ XcdBarrier xcd_barrier_post(unsigned* bar, volatile LAS unsigned* st) {
    XcdBarrier b; b.bar = bar; b.x = xb_xcc_id(); b.st = st;
    if (threadIdx.x == 0) (void)xb_add(&bar[XB_XCNT(b.x)], 1u);
    return b;
}
__device__ __forceinline__ void xcd_barrier_complete(unsigned* bar, unsigned x, unsigned& nloc, unsigned& nx) {
    const unsigned G = gridDim.x * gridDim.y * gridDim.z;
    unsigned sum, cnt, mine, sp = 0u;
    for (;;) {
        sum = 0u; cnt = 0u; mine = 0u;
#pragma unroll
        for (unsigned j = 0; j < 16; ++j) { const unsigned c = xb_ld(&bar[XB_XCNT(j)]); sum += c; cnt += (c > 0u) ? 1u : 0u; mine = (j == x) ? c : mine; }
        if (sum == G) break;
        __builtin_amdgcn_s_sleep(1);
        if ((++sp & 255u) == 0u) { if (xb_ld(&bar[XB_TMO])) break; if (sp > XB_SPIN_CAP) { atomicAdd(&bar[XB_TMO], 1u); break; } }
    }
    nloc = mine > 0u ? mine : 1u; nx = cnt > 0u ? cnt : 1u;
}

__device__ __forceinline__ void xcd_barrier(const XcdBarrier& b) {
    asm volatile("s_waitcnt vmcnt(0)" ::: "memory");
    __syncthreads();
    if (threadIdx.x == 0) {
        unsigned* bar = b.bar;
        __builtin_amdgcn_s_waitcnt(0);
        unsigned nloc = b.st[0], nx = b.st[1];
        if (nloc == 0u) { xcd_barrier_complete(bar, b.x, nloc, nx); b.st[0] = nloc; b.st[1] = nx; }
        const unsigned old = xb_add(&bar[XB_XSUB(b.x)], 1u);
        const unsigned gen = old / nloc;
        if (old + 1u == (gen + 1u) * nloc) {
            __builtin_amdgcn_fence(__ATOMIC_RELEASE, "agent");
            asm volatile("s_waitcnt vmcnt(0)" ::: "memory");
            const unsigned og = xb_add(&bar[XB_TOP], 1u);
            const unsigned tg = og / nx;
            if (og + 1u == (tg + 1u) * nx) xb_add(&bar[XB_TOPGEN], 1u);
            else XB_SPIN(xb_ld(&bar[XB_TOPGEN]) == tg, bar);
            __builtin_amdgcn_fence(__ATOMIC_ACQUIRE, "agent");
            xb_add(&bar[XB_XGEN(b.x)], 1u);
            asm volatile("s_waitcnt vmcnt(0)" ::: "memory");
        } else {
            XB_SPIN(xb_ld(&bar[XB_XGEN(b.x)]) == gen, bar);
            __builtin_amdgcn_fence(__ATOMIC_ACQUIRE, "agent");
            asm volatile("s_waitcnt vmcnt(0)" ::: "memory");
        }
    }
    __syncthreads();
}

__device__ __forceinline__ const void* ldarg(int byteoff) { const void* r;
    asm volatile("s_load_dwordx2 %0, %1, %2\n\ts_waitcnt lgkmcnt(0)" : "=s"(r) : "s"(__builtin_amdgcn_kernarg_segment_ptr()), "i"(byteoff) : "memory"); return r; }
#define LDA(i) ((const float*)ldarg(8 * (i)))
#define GASF __attribute__((address_space(1)))
__device__ __forceinline__ Params load_params() {
    unsigned long long v0, v1, v2, v3, v4, v5, v6, v7, v8, v9, v10, v11, v12, v13, v14, v15, v16;
    asm volatile("s_load_dwordx2 %0, %17, 0\n\ts_load_dwordx2 %1, %17, 8\n\ts_load_dwordx2 %2, %17, 16\n\ts_load_dwordx2 %3, %17, 24\n\ts_load_dwordx2 %4, %17, 32\n\ts_load_dwordx2 %5, %17, 40\n\t"
                 "s_load_dwordx2 %6, %17, 48\n\ts_load_dwordx2 %7, %17, 56\n\ts_load_dwordx2 %8, %17, 64\n\ts_load_dwordx2 %9, %17, 72\n\ts_load_dwordx2 %10, %17, 80\n\ts_load_dwordx2 %11, %17, 88\n\t"
                 "s_load_dwordx2 %12, %17, 96\n\ts_load_dwordx2 %13, %17, 104\n\ts_load_dwordx2 %14, %17, 112\n\ts_load_dwordx2 %15, %17, 120\n\ts_load_dwordx2 %16, %17, 128\n\ts_waitcnt lgkmcnt(0)"
                 : "=&s"(v0), "=&s"(v1), "=&s"(v2), "=&s"(v3), "=&s"(v4), "=&s"(v5), "=&s"(v6), "=&s"(v7), "=&s"(v8), "=&s"(v9),
                   "=&s"(v10), "=&s"(v11), "=&s"(v12), "=&s"(v13), "=&s"(v14), "=&s"(v15), "=&s"(v16)
                 : "s"(__builtin_amdgcn_kernarg_segment_ptr()) : "memory");
#define GP(v) ((const float*)(GASF const float*)(v))
    Params q; q.x = GP(v0); q.c = GP(v1); q.w_ada = GP(v2); q.b_ada = GP(v3); q.n1g = GP(v4); q.w_in = GP(v5); q.b_f = GP(v6); q.qg = GP(v7); q.kg = GP(v8); q.cmw = GP(v9);
    q.w_out = GP(v10); q.n2g = GP(v11); q.w_up = GP(v12); q.fcw = GP(v13); q.w_down = GP(v14); q.out = (float*)(GASF float*)(v15); q.ws = (unsigned char*)(GASF unsigned char*)(v16);
    return q; }
#ifndef PH
#define PH 255
#endif
#ifndef LAST_PHASE
#define LAST_PHASE 99
#endif
__global__ void __launch_bounds__(512, 2) hymba_mega(Params p_arg) {
    extern __shared__ __attribute__((aligned(16))) unsigned char lds_raw[];
    cg::grid_group grid = cg::this_grid();
    LAS unsigned char* lds = (LAS unsigned char*)lds_raw;
    const int tid = threadIdx.x, lane = tid & 63, wave = __builtin_amdgcn_readfirstlane(tid >> 6);
    const int G = gridDim.x, bx = blockIdx.x;
    if (p_arg.ws == nullptr) grid.sync();
    if (tid < 2) ((volatile LAS unsigned*)(lds + 131072))[tid] = 0u;
    __syncthreads();
    const XcdBarrier xbar = xcd_barrier_post((unsigned*)((unsigned char*)(GASF unsigned char*)(unsigned long long)ldarg(8 * 16) + WS_BAR), (volatile LAS unsigned*)(lds + 131072));
#define GSYNC() xcd_barrier(xbar)

#if PH & 1
    { const Params p = load_params(); phase0(p, lds, tid, lane, wave); }
#endif
    GSYNC();
#if PROBE_DUP == 1
    { const Params p = load_params(); phase0(p, lds, tid, lane, wave); } GSYNC();
#endif
#if PROBE_DUP == 9
    GSYNC(); GSYNC(); GSYNC(); GSYNC(); GSYNC(); GSYNC(); GSYNC(); GSYNC(); GSYNC(); GSYNC();
#endif
#if PH & 2
    { const Params p = load_params(); phase1(p, lds, tid, lane, wave); }
#endif
    GSYNC();
#if PROBE_DUP == 2
    { const Params p = load_params(); phase1(p, lds, tid, lane, wave); } GSYNC();
#endif
#if PH & 4
    {
        const Params p = load_params();
        if (bx < 64) scan_item(p, lds, bx, tid, lane, wave);
        pg8::Gemm g{(const bf16_t*)(p.ws + WS_H), (const bf16_t*)(p.ws + WS_WIN), T_, 3072, 1024}; pg8::StaticOrder S; S.init(T_, 3072, G, bx);
        EpiIn E{(bf16_t*)(p.ws + WS_Q), (bf16_t*)(p.ws + WS_K), (bf16_t*)(p.ws + WS_VT), (bf16_t*)(p.ws + WS_Z), (bf16_t*)(p.ws + WS_BG), p.qg, p.kg};
        pg8::gemm_phase<EpiIn, pg8::StaticOrder, true, true>(lds, g, S, E);
    }
#endif
    GSYNC();
#if PH & 8
    { const Params p = load_params(); phase3(p, lds, tid, lane, wave); }
#endif
    GSYNC();
#if PH & 16
    {
        const Params p = load_params();
        pg8::Gemm g{(const bf16_t*)(p.ws + WS_MIX), (const bf16_t*)(p.ws + WS_WOUT), T_, 1024, 1024}; pg8::StaticOrder S; S.init(T_, 1024, G, bx);
        EpiOut E{p.x, (const float*)(p.ws + WS_MOD), p.n2g, (bf16_t*)(p.ws + WS_Q), (bf16_t*)(p.ws + WS_H), (float*)(p.ws + WS_ROWSS), (bf16_t*)(p.ws + WS_TAIL)};
        pg8::gemm_phase<EpiOut, pg8::StaticOrder, true, true>(lds, g, S, E);
#if PROBE_DUP == 7
        GSYNC();
        pg8::gemm_phase<EpiOut, pg8::StaticOrder, true, true>(lds, g, S, E);
#endif
    }
#endif
    GSYNC();
#if PH & 32
    {
        const Params p = load_params();
        pg8::Gemm g{(const bf16_t*)(p.ws + WS_H), (const bf16_t*)(p.ws + WS_WUP), 65 * 256, 2 * DFF, 1024};
        UpOrder S; S.init(65 * 256, 2 * DFF, G, bx); S.tail_off = (long)WS_TAIL - (long)WS_H;
        EpiUpF E{(const float*)(p.ws + WS_ROWSS), (const float*)(p.ws + WS_BIAS2), p.fcw, (bf16_t*)(p.ws + WS_ACT), (LAS float*)(lds + XCH_OFF)};
        pg8::gemm_phase<EpiUpF, UpOrder, true, true>(lds, g, S, E);
#if PROBE_DUP == 5
        GSYNC();
        pg8::gemm_phase<EpiUpF, UpOrder, true, true>(lds, g, S, E);
#endif
    }
#endif
    GSYNC();
#if PH & 128
    {
        const Params p = load_params();
        pg8::Gemm g{(const bf16_t*)(p.ws + WS_ACT), (const bf16_t*)(p.ws + WS_WDOWN), T_, 1024, DFF}; pg8::StaticOrder S; S.init(T_, 1024, G, bx);
#if PROBE_DUP == 8
        { EpiDown E0{(const float*)(p.ws + WS_MOD), (const bf16_t*)(p.ws + WS_Q), (float*)(p.ws + WS_K)};
          pg8::gemm_phase<EpiDown, pg8::StaticOrder, true, true>(lds, g, S, E0); GSYNC(); }
#endif
        EpiDown E{(const float*)(p.ws + WS_MOD), (const bf16_t*)(p.ws + WS_Q), p.out};
        pg8::gemm_phase<EpiDown, pg8::StaticOrder, true, true>(lds, g, S, E);
    }
#endif
}

extern "C" void kernel_launch(void* const* d_in, const int* in_sizes, int n_in, void* d_out, int out_size, void* d_ws, size_t ws_size, hipStream_t stream) {
    static int grid = 0;
    if (grid == 0) {
        int dev = 0, cus = 0, per_cu = 0;
        hipGetDevice(&dev); hipDeviceGetAttribute(&cus, hipDeviceAttributeMultiprocessorCount, dev);
        if (hipFuncSetAttribute((const void*)hymba_mega, hipFuncAttributeMaxDynamicSharedMemorySize, LDS_BYTES) != hipSuccess) fprintf(stderr, "hipFuncSetAttribute failed\n");
        if (hipOccupancyMaxActiveBlocksPerMultiprocessor(&per_cu, (const void*)hymba_mega, 512, LDS_BYTES) != hipSuccess || per_cu < 1) { fprintf(stderr, "occupancy query: %d\n", per_cu); per_cu = 1; }
        (void)hipGetLastError();
        grid = cus > 0 ? cus : 256;
    }
    Params p{};
    p.x = (const float*)d_in[0]; p.c = (const float*)d_in[1]; p.w_ada = (const float*)d_in[2]; p.b_ada = (const float*)d_in[3]; p.n1g = (const float*)d_in[4];
    p.w_in = (const float*)d_in[5]; p.b_f = (const float*)d_in[6]; p.qg = (const float*)d_in[7]; p.kg = (const float*)d_in[8]; p.cmw = (const float*)d_in[9];
    p.w_out = (const float*)d_in[10]; p.n2g = (const float*)d_in[11]; p.w_up = (const float*)d_in[12]; p.fcw = (const float*)d_in[13]; p.w_down = (const float*)d_in[14];
    p.out = (float*)d_out; p.ws = (unsigned char*)d_ws;
    (void)hipMemsetAsync((unsigned char*)d_ws + WS_BAR, 0, 16384, stream);
    void* args[] = {&p};
    hipError_t e = hipLaunchCooperativeKernel((const void*)hymba_mega, dim3(grid), dim3(512), args, LDS_BYTES, stream);
    if (e != hipSuccess) fprintf(stderr, "cooperative launch failed: %s (grid %d)\n", hipGetErrorString(e), grid);
}
```

```cpp
#include <hip/hip_runtime.h>
#include <hip/hip_cooperative_groups.h>
#include <cstdio>
#include <cstdint>
namespace cg = cooperative_groups;
#ifndef PROBE_DUP
#define PROBE_DUP 0
#endif
namespace pg8 {
#define PG8_LAS __attribute__((address_space(3)))
typedef unsigned short bf16_t;
typedef short bf16x8 __attribute__((ext_vector_type(8)));
typedef float f32x4 __attribute__((ext_vector_type(4)));
typedef unsigned u32x4 __attribute__((ext_vector_type(4)));
constexpr int BM = 256, BK = 64, HALF = 128, HTB = HALF * BK * 2  , STAGE_BYTES = 8 * HTB, NXCD = 8, WGM = 8;

__host__ __device__ __forceinline__ int lds_byte(int r, int c) { const int st = (r >> 4) * 2 + (c >> 5), rr = r & 15, cc = c & 31, ob = rr * 64 + cc * 2; return st * 1024 + (ob ^ (((ob >> 9) & 1) << 5)); }
__host__ __device__ __forceinline__ void stage_rc(int b, int& R, int& C) { const int st = b / 1024, sb = b % 1024, swz = sb ^ (((sb >> 9) & 1) << 5); R = (st >> 1) * 16 + swz / 64; C = (st & 1) * 32 + (swz % 64) / 2; }
__host__ __device__ __forceinline__ int perm32(int rho) { const int n = rho >> 4, i = rho & 15; return 8 * (i >> 2) + 4 * n + (i & 3); }

struct Unit { int pm, pn; };
struct Gemm { const bf16_t* A; const bf16_t* Bt; int M, N, K; };

struct StaticOrder {
    int nM, nN, nwg, G, c;
    __host__ __device__ void init(int M, int N, int G_, int c_) { nM = M / BM; nN = N / BM; nwg = nM * nN; G = G_; c = c_; }
    __host__ __device__ bool next(int i, Unit& u) const {
        const long L = (long)i * G + c; if (L >= nwg) return false;
        int wgid = (int)L; { const int q = nwg / NXCD, r = nwg % NXCD, xcd = wgid % NXCD, off = wgid / NXCD; wgid = (xcd < r ? xcd * (q + 1) : r * (q + 1) + (xcd - r) * q) + off; }
        const int nig = WGM * nN, gid = wgid / nig, fm = gid * WGM, gsz = (nM - fm) < WGM ? (nM - fm) : WGM;
        u.pm = fm + ((wgid % nig) % gsz); u.pn = (wgid % nig) / gsz; return true;
    }
    __device__ __forceinline__ void a_ready(const Unit&) const {}
    __device__ __forceinline__ void done(const Unit&) const {}
    __device__ __forceinline__ long a_off(int pm, size_t tstep) const { return (long)pm * (long)tstep; }
};

__device__ __forceinline__ unsigned cvt_pk_bf16(float lo, float hi) { unsigned r; asm volatile("v_cvt_pk_bf16_f32 %0, %1, %2" : "=v"(r) : "v"(lo), "v"(hi)); return r; }
typedef float f32x2 __attribute__((ext_vector_type(2)));
template <class Epi, class Sched, bool ALIGN_EPI = false, bool SP2 = false>
__device__ __forceinline__ void gemm_phase(PG8_LAS unsigned char* lds, const Gemm g, const Sched& S, const Epi& E) {
    int tid_o = threadIdx.x; asm volatile("" : "+v"(tid_o));
    const int tid = tid_o & 511, wid = __builtin_amdgcn_readfirstlane(tid >> 6), lane = tid & 63, wr = wid >> 2, wc = wid & 3, fr = lane & 15, fq = lane >> 4;
    const int K = g.K, nt = K / BK;
    unsigned voffA[2], voffB[2];
#pragma unroll
    for (int i = 0; i < 2; ++i) { int R, C; stage_rc(tid * 16 + i * 8192, R, C); const int Rb = Epi::PERM ? ((R & ~31) + perm32(R & 31)) : R;
        voffA[i] = (unsigned)(R * K + C) * 2u; voffB[i] = (unsigned)(Rb * K + C) * 2u; }
    const size_t kstep = (size_t)(BK * 2);
    const size_t hstep = (size_t)HALF * K * 2;
    const size_t tstep = 2 * hstep;
    const unsigned ldsw = (unsigned)wid * 1024u;
    const int aoff = lds_byte(wr * 64 + fr, fq * 8), boff = lds_byte(wc * 32 + fr, fq * 8);
#define PG8_SA(b, h) (((b) * 2 + (h)) * HTB)
#define PG8_SB(b, h) ((4 + (b) * 2 + (h)) * HTB)
#define PG8_STAGE(bufoff, gbase, voff) do { _Pragma("unroll") for (int _i = 0; _i < 2; ++_i) \
        __builtin_amdgcn_global_load_lds((const unsigned*)((const char*)(gbase) + (voff)[_i]), (PG8_LAS unsigned*)(lds + (bufoff) + ldsw + _i * 8192), 16, 0, 0); } while (0)
#define PG8_LDA(dst, b, h) do { _Pragma("unroll") for (int m = 0; m < 4; ++m) _Pragma("unroll") for (int k = 0; k < 2; ++k) dst[m][k] = *(const PG8_LAS bf16x8*)(lds + PG8_SA(b, h) + aoff + m * 2048 + k * 1024); } while (0)
#define PG8_LDB(dst, b, h) do { _Pragma("unroll") for (int n = 0; n < 2; ++n) _Pragma("unroll") for (int k = 0; k < 2; ++k) dst[n][k] = *(const PG8_LAS bf16x8*)(lds + PG8_SB(b, h) + boff + n * 2048 + k * 1024); } while (0)
#define PG8_MMA(ai, bj, At, Bt) do { __builtin_amdgcn_s_setprio(1); _Pragma("unroll") for (int m = 0; m < 4; ++m) _Pragma("unroll") for (int n = 0; n < 2; ++n) _Pragma("unroll") for (int k = 0; k < 2; ++k) \
        acc[ai][bj][m][n] = __builtin_amdgcn_mfma_f32_16x16x32_bf16(Bt[n][k], At[m][k], acc[ai][bj][m][n], 0, 0, 0); __builtin_amdgcn_s_setprio(0); } while (0)
#define PG8_WAIT_V(n) asm volatile("s_waitcnt vmcnt(" #n ")" ::: "memory")
#define PG8_WAIT_L(n) asm volatile("s_waitcnt lgkmcnt(" #n ")" ::: "memory")
#define PG8_BAR __builtin_amdgcn_s_barrier()
#define PG8_SCHED __builtin_amdgcn_sched_barrier(0)
    Unit cur, nxt; int ui = 0;
    if (!S.next(0, cur)) return;
    f32x4 acc[2][2][4][2];
#pragma unroll
    for (int a = 0; a < 2; ++a)
#pragma unroll
        for (int b = 0; b < 2; ++b)
#pragma unroll
            for (int m = 0; m < 4; ++m)
#pragma unroll
                for (int n = 0; n < 2; ++n) acc[a][b][m][n] = (f32x4){0.f, 0.f, 0.f, 0.f};
    bf16x8 At[4][2], B0[2][2], B1[2][2];
    const char* cA = (const char*)g.A + S.a_off(cur.pm, tstep); const char* cB = (const char*)g.Bt + (size_t)cur.pn * tstep;
    S.a_ready(cur);
    if constexpr (SP2) {
        PG8_STAGE(PG8_SB(0, 0), cB, voffB); PG8_STAGE(PG8_SB(0, 1), cB + hstep, voffB); PG8_STAGE(PG8_SA(0, 0), cA, voffA); PG8_STAGE(PG8_SA(0, 1), cA + hstep, voffA);
        if (wr == 1) PG8_BAR;
        PG8_WAIT_V(2); PG8_BAR;
        PG8_STAGE(PG8_SB(1, 0), cB + kstep, voffB); PG8_STAGE(PG8_SA(1, 0), cA + kstep, voffA); PG8_STAGE(PG8_SB(1, 1), cB + hstep + kstep, voffB);
        PG8_WAIT_V(6); PG8_BAR;
    } else {
        PG8_STAGE(PG8_SB(0, 0), cB, voffB); PG8_STAGE(PG8_SA(0, 0), cA, voffA); PG8_STAGE(PG8_SB(0, 1), cB + hstep, voffB); PG8_STAGE(PG8_SA(0, 1), cA + hstep, voffA);
        if (wr == 1) PG8_BAR;
        PG8_WAIT_V(4); PG8_BAR;
        PG8_STAGE(PG8_SB(1, 0), cB + kstep, voffB); PG8_STAGE(PG8_SA(1, 0), cA + kstep, voffA); PG8_STAGE(PG8_SB(1, 1), cB + hstep + kstep, voffB);
        PG8_WAIT_V(6); PG8_BAR;
    }
    for (;;) {
        const bool has_next = S.next(ui + 1, nxt);
        const char* nA = has_next ? (const char*)g.A + S.a_off(nxt.pm, tstep) : cA; const char* nB = has_next ? (const char*)g.Bt + (size_t)nxt.pn * tstep : cB;
        for (int t = 0; t < nt; t += 2) {
            const bool last = (t == nt - 2);
            const char* a1 = cA + (size_t)(t + 1) * kstep;
            const char* a2 = last ? nA : cA + (size_t)(t + 2) * kstep; const char* b2 = last ? nB : cB + (size_t)(t + 2) * kstep;
            const char* a3 = a2 + kstep; const char* b3 = b2 + kstep;
            if (last && has_next) S.a_ready(nxt);
            if constexpr (SP2) {
            PG8_LDB(B0, 0, 0); PG8_LDB(B1, 0, 1); PG8_SCHED; PG8_LDA(At, 0, 0); PG8_STAGE(PG8_SA(1, 1), a1 + hstep, voffA);
            PG8_WAIT_V(8); PG8_WAIT_L(0); PG8_BAR; PG8_MMA(0, 0, At, B0); PG8_MMA(0, 1, At, B1); PG8_BAR; PG8_SCHED;
            PG8_LDA(At, 0, 1); PG8_STAGE(PG8_SB(0, 0), b2, voffB); PG8_STAGE(PG8_SB(0, 1), b2 + hstep, voffB); PG8_STAGE(PG8_SA(0, 0), a2, voffA);
            PG8_WAIT_V(8); PG8_WAIT_L(0); PG8_BAR; PG8_MMA(1, 0, At, B0); PG8_MMA(1, 1, At, B1); PG8_BAR; PG8_SCHED;
            PG8_LDB(B0, 1, 0); PG8_LDB(B1, 1, 1); PG8_SCHED; PG8_LDA(At, 1, 0); PG8_STAGE(PG8_SA(0, 1), a2 + hstep, voffA);
            PG8_WAIT_V(8); PG8_WAIT_L(0); PG8_BAR; PG8_MMA(0, 0, At, B0); PG8_MMA(0, 1, At, B1); PG8_BAR; PG8_SCHED;
            PG8_LDA(At, 1, 1); PG8_STAGE(PG8_SB(1, 0), b3, voffB); PG8_STAGE(PG8_SB(1, 1), b3 + hstep, voffB); PG8_STAGE(PG8_SA(1, 0), a3, voffA);
            PG8_WAIT_V(8); PG8_WAIT_L(0); PG8_BAR; PG8_MMA(1, 0, At, B0); PG8_MMA(1, 1, At, B1); PG8_BAR; PG8_SCHED;
            } else {
            PG8_LDB(B0, 0, 0); PG8_SCHED; PG8_LDA(At, 0, 0); PG8_STAGE(PG8_SA(1, 1), a1 + hstep, voffA);
            PG8_WAIT_L(8); PG8_BAR; PG8_WAIT_L(0); PG8_MMA(0, 0, At, B0); PG8_BAR; PG8_SCHED;
            PG8_LDB(B1, 0, 1); PG8_STAGE(PG8_SB(0, 0), b2, voffB);
            PG8_BAR; PG8_WAIT_L(0); PG8_MMA(0, 1, At, B1); PG8_BAR;
            PG8_LDA(At, 0, 1); PG8_STAGE(PG8_SA(0, 0), a2, voffA);
            PG8_BAR; PG8_WAIT_L(0); PG8_MMA(1, 0, At, B0); PG8_BAR; PG8_SCHED;
            PG8_STAGE(PG8_SB(0, 1), b2 + hstep, voffB);
            PG8_WAIT_V(6); PG8_BAR; PG8_MMA(1, 1, At, B1); PG8_BAR;
            PG8_LDB(B0, 1, 0); PG8_SCHED; PG8_LDA(At, 1, 0); PG8_STAGE(PG8_SA(0, 1), a2 + hstep, voffA);
            PG8_WAIT_L(8); PG8_BAR; PG8_WAIT_L(0); PG8_MMA(0, 0, At, B0); PG8_BAR; PG8_SCHED;
            PG8_LDB(B1, 1, 1); PG8_STAGE(PG8_SB(1, 0), b3, voffB);
            PG8_BAR; PG8_WAIT_L(0); PG8_MMA(0, 1, At, B1); PG8_BAR;
            PG8_LDA(At, 1, 1); PG8_STAGE(PG8_SA(1, 0), a3, voffA);
            PG8_BAR; PG8_WAIT_L(0); PG8_MMA(1, 0, At, B0); PG8_BAR; PG8_SCHED;
            PG8_STAGE(PG8_SB(1, 1), b3 + hstep, voffB);
            PG8_WAIT_V(6); PG8_BAR; PG8_MMA(1, 1, At, B1); PG8_BAR;
            }
        }
        if constexpr (ALIGN_EPI) { if (wr == 0) PG8_BAR; }
        if constexpr (!Epi::AFTER_DRAIN) { E(acc, cur, wr, wc, fr, fq); S.done(cur); }
        if (!has_next) break;
#pragma unroll
        for (int a = 0; a < 2; ++a)
#pragma unroll
            for (int b = 0; b < 2; ++b)
#pragma unroll
                for (int m = 0; m < 4; ++m)
#pragma unroll
                    for (int n = 0; n < 2; ++n) acc[a][b][m][n] = (f32x4){0.f, 0.f, 0.f, 0.f};
        cur = nxt; cA = nA; cB = nB; ++ui;
        if constexpr (ALIGN_EPI) { if (wr == 1) PG8_BAR; }
    }
    PG8_WAIT_V(0);
    if constexpr (!ALIGN_EPI) { if (wr == 0) PG8_BAR; }
    PG8_BAR;
    if constexpr (Epi::AFTER_DRAIN) { E.fused(acc, cur, wr, wc, fr, fq, lds, wid, lane); S.done(cur); }
#undef PG8_SA
#undef PG8_SB
#undef PG8_STAGE
#undef PG8_LDA
#undef PG8_LDB
#undef PG8_MMA
#undef PG8_WAIT_V
#undef PG8_WAIT_L
#undef PG8_BAR
#undef PG8_SCHED
}
}
#define LAS __attribute__((address_space(3)))
typedef unsigned short bf16_t;
typedef short bf16x8 __attribute__((ext_vector_type(8)));
typedef float f32x4 __attribute__((ext_vector_type(4)));
typedef float f32x16 __attribute__((ext_vector_type(16)));
typedef unsigned u32x4 __attribute__((ext_vector_type(4)));
typedef unsigned u32x2 __attribute__((ext_vector_type(2)));
constexpr int T_ = 16384, D_ = 1024, S_ = 2048, NH = 8, DFF = 2816, DIN = 3080, NMOD = 6144, HALFC = 1408;
constexpr float EPS = 1e-6f;
constexpr float LOG2E = 1.4426950408889634f;
constexpr float C2 = 0.125f * LOG2E;
constexpr size_t MiB = 1u << 20;
constexpr size_t WS_MOD = 0, WS_BIAS2 = 256 * 1024, WS_ROWSS = 31 * MiB, WS_BAR = 640 * 1024, WS_LOGF = 1 * MiB, WS_QAUG = 2 * MiB, WS_KAUG = 4 * MiB,
    WS_WIN = 6 * MiB, WS_WOUT = 12 * MiB, WS_WUP = 14 * MiB, WS_WDOWN = 25 * MiB, WS_H = 32 * MiB, WS_Q = 64 * MiB, WS_K = 80 * MiB,
    WS_VT = 96 * MiB, WS_Z = 112 * MiB, WS_BG = 128 * MiB, WS_MIX = 144 * MiB, WS_ACT = 160 * MiB, WS_TAIL = 30 * MiB + 512 * 1024;
constexpr int LDS_BYTES = 139328;
constexpr int XCH_OFF = 131072 + 64;

struct Params {
    const float *x, *c, *w_ada, *b_ada, *n1g, *w_in, *b_f, *qg, *kg, *cmw, *w_out, *n2g, *w_up, *fcw, *w_down;
    float* out; unsigned char* ws;
};

__device__ __forceinline__ float wave_sum(float v) {
#pragma unroll
    for (int o = 1; o < 64; o <<= 1) v += __shfl_xor(v, o);
    return v;
}
__device__ __forceinline__ float xsum12(float v) {
    v += __builtin_bit_cast(float, __builtin_amdgcn_mov_dpp(__builtin_bit_cast(int, v), 0xB1, 0xf, 0xf, true));
    v += __builtin_bit_cast(float, __builtin_amdgcn_mov_dpp(__builtin_bit_cast(int, v), 0x4E, 0xf, 0xf, true));
    return v;
}
__device__ __forceinline__ unsigned f2bf(float f) { unsigned u = __builtin_bit_cast(unsigned, f); return (u + 0x7fffu + ((u >> 16) & 1u)) >> 16; }
__device__ __forceinline__ float bf2f(unsigned h) { return __builtin_bit_cast(float, h << 16); }
__device__ __forceinline__ unsigned pk2(float lo, float hi) { return pg8::cvt_pk_bf16(lo, hi); }
typedef float f32x2_t __attribute__((ext_vector_type(2))); typedef __bf16 bf16x2_t __attribute__((ext_vector_type(2)));
__device__ __forceinline__ unsigned cvtpk_s(float lo, float hi) { f32x2_t v = {lo, hi}; bf16x2_t b = __builtin_convertvector(v, bf16x2_t); return __builtin_bit_cast(unsigned, b); }
__device__ __forceinline__ void unpack8(u32x4 w, float (&f)[8]) {
    f[0] = bf2f(w.x & 0xffffu); f[1] = __builtin_bit_cast(float, w.x & 0xffff0000u);
    f[2] = bf2f(w.y & 0xffffu); f[3] = __builtin_bit_cast(float, w.y & 0xffff0000u);
    f[4] = bf2f(w.z & 0xffffu); f[5] = __builtin_bit_cast(float, w.z & 0xffff0000u);
    f[6] = bf2f(w.w & 0xffffu); f[7] = __builtin_bit_cast(float, w.w & 0xffff0000u);
}
__device__ __forceinline__ void st16wt(const void* base, unsigned off, u32x4 v) {
    const __amdgpu_buffer_rsrc_t rs = __builtin_amdgcn_make_buffer_rsrc(const_cast<void*>(base), 0, 0x7fffffff, 0x00020000);
    __builtin_amdgcn_raw_buffer_store_b128(v, rs, off, 0,   16);
}
__device__ __forceinline__ u32x4 pack8(const float (&f)[8]) { u32x4 w; w.x = pk2(f[0], f[1]); w.y = pk2(f[2], f[3]); w.z = pk2(f[4], f[5]); w.w = pk2(f[6], f[7]); return w; }

__device__ __forceinline__ void transpose_item(const float* W, int N, int K, bf16_t* WT, int dstrow0, int srccol0, int k0, LAS float* scr, int lane) {
    float tv[32];
    { const float* wp = W + (size_t)(k0 + (lane >> 5)) * N + srccol0 + (lane & 31);
#pragma unroll
      for (int i = 0; i < 32; ++i) tv[i] = __builtin_nontemporal_load(wp + (size_t)(2 * i) * N); }
#pragma unroll
    for (int i = 0; i < 32; ++i) scr[(2 * i + (lane >> 5)) * 33 + (lane & 31)] = tv[i];
    asm volatile("s_waitcnt lgkmcnt(0)" ::: "memory");
    const int c = lane & 7;
#pragma unroll
    for (int j = 0; j < 4; ++j) { const int n = (lane >> 3) + 8 * j; const LAS float* s = scr + (8 * c) * 33 + n;
        u32x4 o; o.x = pk2(s[0 * 33], s[1 * 33]); o.y = pk2(s[2 * 33], s[3 * 33]); o.z = pk2(s[4 * 33], s[5 * 33]); o.w = pk2(s[6 * 33], s[7 * 33]);
        st16wt(WT, (unsigned)(((dstrow0 + n) * K + k0 + 8 * c) * 2), o); }
    asm volatile("s_waitcnt lgkmcnt(0)" ::: "memory");
}
__device__ __forceinline__ int win_src(int p0) {
    const int pn = p0 >> 8, c = p0 & 255, bj = c >> 7, wc = (c & 127) >> 5;
    if (pn < 6) return (pn >> 1) * 512 + (4 * (pn & 1) + wc) * 64 + 32 * bj;
    if (pn < 10) return (bj == 0 ? 1544 : 2568) + 128 * (pn - 6) + (c & 127);
    return 2056 + 256 * (pn - 10) + c;
}
__device__ __forceinline__ int wup_src(int p0) { const int j = p0 >> 8, c = p0 & 255; return (c < 128) ? 128 * j + c : DFF + 128 * j + (c - 128); }

__device__ __forceinline__ void gemv_item(const float* W, int N, int n0, const float* bias, const LAS float* vecs, LAS float* red, float* out, int tid) {
    const int cgp = tid & 7, kg = tid >> 3;
    float acc[8][4];
#pragma unroll
    for (int b = 0; b < 8; ++b)
#pragma unroll
        for (int j = 0; j < 4; ++j) acc[b][j] = 0.f;
#pragma unroll 4
    for (int i = 0; i < 16; ++i) { const int k = kg + 64 * i; const f32x4 w = __builtin_nontemporal_load((const f32x4*)(W + (size_t)k * N + n0 + 4 * cgp));
#pragma unroll
        for (int b = 0; b < 8; ++b) { const float v = vecs[b * 1024 + k]; acc[b][0] += v * w.x; acc[b][1] += v * w.y; acc[b][2] += v * w.z; acc[b][3] += v * w.w; } }
#pragma unroll
    for (int b = 0; b < 8; ++b) *(LAS f32x4*)(red + (kg * 8 + b) * 32 + 4 * cgp) = (f32x4){acc[b][0], acc[b][1], acc[b][2], acc[b][3]};
    __syncthreads();
    if (tid < 256) { const int b = tid >> 5, col = tid & 31; float s = 0.f;
#pragma unroll 8
      for (int g = 0; g < 64; ++g) s += red[(g * 8 + b) * 32 + col];
      out[(size_t)b * N + n0 + col] = s + (bias ? bias[n0 + col] : 0.f); }
    __syncthreads();
}

__device__ __forceinline__ void transposes(const Params& p, LAS unsigned char* lds, int it_begin, int it_end, int gw, int NGW, int lane, int wave) {
    LAS float* scr = (LAS float*)(lds + wave * 8704);
    constexpr int I_IN = 16 * 96, I_OUT = 16 * 32, I_UP = 16 * 176;
    for (int it = it_begin + gw; it < it_end; it += NGW) {
        int r = it;
        if (r < I_IN) { const int kb = r / 96, nb = r % 96; transpose_item(p.w_in, DIN, 1024, (bf16_t*)(p.ws + WS_WIN), 32 * nb, win_src(32 * nb), 64 * kb, scr, lane); continue; } r -= I_IN;
        if (r < I_OUT) { const int kb = r / 32, nb = r % 32; transpose_item(p.w_out, 1024, 1024, (bf16_t*)(p.ws + WS_WOUT), 32 * nb, 32 * nb, 64 * kb, scr, lane); continue; } r -= I_OUT;
        if (r < I_UP) { const int kb = r / 176, nb = r % 176; transpose_item(p.w_up, 2 * DFF, 1024, (bf16_t*)(p.ws + WS_WUP), 32 * nb, wup_src(32 * nb), 64 * kb, scr, lane); continue; } r -= I_UP;
        { const int kb = r / 32, nb = r % 32; transpose_item(p.w_down, 1024, DFF, (bf16_t*)(p.ws + WS_WDOWN), 32 * nb, 32 * nb, 64 * kb, scr, lane); }
    }
}
constexpr int NIT_IN = 16 * 96, NIT_ALL = 16 * 96 + 16 * 32 + 16 * 176 + 44 * 32;
__device__ __forceinline__ void phase0(const Params& p, LAS unsigned char* lds, int tid, int lane, int wave) {
    float* mod = (float*)(p.ws + WS_MOD);
    const int ngemv = gridDim.x > 192 ? 192 : gridDim.x;
    if (blockIdx.x < ngemv) {
        LAS float* vecs = (LAS float*)lds; LAS float* red = (LAS float*)(lds + 32768);
        for (int i = tid; i < 8192; i += 512) { const float v = p.c[i]; vecs[i] = v / (1.f + __expf(-v)); }
        __syncthreads();
        for (int it = blockIdx.x; it < 192; it += ngemv) gemv_item(p.w_ada, NMOD, 32 * it, p.b_ada, vecs, red, mod, tid);
    } else {
        transposes(p, lds, 0, NIT_IN, (blockIdx.x - 192) * 8 + wave, (gridDim.x - 192) * 8, lane, wave);
    }
}

__device__ __forceinline__ void phase1(const Params& p, LAS unsigned char* lds, int tid, int lane, int wave) {
    const float* mod = (const float*)(p.ws + WS_MOD);
    if (blockIdx.x < 176) {
        LAS float* vecs = (LAS float*)lds; LAS float* red = (LAS float*)(lds + 32768);
        for (int i = tid; i < 8192; i += 512) vecs[i] = mod[(i >> 10) * NMOD + 3072 + (i & 1023)];
        __syncthreads();
        for (int it = blockIdx.x; it < 176; it += gridDim.x) gemv_item(p.w_up, 2 * DFF, 32 * it, nullptr, vecs, red, (float*)(p.ws + WS_BIAS2), tid);
    }
    if (gridDim.x == 256) {
        if (blockIdx.x < 176) transposes(p, lds, NIT_IN + 2240, NIT_ALL, blockIdx.x * 8 + wave, 176 * 8, lane, wave);
        else transposes(p, lds, NIT_IN, NIT_IN + 2240, (blockIdx.x - 176) * 8 + wave, 80 * 8, lane, wave);
    } else transposes(p, lds, gridDim.x > 192 ? NIT_IN : 0, NIT_ALL, blockIdx.x * 8 + wave, gridDim.x * 8, lane, wave);
    __syncthreads();
    LAS float* wf = (LAS float*)lds;
    for (int i = tid; i < 8192; i += 512) { const int k = i >> 3, h = i & 7; wf[h * 1024 + k] = p.w_in[(size_t)k * DIN + 1536 + h]; }
    __syncthreads();
    bf16_t* hb = (bf16_t*)(p.ws + WS_H); float* logf = (float*)(p.ws + WS_LOGF);
    const int gw = blockIdx.x * 8 + wave, NGW = gridDim.x * 8;
    const int rpw = (((T_ + NGW - 1) / NGW) + 1) & ~1  , r0 = gw * rpw, r1 = (r0 + rpw < T_) ? r0 + rpw : T_;
    const bool b5 = (lane & 32) != 0, b4 = (lane & 16) != 0, b3 = (lane & 8) != 0;
    f32x4 gmv[4], shv[4]; int bcur = -1;
    f32x4 vn[2][4];
#define ROW2(rw, q) (((rw) + (q) < r1) ? (rw) + (q) : (rw))
    if (r0 < r1) {
#pragma unroll
        for (int q = 0; q < 2; ++q)
#pragma unroll
            for (int j = 0; j < 4; ++j) vn[q][j] = __builtin_nontemporal_load((const f32x4*)(p.x + (size_t)ROW2(r0, q) * D_ + 4 * lane + 256 * j)); }
    for (int row = r0; row < r1; row += 2) {
        const int b = row >> 11;
        if (b != bcur) { bcur = b; const float* mb = mod + b * NMOD;
#pragma unroll
            for (int j = 0; j < 4; ++j) { const int col = 4 * lane + 256 * j; gmv[j] = *(const f32x4*)(p.n1g + col) * (*(const f32x4*)(mb + 1024 + col) + 1.f); shv[j] = *(const f32x4*)(mb + col); } }
        f32x4 v[2][4]; float ss[2];
#pragma unroll
        for (int q = 0; q < 2; ++q) { ss[q] = 0.f;
#pragma unroll
            for (int j = 0; j < 4; ++j) { v[q][j] = vn[q][j]; ss[q] += (v[q][j].x * v[q][j].x + v[q][j].y * v[q][j].y) + (v[q][j].z * v[q][j].z + v[q][j].w * v[q][j].w); } }
        if (row + 2 < r1) {
#pragma unroll
            for (int q = 0; q < 2; ++q)
#pragma unroll
                for (int j = 0; j < 4; ++j) vn[q][j] = __builtin_nontemporal_load((const f32x4*)(p.x + (size_t)ROW2(row + 2, q) * D_ + 4 * lane + 256 * j)); }
#pragma unroll
        for (int q = 0; q < 2; ++q) ss[q] = xsum12(ss[q]);
#pragma unroll
        for (int o = 4; o < 64; o <<= 1) { ss[0] += __shfl_xor(ss[0], o); ss[1] += __shfl_xor(ss[1], o); }
#pragma unroll
        for (int q = 0; q < 2; ++q) { const float rstd = rsqrtf(ss[q] * (1.f / D_) + EPS); const int rq = ROW2(row, q);
#pragma unroll
            for (int j = 0; j < 4; ++j) { const int col = 4 * lane + 256 * j;
                v[q][j] = (v[q][j] * rstd) * gmv[j] + shv[j];
                u32x2 w; w.x = pk2(v[q][j].x, v[q][j].y); w.y = pk2(v[q][j].z, v[q][j].w);
                *(u32x2*)(hb + (size_t)rq * D_ + col) = w; } }
        float f[2][8];
#pragma unroll
        for (int h = 0; h < 8; ++h) { float s0 = 0.f, s1 = 0.f;
#pragma unroll
            for (int j = 0; j < 4; ++j) { const f32x4 w = *(const LAS f32x4*)(wf + h * 1024 + 4 * lane + 256 * j);
                s0 += (v[0][j].x * w.x + v[0][j].y * w.y) + (v[0][j].z * w.z + v[0][j].w * w.w); s1 += (v[1][j].x * w.x + v[1][j].y * w.y) + (v[1][j].z * w.z + v[1][j].w * w.w); }
            f[0][h] = s0; f[1][h] = s1; }
        float g4[2][4], g2[2][2], z[2];
#pragma unroll
        for (int i = 0; i < 4; ++i)
#pragma unroll
            for (int q = 0; q < 2; ++q) { const float send = b5 ? f[q][i] : f[q][4 + i], keep = b5 ? f[q][4 + i] : f[q][i]; g4[q][i] = keep + __shfl_xor(send, 32); }
#pragma unroll
        for (int i = 0; i < 2; ++i)
#pragma unroll
            for (int q = 0; q < 2; ++q) { const float send = b4 ? g4[q][i] : g4[q][2 + i], keep = b4 ? g4[q][2 + i] : g4[q][i]; g2[q][i] = keep + __shfl_xor(send, 16); }
#pragma unroll
        for (int q = 0; q < 2; ++q) { const float send = b3 ? g2[q][0] : g2[q][1], keep = b3 ? g2[q][1] : g2[q][0]; z[q] = keep + __shfl_xor(send, 8); }
#pragma unroll
        for (int q = 0; q < 2; ++q) z[q] = xsum12(z[q]);
        z[0] += __shfl_xor(z[0], 4); z[1] += __shfl_xor(z[1], 4);
        if ((lane & 7) == 0) { const int h = lane >> 3; const float bf_ = p.b_f[h];
#pragma unroll
            for (int q = 0; q < 2; ++q) { const float zz = z[q] + bf_; logf[(size_t)ROW2(row, q) * 8 + h] = fminf(zz, 0.f) - __logf(1.f + __expf(-fabsf(zz))); } }
    }
#undef ROW2
    __syncthreads();
}

__device__ __forceinline__ void scan_item(const Params& p, LAS unsigned char* lds, int bh, int tid, int lane, int wave) {
    const float* logf = (const float*)(p.ws + WS_LOGF); const int b = bh >> 3, h = bh & 7;
    LAS float* wt = (LAS float*)lds;
    float a[4];
#pragma unroll
    for (int i = 0; i < 4; ++i) a[i] = logf[((size_t)(b * S_ + 4 * tid + i)) * 8 + h];
    a[1] += a[0]; a[2] += a[1]; a[3] += a[2];
    float sc = a[3];
#pragma unroll
    for (int o = 1; o < 64; o <<= 1) { const float y = __shfl_up(sc, o); if (lane >= o) sc += y; }
    if (lane == 63) wt[wave] = sc;
    __syncthreads();
    float off = sc - a[3];
    for (int w = 0; w < wave; ++w) off += wt[w];
    u32x4* qa = (u32x4*)(p.ws + WS_QAUG) + (size_t)bh * S_ + 4 * tid; u32x4* ka = (u32x4*)(p.ws + WS_KAUG) + (size_t)bh * S_ + 4 * tid;
#pragma unroll
    for (int i = 0; i < 4; ++i) { const float F = (off + a[i]) * LOG2E;
        const unsigned hi = f2bf(F); const float r1 = F - bf2f(hi); const unsigned mid = f2bf(r1); const float r2 = r1 - bf2f(mid); const unsigned lo = f2bf(r2);
        u32x4 q, k; q.x = hi | (mid << 16); q.y = lo | (0x3F80u << 16); q.z = 0x3F803F80u; q.w = 0u;
        k.x = 0x3F803F80u; k.y = 0x3F80u | ((hi ^ 0x8000u) << 16); k.z = (mid ^ 0x8000u) | ((lo ^ 0x8000u) << 16); k.w = 0u;
        qa[i] = q; ka[i] = k; }
    __syncthreads();
}
struct EpiIn {
    static constexpr bool PERM = true, AFTER_DRAIN = false;
    bf16_t *Q, *K, *Vt, *Z, *BG; const float *qg, *kg;
    __device__ __forceinline__ void operator()(const f32x4 (&acc)[2][2][4][2], const pg8::Unit& u, int wr, int wc, int fr, int fq) const {
        const int pn = u.pn; const int row0 = u.pm * 256 + wr * 64 + fr;
        if (pn < 4) {
            const bool isq = pn < 2; const float* g = isq ? qg : kg; bf16_t* dst = isq ? Q : K; const int head = 4 * (pn & 1) + wc; const float mul = isq ? C2 : 1.f;
            f32x4 gv[2][2];
#pragma unroll
            for (int bj = 0; bj < 2; ++bj)
#pragma unroll
                for (int n = 0; n < 2; ++n) gv[bj][n] = *(const f32x4*)(g + 32 * bj + 8 * fq + 4 * n) * mul;
#pragma unroll
            for (int ai = 0; ai < 2; ++ai)
#pragma unroll
                for (int m = 0; m < 4; ++m) {
                    float ss = 0.f;
#pragma unroll
                    for (int bj = 0; bj < 2; ++bj)
#pragma unroll
                        for (int n = 0; n < 2; ++n) { const f32x4 a = acc[ai][bj][m][n]; ss += (a.x * a.x + a.y * a.y) + (a.z * a.z + a.w * a.w); }
                    ss += __shfl_xor(ss, 16); ss += __shfl_xor(ss, 32);
                    const float rinv = rsqrtf(ss * (1.f / 64.f) + EPS);
                    const unsigned row = (unsigned)(row0 + ai * 128 + m * 16);
#pragma unroll
                    for (int bj = 0; bj < 2; ++bj) { const f32x4 v0 = acc[ai][bj][m][0] * rinv * gv[bj][0], v1 = acc[ai][bj][m][1] * rinv * gv[bj][1];
                        u32x4 w; w.x = pk2(v0.x, v0.y); w.y = pk2(v0.z, v0.w); w.z = pk2(v1.x, v1.y); w.w = pk2(v1.z, v1.w);
                        st16wt(dst, (row * 512 + head * 64 + 32 * bj + 8 * fq) * 2u, w); }
                }
        } else if (pn < 6) {
            const int head = 4 * (pn & 1) + wc, b = u.pm >> 3;
            bf16_t* vb = Vt + (size_t)((b * 8 + head) * 64) * S_;
#pragma unroll
            for (int ai = 0; ai < 2; ++ai)
#pragma unroll
                for (int m = 0; m < 4; ++m) { const int t = (row0 + ai * 128 + m * 16) & (S_ - 1);
                    const int tp = (t & ~15) | (((t >> 2) & 1) << 3) | (((t >> 3) & 1) << 2) | (t & 3);
#pragma unroll
                    for (int bj = 0; bj < 2; ++bj)
#pragma unroll
                        for (int n = 0; n < 2; ++n) { const f32x4 a = acc[ai][bj][m][n]; const int d = 32 * bj + 8 * fq + 4 * n;
                            vb[(unsigned)((d + 0) * S_ + tp)] = (bf16_t)f2bf(a.x); vb[(unsigned)((d + 1) * S_ + tp)] = (bf16_t)f2bf(a.y);
                            vb[(unsigned)((d + 2) * S_ + tp)] = (bf16_t)f2bf(a.z); vb[(unsigned)((d + 3) * S_ + tp)] = (bf16_t)f2bf(a.w); }
                }
        } else if (pn < 10) {
            const int ch0 = 128 * (pn - 6) + 32 * wc + 8 * fq;
#pragma unroll
            for (int ai = 0; ai < 2; ++ai)
#pragma unroll
                for (int m = 0; m < 4; ++m) { const unsigned row = (unsigned)(row0 + ai * 128 + m * 16);
                    const f32x4 v0 = acc[ai][0][m][0] * acc[ai][1][m][0], v1 = acc[ai][0][m][1] * acc[ai][1][m][1];
                    u32x4 w; w.x = pk2(v0.x, v0.y); w.y = pk2(v0.z, v0.w); w.z = pk2(v1.x, v1.y); w.w = pk2(v1.z, v1.w);
                    st16wt(Z, (row * 512 + ch0) * 2u, w); }
        } else {
#pragma unroll
            for (int ai = 0; ai < 2; ++ai)
#pragma unroll
                for (int m = 0; m < 4; ++m) { const unsigned row = (unsigned)(row0 + ai * 128 + m * 16);
#pragma unroll
                    for (int bj = 0; bj < 2; ++bj) { const f32x4 v0 = acc[ai][bj][m][0], v1 = acc[ai][bj][m][1];
                        u32x4 w; w.x = pk2(v0.x, v0.y); w.y = pk2(v0.z, v0.w); w.z = pk2(v1.x, v1.y); w.w = pk2(v1.z, v1.w);
                        st16wt(BG, (row * 512 + 256 * (pn - 10) + 128 * bj + 32 * wc + 8 * fq) * 2u, w); } }
        }
    }
};
struct EpiOut {
    static constexpr bool PERM = true, AFTER_DRAIN = false;
    const float* x; const float* mod; const float* n2g; bf16_t* x1b; bf16_t* A2; float* rowss; bf16_t* A2tail;
    __device__ __forceinline__ void operator()(const f32x4 (&acc)[2][2][4][2], const pg8::Unit& u, int wr, int wc, int fr, int fq) const {
        const int b = u.pm >> 3, colb = u.pn * 256 + wc * 32 + 8 * fq; const int row0 = u.pm * 256 + wr * 64 + fr;
        const float* mb = mod + b * NMOD;
        f32x4 g1v[2][2], gm[2][2];
#pragma unroll
        for (int bj = 0; bj < 2; ++bj)
#pragma unroll
            for (int n = 0; n < 2; ++n) { const int col = colb + 128 * bj + 4 * n; g1v[bj][n] = *(const f32x4*)(mb + 2048 + col);
                gm[bj][n] = *(const f32x4*)(n2g + col) * (*(const f32x4*)(mb + 4096 + col) + 1.f); }
#pragma unroll
        for (int ai = 0; ai < 2; ++ai) {
            f32x4 xv[4][2][2];
#pragma unroll
            for (int m = 0; m < 4; ++m)
#pragma unroll
                for (int bj = 0; bj < 2; ++bj)
#pragma unroll
                    for (int n = 0; n < 2; ++n) xv[m][bj][n] = __builtin_nontemporal_load((const f32x4*)(x + ((unsigned)(row0 + ai * 128 + m * 16) * D_ + colb + 128 * bj + 4 * n)));
#pragma unroll
            for (int m = 0; m < 4; ++m) { const unsigned row = (unsigned)(row0 + ai * 128 + m * 16); float ss = 0.f;
#pragma unroll
                for (int bj = 0; bj < 2; ++bj) { f32x4 x1[2]; u32x4 xb;
#pragma unroll
                    for (int n = 0; n < 2; ++n) {
                        x1[n] = xv[m][bj][n] + g1v[bj][n] * acc[ai][bj][m][n];
                        ss += (x1[n].x * x1[n].x + x1[n].y * x1[n].y) + (x1[n].z * x1[n].z + x1[n].w * x1[n].w); if (n == 0) { xb.x = pk2(x1[0].x, x1[0].y); xb.y = pk2(x1[0].z, x1[0].w); } else { xb.z = pk2(x1[1].x, x1[1].y); xb.w = pk2(x1[1].z, x1[1].w); } x1[n] = x1[n] * gm[bj][n]; }
                    u32x4 w; w.x = pk2(x1[0].x, x1[0].y); w.y = pk2(x1[0].z, x1[0].w); w.z = pk2(x1[1].x, x1[1].y); w.w = pk2(x1[1].z, x1[1].w);
                    st16wt(A2, (row * D_ + colb + 128 * bj) * 2u, w);
                    st16wt(x1b, (row * D_ + colb + 128 * bj) * 2u, xb);
                    { const unsigned t = row & (S_ - 1); if (t >= 2016u) st16wt(A2tail, (((row >> 11) * 32 + (t - 2016u)) * D_ + colb + 128 * bj) * 2u, w); } }
                ss += __shfl_xor(ss, 16); ss += __shfl_xor(ss, 32);
                if (fq == 0) rowss[row * 16 + u.pn * 4 + wc] = ss; }
            asm volatile("" ::: "memory");
        }
    }
};
struct EpiUp {
    static constexpr bool PERM = true, AFTER_DRAIN = false;
    const float* rowss; const float* bias2; bf16_t* U; int half;
    __device__ __forceinline__ void operator()(const f32x4 (&acc)[2][2][4][2], const pg8::Unit& u, int wr, int wc, int fr, int fq) const {
        const int b = u.pm >> 3; const int row0 = u.pm * 256 + wr * 64 + fr;
        f32x4 bv[2][2];
#pragma unroll
        for (int bj = 0; bj < 2; ++bj)
#pragma unroll
            for (int n = 0; n < 2; ++n) bv[bj][n] = *(const f32x4*)(bias2 + b * (2 * DFF) + bj * DFF + half * HALFC + 128 * u.pn + 32 * wc + 8 * fq + 4 * n);
#pragma unroll
        for (int ai = 0; ai < 2; ++ai)
#pragma unroll
            for (int m = 0; m < 4; ++m) { const unsigned row = (unsigned)(row0 + ai * 128 + m * 16); const f32x4 s4 = *(const f32x4*)(rowss + row * 16 + 4 * fq); float sq = (s4.x + s4.y) + (s4.z + s4.w); sq += __shfl_xor(sq, 16); sq += __shfl_xor(sq, 32);
                const float rstd = rsqrtf(sq * (1.f / D_) + EPS);
#pragma unroll
                for (int bj = 0; bj < 2; ++bj) { const f32x4 v0 = acc[ai][bj][m][0] * rstd + bv[bj][0], v1 = acc[ai][bj][m][1] * rstd + bv[bj][1];
                    u32x4 w; w.x = pk2(v0.x, v0.y); w.y = pk2(v0.z, v0.w); w.z = pk2(v1.x, v1.y); w.w = pk2(v1.z, v1.w);
                    *(u32x4*)(U + (row * DFF + 256 * u.pn + 128 * bj + 32 * wc + 8 * fq)) = w; } }
    }
};

__device__ __forceinline__ float dpp_f(float old, float src, int which) {
    const int o = __builtin_bit_cast(int, old), v = __builtin_bit_cast(int, src); int r;
    if (which == 0) r = __builtin_amdgcn_update_dpp(o, v, 0x111, 0xf, 0xf, false);
    else if (which == 1) r = __builtin_amdgcn_update_dpp(o, v, 0x112, 0xf, 0xf, false);
    else if (which == 2) r = __builtin_amdgcn_mov_dpp(v, 0x121, 0xf, 0xf, true);
    else r = __builtin_amdgcn_mov_dpp(v, 0x122, 0xf, 0xf, true);
    return __builtin_bit_cast(float, r);
}
__device__ __forceinline__ float dppz(float src, int which) {
    const int v = __builtin_bit_cast(int, src); int r;
    if (which == 0) r = __builtin_amdgcn_update_dpp(0, v, 0x111, 0xf, 0xf, true);
    else if (which == 1) r = __builtin_amdgcn_update_dpp(0, v, 0x112, 0xf, 0xf, true);
    else if (which == 2) r = __builtin_amdgcn_mov_dpp(v, 0x121, 0xf, 0xf, true);
    else r = __builtin_amdgcn_mov_dpp(v, 0x122, 0xf, 0xf, true);
    return __builtin_bit_cast(float, r);
}
#define FMAC_DPP4(G, V, sg, sv, wa, wb, wc, wd, c1, c2) \
    asm("s_nop 1\n\tv_fmac_f32_dpp %0, %2, %4 " c1 " row_mask:0xf bank_mask:0xf bound_ctrl:1\n\tv_fmac_f32_dpp %0, %2, %5 " c2 " row_mask:0xf bank_mask:0xf bound_ctrl:1\n\t" \
        "v_fmac_f32_dpp %1, %3, %6 " c1 " row_mask:0xf bank_mask:0xf bound_ctrl:1\n\tv_fmac_f32_dpp %1, %3, %7 " c2 " row_mask:0xf bank_mask:0xf bound_ctrl:1" \
        : "+v"(G), "+v"(V) : "v"(sg), "v"(sv), "v"(wa), "v"(wb), "v"(wc), "v"(wd))
struct UpOrder : pg8::StaticOrder {
    long tail_off;
    __device__ __forceinline__ long a_off(int pm, size_t) const { return pm < 64 ? ((long)((pm >> 3) * S_ + 254 * (pm & 7) - 2)) * (D_ * 2) : tail_off; }
};
struct EpiUpF {
    static constexpr bool PERM = true, AFTER_DRAIN = false;
    const float* rowss; const float* bias2; const float* fcw; bf16_t* act; LAS float* xch;
    __device__ __forceinline__ void operator()(f32x4 (&acc)[2][2][4][2], const pg8::Unit& u, int wr, int wc, int fr, int fq) const {
        if (u.pm == 64) run<true>(acc, u, wr, wc, fr, fq); else run<false>(acc, u, wr, wc, fr, fq);
    }
    template <bool tail> __device__ __forceinline__ void run(f32x4 (&acc)[2][2][4][2], const pg8::Unit& u, int wr, int wc, int fr_in, int fq_in) const {
        int fr = fr_in, fq = fq_in; asm volatile("" : "+v"(fr), "+v"(fq));
        fr &= 15; fq &= 3;
        const int pm = u.pm, pn = u.pn; const int breg = pm >> 3, ireg = pm & 7;
        const int rbase = wr * 64 + fr, colg = 32 * wc + 8 * fq, chan0 = 128 * pn + colg;
        const int tok0 = breg * S_ + 254 * ireg - 2;
        const bool zfirst = !tail && ireg == 0 && wr == 0 && fr < 2;
        float rstd[2][4];
#pragma unroll
        for (int ai = 0; ai < 2; ++ai)
#pragma unroll
            for (int m = 0; m < 4; ++m) {
                const int r = rbase + 128 * ai + 16 * m; int grow = tail ? (r >> 5) * S_ + 2016 + (r & 31) : tok0 + r; grow = grow < 0 ? 0 : grow;
                const f32x4 s4 = *(const f32x4*)(rowss + (unsigned)grow * 16 + 4 * fq); float sq = (s4.x + s4.y) + (s4.z + s4.w); sq += __shfl_xor(sq, 16); sq += __shfl_xor(sq, 32);
                rstd[ai][m] = rsqrtf(sq * (1.f / D_) + EPS);
            }
#pragma unroll
        for (int ai = 0; ai < 2; ++ai) { const float* bp = bias2 + (tail ? (4 * ai + 2 * wr + 1) : breg) * (2 * DFF) + chan0;
#pragma unroll
            for (int bj = 0; bj < 2; ++bj)
#pragma unroll
                for (int n = 0; n < 2; ++n) { const f32x4 v = acc[ai][bj][3][n] * rstd[ai][3] + *(const f32x4*)(bp + bj * DFF + 4 * n);
                    if (fr >= 14) *(LAS f32x4*)(xch + (((2 * ai + wr) * 2 + (fr - 14)) * 256 + 128 * bj + colg + 4 * n)) = v; } }
        asm volatile("s_waitcnt lgkmcnt(0)" ::: "memory"); __builtin_amdgcn_s_barrier(); asm volatile("" ::: "memory");
#pragma unroll
        for (int n = 0; n < 2; ++n) {
            const float* wp = fcw + chan0 + 4 * n;
            const f32x4 wg0 = *(const f32x4*)(wp), wg1 = *(const f32x4*)(wp + 2 * DFF), wg2 = *(const f32x4*)(wp + 4 * DFF);
            const f32x4 wv0 = *(const f32x4*)(wp + DFF), wv1 = *(const f32x4*)(wp + 3 * DFF), wv2 = *(const f32x4*)(wp + 5 * DFF);
            f32x4 bg = (f32x4){0.f, 0.f, 0.f, 0.f}, bvl = bg;
            if (!tail) { bg = *(const f32x4*)(bias2 + breg * (2 * DFF) + chan0 + 4 * n); bvl = *(const f32x4*)(bias2 + breg * (2 * DFF) + DFF + chan0 + 4 * n); }
            f32x4 ag, bgm, av, bvm;
#pragma unroll
            for (int e = 0; e < 4; ++e) { ag[e] = fr == 0 ? wg1[e] : 0.f; bgm[e] = fr < 2 ? wg0[e] : 0.f; av[e] = fr == 0 ? wv1[e] : 0.f; bvm[e] = fr < 2 ? wv0[e] : 0.f; }
#pragma unroll
            for (int ai = 0; ai < 2; ++ai) {
                const int slot = 2 * ai + wr - 1;
                f32x4 g14 = (f32x4){0.f, 0.f, 0.f, 0.f}, g15 = g14, v14 = g14, v15 = g14;
                if (slot >= 0) { const LAS float* xp = xch + (slot * 2) * 256 + colg + 4 * n;
                    g14 = *(const LAS f32x4*)(xp); g15 = *(const LAS f32x4*)(xp + 256); v14 = *(const LAS f32x4*)(xp + 128); v15 = *(const LAS f32x4*)(xp + 256 + 128); }
                f32x4 pg = g14, pv = g14;
#pragma unroll
                for (int m = 0; m < 4; ++m) {
                    const int r = rbase + 128 * ai + 16 * m;
                    if (tail) { const float* bp = bias2 + (4 * ai + 2 * wr + (m >> 1)) * (2 * DFF) + chan0 + 4 * n; bg = *(const f32x4*)(bp); bvl = *(const f32x4*)(bp + DFF); }
                    f32x4 cg_ = acc[ai][0][m][n] * rstd[ai][m] + bg, cv_ = acc[ai][1][m][n] * rstd[ai][m] + bvl;
                    if (ai == 0 && m == 0) { if (zfirst) { cg_ = (f32x4){0.f, 0.f, 0.f, 0.f}; cv_ = cg_; } }
                    float o[4];
#pragma unroll
                    for (int e = 0; e < 4; ++e) {
                        float G = wg2[e] * cg_[e], V = wv2[e] * cv_[e];
                        FMAC_DPP4(G, V, cg_[e], cv_[e], wg1[e], wg0[e], wv1[e], wv0[e], "row_shr:1", "row_shr:2");
                        if (m == 0) { const float x2g = (fr == 0) ? g14[e] : g15[e], x2v = (fr == 0) ? v14[e] : v15[e];
                            G = __builtin_fmaf(g15[e], ag[e], G); G = __builtin_fmaf(x2g, bgm[e], G); V = __builtin_fmaf(v15[e], av[e], V); V = __builtin_fmaf(x2v, bvm[e], V); }
                        else { FMAC_DPP4(G, V, pg[e], pv[e], ag[e], bgm[e], av[e], bvm[e], "row_ror:1", "row_ror:2"); }
                        o[e] = G * __builtin_amdgcn_rcpf(1.f + __expf(-G)) * V;
                    }
                    pg = cg_; pv = cv_;
                    bool outv; int tg;
                    if (tail) { outv = (m & 1) != 0; tg = (r >> 5) * S_ + 2016 + (r & 31); } else { outv = r >= 2; tg = tok0 + r; }
                    if (outv) { u32x2 w; w.x = pk2(o[0], o[1]); w.y = pk2(o[2], o[3]); *(u32x2*)(act + ((unsigned)tg * DFF + chan0 + 4 * n)) = w; }
                    __builtin_amdgcn_sched_barrier(0);
                }
            }
        }
    }
};
struct EpiDown {
    static constexpr bool PERM = true, AFTER_DRAIN = false;
    const float* mod; const bf16_t* x1b; float* dst;
    __device__ __forceinline__ void operator()(const f32x4 (&acc)[2][2][4][2], const pg8::Unit& u, int wr, int wc, int fr, int fq) const {
        const int b = u.pm >> 3, colb = u.pn * 256 + wc * 32 + 8 * fq; const int row0 = u.pm * 256 + wr * 64 + fr;
        const float* mb = mod + b * NMOD + 5120;
        f32x4 g2v[2][2];
#pragma unroll
        for (int bj = 0; bj < 2; ++bj)
#pragma unroll
            for (int n = 0; n < 2; ++n) g2v[bj][n] = *(const f32x4*)(mb + colb + 128 * bj + 4 * n);
#pragma unroll
        for (int ai = 0; ai < 2; ++ai) {
            u32x4 xw[4][2];
#pragma unroll
            for (int m = 0; m < 4; ++m)
#pragma unroll
                for (int bj = 0; bj < 2; ++bj) xw[m][bj] = __builtin_nontemporal_load((const u32x4*)(x1b + ((unsigned)(row0 + ai * 128 + m * 16) * D_ + colb + 128 * bj)));
#pragma unroll
            for (int m = 0; m < 4; ++m) { const unsigned row = (unsigned)(row0 + ai * 128 + m * 16);
#pragma unroll
                for (int bj = 0; bj < 2; ++bj) { float xf[8]; unpack8(xw[m][bj], xf);
#pragma unroll
                    for (int n = 0; n < 2; ++n) { const unsigned o_ = row * D_ + colb + 128 * bj + 4 * n;
                        *(f32x4*)(dst + o_) = (f32x4){xf[4 * n], xf[4 * n + 1], xf[4 * n + 2], xf[4 * n + 3]} + g2v[bj][n] * acc[ai][bj][m][n]; } } }
            asm volatile("" ::: "memory");
        }
    }
};

__device__ __forceinline__ int crow(int r, int hi) { return (r & 3) + 8 * (r >> 2) + 4 * hi; }
constexpr int AB_K = 0, AB_V = 9216, AB_A = 18432, ABUF = 19456, A_LW = 2 * ABUF;
__device__ __forceinline__ void attn_unit(const Params& p, LAS unsigned char* lds, int bh, int qb, float mshift, int tid, int lane, int wave) {
    const int r32 = lane & 31, hi = lane >> 5, b = bh >> 3, h = bh & 7;
    const bf16_t* Qg = (const bf16_t*)(p.ws + WS_Q); const bf16_t* Kg = (const bf16_t*)(p.ws + WS_K); const bf16_t* Vg = (const bf16_t*)(p.ws + WS_VT);
    const u32x4* qaug = (const u32x4*)(p.ws + WS_QAUG) + (size_t)bh * S_; const u32x4* kaug = (const u32x4*)(p.ws + WS_KAUG) + (size_t)bh * S_;
    bf16_t* mix = (bf16_t*)(p.ws + WS_MIX);
    const int q_rel = 32 * wave + r32, tq = 256 * qb + q_rel;
    bf16x8 qr[4], qa;
    { const bf16_t* qp = Qg + ((size_t)(b * S_ + tq)) * 512 + h * 64 + 8 * hi;
#pragma unroll
      for (int d0 = 0; d0 < 4; ++d0) qr[d0] = *(const bf16x8*)(qp + 16 * d0);
      u32x4 t = qaug[tq]; if (hi) t = (u32x4){0u, 0u, 0u, 0u}; qa = __builtin_bit_cast(bf16x8, t); }
    f32x16 o[2]; float lsum = 0.f;
#pragma unroll
    for (int i = 0; i < 16; ++i) { o[0][i] = 0.f; o[1][i] = 0.f; }
    const int NT = 4 * (qb + 1);
    const int srow = tid >> 3, sch = tid & 7;
    const bf16_t* kp = Kg + ((size_t)(b * S_ + srow)) * 512 + h * 64 + 8 * sch;
    const bf16_t* vp = Vg + ((size_t)(bh * 64 + srow)) * S_ + 8 * sch;
    u32x4 kreg = *(const u32x4*)kp, vreg = *(const u32x4*)vp, areg = (u32x4){0u, 0u, 0u, 0u};
    if (tid < 64) areg = kaug[tid];
    { LAS unsigned char* bb = lds; *(LAS u32x4*)(bb + AB_K + srow * 144 + sch * 16) = kreg; *(LAS u32x4*)(bb + AB_V + srow * 144 + sch * 16) = vreg; if (tid < 64) *(LAS u32x4*)(bb + AB_A + tid * 16) = areg; }
    __syncthreads();
    for (int j = 0; j < NT; ++j) {
        const bool more = (j + 1 < NT);
        if (more) { kreg = *(const u32x4*)(kp + (size_t)(j + 1) * 64 * 512); vreg = *(const u32x4*)(vp + (j + 1) * 64); if (tid < 64) areg = kaug[(j + 1) * 64 + tid]; }
        const LAS unsigned char* bb = lds + (j & 1) * ABUF;
        const int jb = j - 4 * qb;
#pragma unroll
        for (int kh = 0; kh < 2; ++kh) {
            if (jb >= 0 && 64 * jb + 32 * kh > 32 * wave + 31) continue;
            f32x16 C;
#pragma unroll
            for (int i = 0; i < 16; ++i) C[i] = -mshift;
            const LAS unsigned char* kr = bb + AB_K + (32 * kh + r32) * 144 + hi * 16;
#pragma unroll
            for (int d0 = 0; d0 < 4; ++d0) { const bf16x8 a = *(const LAS bf16x8*)(kr + d0 * 32); C = __builtin_amdgcn_mfma_f32_32x32x16_bf16(a, qr[d0], C, 0, 0, 0); }
            { u32x4 t = *(const LAS u32x4*)(bb + AB_A + (32 * kh + r32) * 16); if (hi) t = (u32x4){0u, 0u, 0u, 0u};
              C = __builtin_amdgcn_mfma_f32_32x32x16_bf16(__builtin_bit_cast(bf16x8, t), qa, C, 0, 0, 0); }
            if (jb >= 0) {
#pragma unroll
                for (int i = 0; i < 16; ++i) { const int kv = 64 * jb + 32 * kh + crow(i, hi); if (kv > q_rel) C[i] = -INFINITY; }
            }
#pragma unroll
            for (int i = 0; i < 16; ++i) { C[i] = __builtin_amdgcn_exp2f(C[i]); lsum += C[i]; }
#pragma unroll
            for (int s = 0; s < 2; ++s) {
                u32x4 pw; pw.x = cvtpk_s(C[8 * s + 0], C[8 * s + 1]); pw.y = cvtpk_s(C[8 * s + 2], C[8 * s + 3]); pw.z = cvtpk_s(C[8 * s + 4], C[8 * s + 5]); pw.w = cvtpk_s(C[8 * s + 6], C[8 * s + 7]);
                const bf16x8 pa = __builtin_bit_cast(bf16x8, pw);
#pragma unroll
                for (int dh = 0; dh < 2; ++dh) { const bf16x8 vf = *(const LAS bf16x8*)(bb + AB_V + (32 * dh + r32) * 144 + (32 * kh + 16 * s + 8 * hi) * 2);
                    o[dh] = __builtin_amdgcn_mfma_f32_32x32x16_bf16(pa, vf, o[dh], 0, 0, 0); }
            }
        }
        if (more) { LAS unsigned char* nb = lds + ((j + 1) & 1) * ABUF; *(LAS u32x4*)(nb + AB_K + srow * 144 + sch * 16) = kreg; *(LAS u32x4*)(nb + AB_V + srow * 144 + sch * 16) = vreg; if (tid < 64) *(LAS u32x4*)(nb + AB_A + tid * 16) = areg; }
        __syncthreads();
    }
    lsum += __shfl_xor(lsum, 32);
    LAS float* lw = (LAS float*)(lds + A_LW + wave * 128);
    if (hi == 0) lw[r32] = lsum;
    asm volatile("s_waitcnt lgkmcnt(0)" ::: "memory");
    bf16_t* op = mix + ((size_t)(b * S_ + 256 * qb + 32 * wave)) * D_ + h * 64 + r32;
#pragma unroll
    for (int i = 0; i < 16; ++i) { const int qq = crow(i, hi); const float rl = 1.f / lw[qq];
        op[(size_t)qq * D_] = (bf16_t)f2bf(o[0][i] * rl); op[(size_t)qq * D_ + 32] = (bf16_t)f2bf(o[1][i] * rl); }
    asm volatile("s_waitcnt lgkmcnt(0)" ::: "memory");
}

__device__ __forceinline__ void phase3(const Params& p, LAS unsigned char* lds, int tid, int lane, int wave) {
    float mq = 0.f, mk = 0.f;
    for (int i = 0; i < 64; ++i) { mq = fmaxf(mq, fabsf(p.qg[i])); mk = fmaxf(mk, fabsf(p.kg[i])); }
    const float mshift = 8.f * LOG2E * 1.03f * mq * mk;
    const int G = gridDim.x, bx = blockIdx.x; const int vcu = (G % 8 == 0) ? (bx % 8) * (G / 8) + bx / 8 : bx;
    for (int pr = vcu; pr < 256; pr += G) { const int bh = pr >> 2, s = pr & 3;
#if PROBE_DUP == 4
        for (int rep = 0; rep < 4; ++rep) { int e = rep & 1; asm volatile("" : "+s"(e)); attn_unit(p, lds, bh, e ? s : 7 - s, mshift, tid, lane, wave); }
#else
        for (int rep = 0; rep < 2; ++rep) { int e = rep; asm volatile("" : "+s"(e)); attn_unit(p, lds, bh, e ? s : 7 - s, mshift, tid, lane, wave); }
#endif
    }
    const bf16_t* Z = (const bf16_t*)(p.ws + WS_Z); const bf16_t* BG = (const bf16_t*)(p.ws + WS_BG); bf16_t* mix = (bf16_t*)(p.ws + WS_MIX);
    for (int it = bx * 512 + tid; it < (T_ / 8) * 64; it += G * 512) {
        const int rc = it >> 6, c0 = 8 * (it & 63), t0 = 8 * rc;
        float w0[8], w1[8], w2[8], z1[8], z2[8];
#pragma unroll
        for (int i = 0; i < 8; ++i) { w0[i] = p.cmw[c0 + i]; w1[i] = p.cmw[512 + c0 + i]; w2[i] = p.cmw[1024 + c0 + i]; z1[i] = 0.f; z2[i] = 0.f; }
        if (t0 & (S_ - 1)) { unpack8(*(const u32x4*)(Z + (size_t)(t0 - 2) * 512 + c0), z2); unpack8(*(const u32x4*)(Z + (size_t)(t0 - 1) * 512 + c0), z1); }
#pragma unroll
        for (int r = 0; r < 8; ++r) { float zc[8], bg[8], ov[8];
            unpack8(*(const u32x4*)(Z + (size_t)(t0 + r) * 512 + c0), zc); unpack8(*(const u32x4*)(BG + (size_t)(t0 + r) * 512 + c0), bg);
#pragma unroll
            for (int i = 0; i < 8; ++i) { ov[i] = bg[i] * (w0[i] * z2[i] + w1[i] * z1[i] + w2[i] * zc[i]); z2[i] = z1[i]; z1[i] = zc[i]; }
            st16wt(mix, (unsigned)(((t0 + r) * D_ + 512 + c0) * 2), pack8(ov)); }
    }
}

#define XB_TMO      128
#define XB_XCNT(j)  (256  + 64 * (j))
#define XB_XSUB(j)  (1280 + 64 * (j))
#define XB_XGEN(j)  (2304 + 64 * (j))
#define XB_TOP      3328
#define XB_TOPGEN   3392
#define XCD_BAR_WORDS 3456
#define XB_SPIN_CAP (1u << 18)

__device__ __forceinline__ unsigned xb_ld(unsigned* p)              { return __hip_atomic_load(p, __ATOMIC_RELAXED, __HIP_MEMORY_SCOPE_AGENT); }
__device__ __forceinline__ unsigned xb_add(unsigned* p, unsigned v) { return __hip_atomic_fetch_add(p, v, __ATOMIC_RELAXED, __HIP_MEMORY_SCOPE_AGENT); }
__device__ __forceinline__ unsigned xb_xcc_id() { return (unsigned)__builtin_amdgcn_s_getreg((3 << 11) | 20) & 0xFu; }
#define XB_SPIN(cond, bar) do { unsigned _sp = 0; while (cond) { __builtin_amdgcn_s_sleep(1); \
    if ((++_sp & 255u) == 0u) { if (xb_ld(&(bar)[XB_TMO])) break; if (_sp > XB_SPIN_CAP) { atomicAdd(&(bar)[XB_TMO], 1u); break; } } } } while (0)

struct XcdBarrier {
    unsigned* bar; unsigned x;
    volatile LAS unsigned* st;
};

__device__ __forceinline__ XcdBarrier xcd_barrier_post(unsigned* bar, volatile LAS unsigned* st) {
    XcdBarrier b; b.bar = bar; b.x = xb_xcc_id(); b.st = st;
    if (threadIdx.x == 0) (void)xb_add(&bar[XB_XCNT(b.x)], 1u);
    return b;
}
__device__ __forceinline__ void xcd_barrier_complete(unsigned* bar, unsigned x, unsigned& nloc, unsigned& nx) {
    const unsigned G = gridDim.x * gridDim.y * gridDim.z;
    unsigned sum, cnt, mine, sp = 0u;
    for (;;) {
        sum = 0u; cnt = 0u; mine = 0u;
#pragma unroll
        for (unsigned j = 0; j < 16; ++j) { const unsigned c = xb_ld(&bar[XB_XCNT(j)]); sum += c; cnt += (c > 0u) ? 1u : 0u; mine = (j == x) ? c : mine; }
        if (sum == G) break;
        __builtin_amdgcn_s_sleep(1);
        if ((++sp & 255u) == 0u) { if (xb_ld(&bar[XB_TMO])) break; if (sp > XB_SPIN_CAP) { atomicAdd(&bar[XB_TMO], 1u); break; } }
    }
    nloc = mine > 0u ? mine : 1u; nx = cnt > 0u ? cnt : 1u;
}

__device__ __forceinline__ void xcd_barrier(const XcdBarrier& b) {
    asm volatile("s_waitcnt vmcnt(0)" ::: "memory");
    __syncthreads();
    if (threadIdx.x == 0) {
        unsigned* bar = b.bar;
        __builtin_amdgcn_s_waitcnt(0);
        unsigned nloc = b.st[0], nx = b.st[1];
        if (nloc == 0u) { xcd_barrier_complete(bar, b.x, nloc, nx); b.st[0] = nloc; b.st[1] = nx; }
        const unsigned old = xb_add(&bar[XB_XSUB(b.x)], 1u);
        const unsigned gen = old / nloc;
        if (old + 1u == (gen + 1u) * nloc) {
            __builtin_amdgcn_fence(__ATOMIC_RELEASE, "agent");
            asm volatile("s_waitcnt vmcnt(0)" ::: "memory");
            const unsigned og = xb_add(&bar[XB_TOP], 1u);
            const unsigned tg = og / nx;
            if (og + 1u == (tg + 1u) * nx) xb_add(&bar[XB_TOPGEN], 1u);
            else XB_SPIN(xb_ld(&bar[XB_TOPGEN]) == tg, bar);
            __builtin_amdgcn_fence(__ATOMIC_ACQUIRE, "agent");
            xb_add(&bar[XB_XGEN(b.x)], 1u);
            asm volatile("s_waitcnt vmcnt(0)" ::: "memory");
        } else {
            XB_SPIN(xb_ld(&bar[XB_XGEN(b.x)]) == gen, bar);
            __builtin_amdgcn_fence(__ATOMIC_ACQUIRE, "agent");
            asm volatile("s_waitcnt vmcnt(0)" ::: "memory");
        }
    }
    __syncthreads();
}

__device__ __forceinline__ const void* ldarg(int byteoff) { const void* r;
    asm volatile("s_load_dwordx2 %0, %1, %2\n\ts_waitcnt lgkmcnt(0)" : "=s"(r) : "s"(__builtin_amdgcn_kernarg_segment_ptr()), "i"(byteoff) : "memory"); return r; }
#define LDA(i) ((const float*)ldarg(8 * (i)))
#define GASF __attribute__((address_space(1)))
__device__ __forceinline__ Params load_params() {
    unsigned long long v0, v1, v2, v3, v4, v5, v6, v7, v8, v9, v10, v11, v12, v13, v14, v15, v16;
    asm volatile("s_load_dwordx2 %0, %17, 0\n\ts_load_dwordx2 %1, %17, 8\n\ts_load_dwordx2 %2, %17, 16\n\ts_load_dwordx2 %3, %17, 24\n\ts_load_dwordx2 %4, %17, 32\n\ts_load_dwordx2 %5, %17, 40\n\t"
                 "s_load_dwordx2 %6, %17, 48\n\ts_load_dwordx2 %7, %17, 56\n\ts_load_dwordx2 %8, %17, 64\n\ts_load_dwordx2 %9, %17, 72\n\ts_load_dwordx2 %10, %17, 80\n\ts_load_dwordx2 %11, %17, 88\n\t"
                 "s_load_dwordx2 %12, %17, 96\n\ts_load_dwordx2 %13, %17, 104\n\ts_load_dwordx2 %14, %17, 112\n\ts_load_dwordx2 %15, %17, 120\n\ts_load_dwordx2 %16, %17, 128\n\ts_waitcnt lgkmcnt(0)"
                 : "=&s"(v0), "=&s"(v1), "=&s"(v2), "=&s"(v3), "=&s"(v4), "=&s"(v5), "=&s"(v6), "=&s"(v7), "=&s"(v8), "=&s"(v9),
                   "=&s"(v10), "=&s"(v11), "=&s"(v12), "=&s"(v13), "=&s"(v14), "=&s"(v15), "=&s"(v16)
                 : "s"(__builtin_amdgcn_kernarg_segment_ptr()) : "memory");
#define GP(v) ((const float*)(GASF const float*)(v))
    Params q; q.x = GP(v0); q.c = GP(v1); q.w_ada = GP(v2); q.b_ada = GP(v3); q.n1g = GP(v4); q.w_in = GP(v5); q.b_f = GP(v6); q.qg = GP(v7); q.kg = GP(v8); q.cmw = GP(v9);
    q.w_out = GP(v10); q.n2g = GP(v11); q.w_up = GP(v12); q.fcw = GP(v13); q.w_down = GP(v14); q.out = (float*)(GASF float*)(v15); q.ws = (unsigned char*)(GASF unsigned char*)(v16);
    return q; }
#ifndef PH
#define PH 255
#endif
#ifndef LAST_PHASE
#define LAST_PHASE 99
#endif
__global__ void __launch_bounds__(512, 2) hymba_mega(Params p_arg) {
    extern __shared__ __attribute__((aligned(16))) unsigned char lds_raw[];
    cg::grid_group grid = cg::this_grid();
    LAS unsigned char* lds = (LAS unsigned char*)lds_raw;
    const int tid = threadIdx.x, lane = tid & 63, wave = __builtin_amdgcn_readfirstlane(tid >> 6);
    const int G = gridDim.x, bx = blockIdx.x;
    if (p_arg.ws == nullptr) grid.sync();
    if (tid < 2) ((volatile LAS unsigned*)(lds + 131072))[tid] = 0u;
    __syncthreads();
    const XcdBarrier xbar = xcd_barrier_post((unsigned*)((unsigned char*)(GASF unsigned char*)(unsigned long long)ldarg(8 * 16) + WS_BAR), (volatile LAS unsigned*)(lds + 131072));
#define GSYNC() xcd_barrier(xbar)

#if PH & 1
    { const Params p = load_params(); phase0(p, lds, tid, lane, wave); }
#endif
    GSYNC();
#if PROBE_DUP == 1
    { const Params p = load_params(); phase0(p, lds, tid, lane, wave); } GSYNC();
#endif
#if PROBE_DUP == 9
    GSYNC(); GSYNC(); GSYNC(); GSYNC(); GSYNC(); GSYNC(); GSYNC(); GSYNC(); GSYNC(); GSYNC();
#endif
#if PH & 2
    { const Params p = load_params(); phase1(p, lds, tid, lane, wave); }
#endif
    GSYNC();
#if PROBE_DUP == 2
    { const Params p = load_params(); phase1(p, lds, tid, lane, wave); } GSYNC();
#endif
#if PH & 4
    {
        const Params p = load_params();
        if (bx < 64) scan_item(p, lds, bx, tid, lane, wave);
        pg8::Gemm g{(const bf16_t*)(p.ws + WS_H), (const bf16_t*)(p.ws + WS_WIN), T_, 3072, 1024}; pg8::StaticOrder S; S.init(T_, 3072, G, bx);
        EpiIn E{(bf16_t*)(p.ws + WS_Q), (bf16_t*)(p.ws + WS_K), (bf16_t*)(p.ws + WS_VT), (bf16_t*)(p.ws + WS_Z), (bf16_t*)(p.ws + WS_BG), p.qg, p.kg};
        pg8::gemm_phase<EpiIn, pg8::StaticOrder, true, true>(lds, g, S, E);
    }
#endif
    GSYNC();
#if PH & 8
    { const Params p = load_params(); phase3(p, lds, tid, lane, wave); }
#endif
    GSYNC();
#if PH & 16
    {
        const Params p = load_params();
        pg8::Gemm g{(const bf16_t*)(p.ws + WS_MIX), (const bf16_t*)(p.ws + WS_WOUT), T_, 1024, 1024}; pg8::StaticOrder S; S.init(T_, 1024, G, bx);
        EpiOut E{p.x, (const float*)(p.ws + WS_MOD), p.n2g, (bf16_t*)(p.ws + WS_Q), (bf16_t*)(p.ws + WS_H), (float*)(p.ws + WS_ROWSS), (bf16_t*)(p.ws + WS_TAIL)};
        pg8::gemm_phase<EpiOut, pg8::StaticOrder, true, true>(lds, g, S, E);
#if PROBE_DUP == 7
        GSYNC();
        pg8::gemm_phase<EpiOut, pg8::StaticOrder, true, true>(lds, g, S, E);
#endif
    }
#endif
    GSYNC();
#if PH & 32
    {
        const Params p = load_params();
        pg8::Gemm g{(const bf16_t*)(p.ws + WS_H), (const bf16_t*)(p.ws + WS_WUP), 65 * 256, 2 * DFF, 1024};
        UpOrder S; S.init(65 * 256, 2 * DFF, G, bx); S.tail_off = (long)WS_TAIL - (long)WS_H;
        EpiUpF E{(const float*)(p.ws + WS_ROWSS), (const float*)(p.ws + WS_BIAS2), p.fcw, (bf16_t*)(p.ws + WS_ACT), (LAS float*)(lds + XCH_OFF)};
        pg8::gemm_phase<EpiUpF, UpOrder, true, true>(lds, g, S, E);
#if PROBE_DUP == 5
        GSYNC();
        pg8::gemm_phase<EpiUpF, UpOrder, true, true>(lds, g, S, E);
#endif
    }
#endif
    GSYNC();
#if PH & 128
    {
        const Params p = load_params();
        pg8::Gemm g{(const bf16_t*)(p.ws + WS_ACT), (const bf16_t*)(p.ws + WS_WDOWN), T_, 1024, DFF}; pg8::StaticOrder S; S.init(T_, 1024, G, bx);
#if PROBE_DUP == 8
        { EpiDown E0{(const float*)(p.ws + WS_MOD), (const bf16_t*)(p.ws + WS_Q), (float*)(p.ws + WS_K)};
          pg8::gemm_phase<EpiDown, pg8::StaticOrder, true, true>(lds, g, S, E0); GSYNC(); }
#endif
        EpiDown E{(const float*)(p.ws + WS_MOD), (const bf16_t*)(p.ws + WS_Q), p.out};
        pg8::gemm_phase<EpiDown, pg8::StaticOrder, true, true>(lds, g, S, E);
    }
#endif
}

extern "C" void kernel_launch(void* const* d_in, const int* in_sizes, int n_in, void* d_out, int out_size, void* d_ws, size_t ws_size, hipStream_t stream) {
    static int grid = 0;
    if (grid == 0) {
        int dev = 0, cus = 0, per_cu = 0;
        hipGetDevice(&dev); hipDeviceGetAttribute(&cus, hipDeviceAttributeMultiprocessorCount, dev);
        if (hipFuncSetAttribute((const void*)hymba_mega, hipFuncAttributeMaxDynamicSharedMemorySize, LDS_BYTES) != hipSuccess) fprintf(stderr, "hipFuncSetAttribute failed\n");
        if (hipOccupancyMaxActiveBlocksPerMultiprocessor(&per_cu, (const void*)hymba_mega, 512, LDS_BYTES) != hipSuccess || per_cu < 1) { fprintf(stderr, "occupancy query: %d\n", per_cu); per_cu = 1; }
        (void)hipGetLastError();
        grid = cus > 0 ? cus : 256;
    }
    Params p{};
    p.x = (const float*)d_in[0]; p.c = (const float*)d_in[1]; p.w_ada = (const float*)d_in[2]; p.b_ada = (const float*)d_in[3]; p.n1g = (const float*)d_in[4];
    p.w_in = (const float*)d_in[5]; p.b_f = (const float*)d_in[6]; p.qg = (const float*)d_in[7]; p.kg = (const float*)d_in[8]; p.cmw = (const float*)d_in[9];
    p.w_out = (const float*)d_in[10]; p.n2g = (const float*)d_in[11]; p.w_up = (const float*)d_in[12]; p.fcw = (const float*)d_in[13]; p.w_down = (const float*)d_in[14];
    p.out = (float*)d_out; p.ws = (unsigned char*)d_ws;
    (void)hipMemsetAsync((unsigned char*)d_ws + WS_BAR, 0, 16384, stream);
    void* args[] = {&p};
    hipError_t e = hipLaunchCooperativeKernel((const void*)hymba_mega, dim3(grid), dim3(512), args, LDS_BYTES, stream);
    if (e != hipSuccess) fprintf(stderr, "cooperative launch failed: %s (grid %d)\n", hipGetErrorString(e), grid);
}
```
